# Optimizing an MI355X kernel written in HIP

```python
import jax
import jax.numpy as jnp
from jax import lax
import numpy as np

D_MODEL = 1024
BATCH = 32
SEQ = 2048
DEPTH = 1
DEC_BATCH = 32
DEC_SEQ = 32
PAST_LEN = 4096

CHUNK = 64
N_META = 16
Q_BLOCK = 128
EPS = 1e-6
NEG = -1e30
MLA_HEADS = 8
QK_NOPE = 64
QK_ROPE = 32
V_DIM = 64
Q_LORA = 256
KV_LORA = 128
ROPE_BASE = 10000.0
ATTN_SCALE = (QK_NOPE + QK_ROPE) ** -0.5
MLA_DIM = MLA_HEADS * V_DIM
MLA_COLS = Q_LORA + KV_LORA + QK_ROPE
RWKV_HEADS = 8
RWKV_HEAD = 64
RWKV_DIM = RWKV_HEADS * RWKV_HEAD
DECAY_LORA = 64
AAA_LORA = 64
GATE_LORA = 128
LNX_EPS = 64e-5
RWKV_COLS = 3 * RWKV_DIM + DECAY_LORA + AAA_LORA + GATE_LORA
IN_COLS = MLA_COLS + RWKV_COLS
MIX_DIM = MLA_DIM + RWKV_DIM
D_FF = -(-8 * D_MODEL // (3 * 256)) * 256

kernel_name = 'hymba_mla_rwkv7_streaming_step'


def rmsnorm(x, g, eps=EPS):
    xf = x.astype(jnp.float32)
    y = xf * lax.rsqrt(jnp.mean(xf * xf, axis=-1, keepdims=True) + eps)
    return (y * g.astype(jnp.float32)).astype(x.dtype)


def rope(x, pos):
    half = x.shape[-1] // 2
    inv = ROPE_BASE ** (-jnp.arange(half, dtype=jnp.float32) / half)
    ang = pos.astype(jnp.float32)[:, None] * inv[None, :]
    shape = (ang.shape[0],) + (1,) * (x.ndim - 3) + (half,)
    cos = jnp.cos(ang).reshape(shape).astype(x.dtype)
    sin = jnp.sin(ang).reshape(shape).astype(x.dtype)
    x1, x2 = x[..., :half], x[..., half:]
    return jnp.concatenate([x1 * cos - x2 * sin, x1 * sin + x2 * cos], axis=-1)


def mla_kv_rows(p_mla, pos, kv_norm_g, kn_rope_g):
    c = rmsnorm(p_mla[..., Q_LORA:Q_LORA + KV_LORA], kv_norm_g)
    kr = rope(rmsnorm(p_mla[..., Q_LORA + KV_LORA:MLA_COLS], kn_rope_g), pos)
    return c, kr


def mla_queries(p_mla, pos, q_norm_g, w_q_up, qn_nope_g, qn_rope_g):
    b, l = p_mla.shape[:2]
    ql = rmsnorm(p_mla[..., :Q_LORA], q_norm_g)
    q = (ql @ w_q_up).reshape(b, l, MLA_HEADS, QK_NOPE + QK_ROPE)
    qn = rmsnorm(q[..., :QK_NOPE], qn_nope_g)
    qr = rope(rmsnorm(q[..., QK_NOPE:], qn_rope_g), pos)
    return qn, qr


def expand_latent(c, w_kv_up, kn_nope_g):
    b, l = c.shape[:2]
    kv = (c @ w_kv_up).reshape(b, l, MLA_HEADS, QK_NOPE + V_DIM)
    return rmsnorm(kv[..., :QK_NOPE], kn_nope_g), kv[..., QK_NOPE:]


def attend_block(qn, qr, q_chunk, kn, kr, v, k_chunk):
    s = jnp.einsum('bqhd,bkhd->bhqk', qn, kn) + jnp.einsum('bqhr,bkr->bhqk', qr, kr)
    s = s.astype(jnp.float32) * ATTN_SCALE
    mask = k_chunk[None, :] <= q_chunk[:, None]
    s = jnp.where(mask[None, None], s, NEG)
    p = jax.nn.softmax(s, axis=-1).astype(v.dtype)
    return jnp.einsum('bhqk,bkhd->bqhd', p, v)


def prompt_attention(qn, qr, q_chunk, kn, kr, v, k_chunk):
    b, s = qn.shape[:2]
    nb = s // Q_BLOCK

    def blocks(t):
        return jnp.swapaxes(t.reshape((b, nb, Q_BLOCK) + t.shape[2:]), 0, 1)

    out = lax.map(lambda a: attend_block(a[0], a[1], a[2], kn, kr, v, k_chunk),
                  (blocks(qn), blocks(qr), q_chunk.reshape(nb, Q_BLOCK)))
    return jnp.swapaxes(out, 0, 1).reshape(b, s, MLA_DIM)


def heads(t):
    return t.reshape(t.shape[:-1] + (RWKV_HEADS, RWKV_HEAD))


def rwkv_inputs(p_rw, prev, mu_shift, w0, w2, a0, a2, k_k, k_a):
    shifted = jnp.concatenate([prev[:, None, :].astype(p_rw.dtype), p_rw[:, :-1]], axis=1)
    xm = p_rw + (shifted - p_rw) * mu_shift
    o = RWKV_DIM
    r, k, v = xm[..., :o], xm[..., o:2 * o], xm[..., 2 * o:3 * o]
    wl = xm[..., 3 * o:3 * o + DECAY_LORA]
    al = xm[..., 3 * o + DECAY_LORA:3 * o + DECAY_LORA + AAA_LORA]
    gl = xm[..., 3 * o + DECAY_LORA + AAA_LORA:]
    w_log = -jax.nn.softplus(-(w0 + jnp.tanh(wl) @ w2).astype(jnp.float32)) - 0.5
    decay = jnp.exp(-jnp.exp(w_log))
    a = jax.nn.sigmoid((a0 + al @ a2).astype(jnp.float32))
    kk = heads((k * k_k).astype(jnp.float32))
    kk = kk / jnp.maximum(jnp.sqrt(jnp.sum(kk * kk, axis=-1, keepdims=True)), 1e-12)
    k_eff = k.astype(jnp.float32) * (1.0 + (a - 1.0) * k_a.astype(jnp.float32))
    return (heads(r.astype(jnp.float32)), heads(decay), heads(k_eff),
            heads(v.astype(jnp.float32)), kk, heads(a), gl)


def wkv_scan(s0, r, w, k, v, kk, a):
    def step(S, inp):
        r_t, w_t, k_t, v_t, kk_t, a_t = inp
        sa = jnp.einsum('bhvk,bhk->bhv', S, -kk_t)
        S = (S * w_t[:, :, None, :] + sa[..., None] * (kk_t * a_t)[:, :, None, :]
             + v_t[..., None] * k_t[:, :, None, :])
        return S, jnp.einsum('bhvk,bhk->bhv', S, r_t)

    xs = tuple(jnp.swapaxes(t, 0, 1) for t in (r, w, k, v, kk, a))
    S, ys = lax.scan(step, s0.astype(jnp.float32), xs)
    return S, jnp.swapaxes(ys, 0, 1)


def rwkv_out(y, r, k, v, gl, g2, r_k, lnx_g, lnx_b):
    b, l = y.shape[:2]
    mean = jnp.mean(y, axis=-1, keepdims=True)
    var = jnp.mean(jnp.square(y - mean), axis=-1, keepdims=True)
    yn = ((y - mean) * lax.rsqrt(var + LNX_EPS)).reshape(b, l, RWKV_DIM)
    yn = yn * lnx_g.astype(jnp.float32) + lnx_b.astype(jnp.float32)
    bonus = (jnp.sum(r * k * r_k.astype(jnp.float32), axis=-1, keepdims=True) * v).reshape(b, l, RWKV_DIM)
    g = jax.nn.sigmoid(gl) @ g2
    return (yn + bonus).astype(gl.dtype) * g


def layer_tail(x, attn, rw, attn_out_g, w_out, norm_ffn_g, w_gate, w_up, w_down):
    mix = jnp.concatenate([rmsnorm(attn, attn_out_g), rw], axis=-1)
    h = x + mix @ w_out
    u = rmsnorm(h, norm_ffn_g)
    return h + (jax.nn.silu(u @ w_gate) * (u @ w_up)) @ w_down


def setup_inputs(seed: int = 0) -> dict:
    key = jax.random.key(seed)
    ks = jax.random.split(key, 40)

    def nrm(k, shape, scale):
        return jax.random.normal(k, shape, jnp.float32) * scale

    return {
        'x_prompt': nrm(ks[0], (BATCH, SEQ, D_MODEL), 1.0),
        'x_sample': nrm(ks[1], (DEC_BATCH, DEC_SEQ, D_MODEL), 1.0),
        'cache_kv_latent': nrm(ks[2], (DEC_BATCH, PAST_LEN, KV_LORA), 1.0),
        'cache_k_rope': nrm(ks[3], (DEC_BATCH, PAST_LEN, QK_ROPE), 1.0),
        'state_wkv': nrm(ks[4], (DEC_BATCH, RWKV_HEADS, RWKV_HEAD, RWKV_HEAD), 0.1),
        'state_shift': nrm(ks[5], (DEC_BATCH, RWKV_COLS), 1.0),
        'meta_tokens': nrm(ks[6], (N_META, D_MODEL), 1.0),
        'norm_mix_g': 1.0 + nrm(ks[7], (D_MODEL,), 0.02),
        'w_in': nrm(ks[8], (D_MODEL, IN_COLS), D_MODEL ** -0.5),
        'q_norm_g': 1.0 + nrm(ks[9], (Q_LORA,), 0.02),
        'w_q_up': nrm(ks[10], (Q_LORA, MLA_HEADS * (QK_NOPE + QK_ROPE)), Q_LORA ** -0.5),
        'kv_norm_g': 1.0 + nrm(ks[11], (KV_LORA,), 0.02),
        'w_kv_up': nrm(ks[12], (KV_LORA, MLA_HEADS * (QK_NOPE + V_DIM)), KV_LORA ** -0.5),
        'qn_nope_g': 1.0 + nrm(ks[13], (QK_NOPE,), 0.02),
        'qn_rope_g': 1.0 + nrm(ks[14], (QK_ROPE,), 0.02),
        'kn_nope_g': 1.0 + nrm(ks[15], (QK_NOPE,), 0.02),
        'kn_rope_g': 1.0 + nrm(ks[16], (QK_ROPE,), 0.02),
        'attn_out_g': 1.0 + nrm(ks[17], (MLA_DIM,), 0.02),
        'mu_shift': jax.random.uniform(ks[18], (RWKV_COLS,), jnp.float32, 0.0, 1.0),
        'w0': jax.random.uniform(ks[19], (RWKV_DIM,), jnp.float32, -6.0, -1.0),
        'w2': nrm(ks[20], (DECAY_LORA, RWKV_DIM), 0.1 * DECAY_LORA ** -0.5),
        'a0': nrm(ks[21], (RWKV_DIM,), 0.1),
        'a2': nrm(ks[22], (AAA_LORA, RWKV_DIM), 0.5 * AAA_LORA ** -0.5),
        'g2': nrm(ks[23], (GATE_LORA, RWKV_DIM), GATE_LORA ** -0.5),
        'k_k': 0.85 + nrm(ks[24], (RWKV_DIM,), 0.02),
        'k_a': 1.0 + nrm(ks[25], (RWKV_DIM,), 0.02),
        'r_k': nrm(ks[26], (RWKV_HEADS, RWKV_HEAD), 0.1),
        'lnx_g': 1.0 + nrm(ks[27], (RWKV_DIM,), 0.02),
        'lnx_b': nrm(ks[28], (RWKV_DIM,), 0.02),
        'w_out': nrm(ks[29], (MIX_DIM, D_MODEL), MIX_DIM ** -0.5),
        'norm_ffn_g': 1.0 + nrm(ks[30], (D_MODEL,), 0.02),
        'w_gate': nrm(ks[31], (D_MODEL, D_FF), D_MODEL ** -0.5),
        'w_up': nrm(ks[32], (D_MODEL, D_FF), D_MODEL ** -0.5),
        'w_down': nrm(ks[33], (D_FF, D_MODEL), D_FF ** -0.5),
    }


def reference(x_prompt, x_sample, cache_kv_latent, cache_k_rope, state_wkv, state_shift,
              meta_tokens, norm_mix_g, w_in, q_norm_g, w_q_up, kv_norm_g, w_kv_up,
              qn_nope_g, qn_rope_g, kn_nope_g, kn_rope_g, attn_out_g, mu_shift, w0, w2,
              a0, a2, g2, k_k, k_a, r_k, lnx_g, lnx_b, w_out, norm_ffn_g, w_gate, w_up, w_down):
    b, s = x_prompt.shape[:2]
    L = N_META + s
    xf = jnp.concatenate([jnp.broadcast_to(meta_tokens.astype(x_prompt.dtype)[None], (b, N_META, D_MODEL)),
                          x_prompt], axis=1)
    proj = rmsnorm(xf, norm_mix_g) @ w_in
    p_mla, p_rw = proj[..., :MLA_COLS], proj[..., MLA_COLS:]
    pos = jnp.arange(L, dtype=jnp.int32)
    k_chunk = jnp.concatenate([jnp.full((N_META,), -1, jnp.int32),
                               jnp.arange(s, dtype=jnp.int32) // CHUNK])
    q_chunk = jnp.arange(s, dtype=jnp.int32) // CHUNK
    c_p, kr_p = mla_kv_rows(p_mla, pos, kv_norm_g, kn_rope_g)
    kn_p, v_p = expand_latent(c_p, w_kv_up, kn_nope_g)
    qn_p, qr_p = mla_queries(p_mla[:, N_META:], pos[N_META:], q_norm_g, w_q_up, qn_nope_g, qn_rope_g)
    attn_p = prompt_attention(qn_p, qr_p, q_chunk, kn_p, kr_p, v_p, k_chunk)
    r, w, k, v, kk, a, gl = rwkv_inputs(p_rw, jnp.zeros((b, RWKV_COLS), p_rw.dtype),
                                        mu_shift, w0, w2, a0, a2, k_k, k_a)
    wkv_p, y_rw = wkv_scan(jnp.zeros((b, RWKV_HEADS, RWKV_HEAD, RWKV_HEAD), jnp.float32),
                           r, w, k, v, kk, a)
    rw_p = rwkv_out(y_rw[:, N_META:], r[:, N_META:], k[:, N_META:], v[:, N_META:],
                    gl[:, N_META:], g2, r_k, lnx_g, lnx_b)
    y_prompt = layer_tail(x_prompt, attn_p, rw_p, attn_out_g, w_out, norm_ffn_g, w_gate, w_up, w_down)
    shift_p = p_rw[:, -1]

    db, ds = x_sample.shape[:2]
    past = cache_kv_latent.shape[1]
    proj_s = rmsnorm(x_sample, norm_mix_g) @ w_in
    ps_mla, ps_rw = proj_s[..., :MLA_COLS], proj_s[..., MLA_COLS:]
    pos_s = past + jnp.arange(ds, dtype=jnp.int32)
    c_s, kr_s = mla_kv_rows(ps_mla, pos_s, kv_norm_g, kn_rope_g)
    c_all = jnp.concatenate([cache_kv_latent.astype(c_s.dtype), c_s], axis=1)
    kr_all = jnp.concatenate([cache_k_rope.astype(kr_s.dtype), kr_s], axis=1)
    kn_s, v_s = expand_latent(c_all, w_kv_up, kn_nope_g)
    qn_s, qr_s = mla_queries(ps_mla, pos_s, q_norm_g, w_q_up, qn_nope_g, qn_rope_g)
    k_chunk_s = jnp.arange(past + ds, dtype=jnp.int32) // CHUNK
    attn_s = attend_block(qn_s, qr_s, pos_s // CHUNK, kn_s, kr_all, v_s, k_chunk_s).reshape(db, ds, MLA_DIM)
    r2, w2_, k2, v2, kk2, a2_, gl2 = rwkv_inputs(ps_rw, state_shift, mu_shift, w0, w2, a0, a2, k_k, k_a)
    wkv_s, y_rw_s = wkv_scan(state_wkv, r2, w2_, k2, v2, kk2, a2_)
    rw_s = rwkv_out(y_rw_s, r2, k2, v2, gl2, g2, r_k, lnx_g, lnx_b)
    y_sample = layer_tail(x_sample, attn_s, rw_s, attn_out_g, w_out, norm_ffn_g, w_gate, w_up, w_down)
    shift_s = ps_rw[:, -1].astype(state_shift.dtype)

    return (y_prompt, y_sample, c_p, kr_p, wkv_p.astype(x_prompt.dtype), shift_p,
            c_s, kr_s, wkv_s.astype(state_wkv.dtype), shift_s)
```

```cpp
#include <hip/hip_runtime.h>
#include <hip/hip_cooperative_groups.h>
#include <cstdio>
#include <cstdint>
namespace cg = cooperative_groups;

namespace pg8 {
#define PG8_LAS __attribute__((address_space(3)))
typedef unsigned short bf16_t;
typedef short bf16x8 __attribute__((ext_vector_type(8)));
typedef float f32x4 __attribute__((ext_vector_type(4)));
typedef unsigned u32x4 __attribute__((ext_vector_type(4)));
constexpr int BM = 256, BK = 64, HALF = 128, HTB = HALF * BK * 2  , STAGE_BYTES = 8 * HTB, NXCD = 8, WGM = 8;

__host__ __device__ __forceinline__ int lds_byte(int r, int c) { const int st = (r >> 4) * 2 + (c >> 5), rr = r & 15, cc = c & 31, ob = rr * 64 + cc * 2; return st * 1024 + (ob ^ (((ob >> 9) & 1) << 5)); }
__host__ __device__ __forceinline__ void stage_rc(int b, int& R, int& C) { const int st = b / 1024, sb = b % 1024, swz = sb ^ (((sb >> 9) & 1) << 5); R = (st >> 1) * 16 + swz / 64; C = (st & 1) * 32 + (swz % 64) / 2; }
__host__ __device__ __forceinline__ int perm32(int rho) { const int n = rho >> 4, i = rho & 15; return 8 * (i >> 2) + 4 * n + (i & 3); }

struct Unit { int pm, pn, kc; };
struct Gemm { const bf16_t* A; const bf16_t* Bt; int M, N, K, Kc, wv; };

struct StaticOrder {
    int nM, nN, nwg, G, c;
    __host__ __device__ void init(int M, int N, int G_, int c_) { nM = M / BM; nN = N / BM; nwg = nM * nN; G = G_; c = c_; }
    __host__ __device__ bool next(int i, Unit& u) const {
        const long L = (long)i * G + c; if (L >= nwg) return false;
        int wgid = (int)L; { const int q = nwg / NXCD, r = nwg % NXCD, xcd = wgid % NXCD, off = wgid / NXCD; wgid = (xcd < r ? xcd * (q + 1) : r * (q + 1) + (xcd - r) * q) + off; }
        const int nig = WGM * nN, gid = wgid / nig, fm = gid * WGM, gsz = (nM - fm) < WGM ? (nM - fm) : WGM;
        u.pm = fm + ((wgid % nig) % gsz); u.pn = (wgid % nig) / gsz; u.kc = 0; return true;
    }
    __device__ __forceinline__ void a_ready(const Unit&) const {}
    __device__ __forceinline__ void done(const Unit&) const {}
};

__device__ __forceinline__ unsigned cvt_pk_bf16(float lo, float hi) { unsigned r; asm volatile("v_cvt_pk_bf16_f32 %0, %1, %2" : "=v"(r) : "v"(lo), "v"(hi)); return r; }
template <class Epi, class Sched, bool ALIGN_EPI = false, bool SP2 = false, bool SPLITK = false>
__device__ __forceinline__ void gemm_phase(PG8_LAS unsigned char* lds, const Gemm g, const Sched& S, const Epi& E) {
    int tid_l; asm volatile("v_mbcnt_lo_u32_b32 %0, -1, 0\n\tv_mbcnt_hi_u32_b32 %0, -1, %0" : "=v"(tid_l)); const int tid = g.wv * 64 + tid_l, wid = __builtin_amdgcn_readfirstlane(tid >> 6), lane = tid & 63, wr = wid >> 2, wc = wid & 3, fr = lane & 15, fq = lane >> 4;
    const int K = g.K, nt = (SPLITK ? g.Kc : g.K) / BK; const size_t kcb = SPLITK ? (size_t)g.Kc * 2 : 0;
    unsigned voffA[2], voffB[2];
#pragma unroll
    for (int i = 0; i < 2; ++i) { int R, C; stage_rc(tid * 16 + i * 8192, R, C); const int Rb = Epi::PERM ? ((R & ~31) + perm32(R & 31)) : R;
        voffA[i] = (unsigned)(R * K + C) * 2u; voffB[i] = (unsigned)(Rb * K + C) * 2u; }
    const size_t kstep = (size_t)(BK * 2);
    const size_t hstep = (size_t)HALF * K * 2;
    const size_t tstep = 2 * hstep;
    const unsigned ldsw = (unsigned)wid * 1024u;
    const int aoff = lds_byte(wr * 64 + fr, fq * 8), boff = lds_byte(wc * 32 + fr, fq * 8);
#define PG8_SA(b, h) (((b) * 2 + (h)) * HTB)
#define PG8_SB(b, h) ((4 + (b) * 2 + (h)) * HTB)
#define PG8_STAGE(bufoff, gbase, voff) do { _Pragma("unroll") for (int _i = 0; _i < 2; ++_i) \
        __builtin_amdgcn_global_load_lds((const unsigned*)((const char*)(gbase) + (voff)[_i]), (PG8_LAS unsigned*)(lds + (bufoff) + ldsw + _i * 8192), 16, 0, 0); } while (0)
#define PG8_LDA(dst, b, h) do { _Pragma("unroll") for (int m = 0; m < 4; ++m) _Pragma("unroll") for (int k = 0; k < 2; ++k) dst[m][k] = *(const PG8_LAS bf16x8*)(lds + PG8_SA(b, h) + aoff + m * 2048 + k * 1024); } while (0)
#define PG8_LDB(dst, b, h) do { _Pragma("unroll") for (int n = 0; n < 2; ++n) _Pragma("unroll") for (int k = 0; k < 2; ++k) dst[n][k] = *(const PG8_LAS bf16x8*)(lds + PG8_SB(b, h) + boff + n * 2048 + k * 1024); } while (0)
#define PG8_MMA(ai, bj, At, Bt) do { __builtin_amdgcn_s_setprio(1); _Pragma("unroll") for (int m = 0; m < 4; ++m) _Pragma("unroll") for (int n = 0; n < 2; ++n) _Pragma("unroll") for (int k = 0; k < 2; ++k) \
        acc[ai][bj][m][n] = __builtin_amdgcn_mfma_f32_16x16x32_bf16(Bt[n][k], At[m][k], acc[ai][bj][m][n], 0, 0, 0); __builtin_amdgcn_s_setprio(0); } while (0)
#define PG8_WAIT_V(n) asm volatile("s_waitcnt vmcnt(" #n ")" ::: "memory")
#define PG8_WAIT_L(n) asm volatile("s_waitcnt lgkmcnt(" #n ")" ::: "memory")
#define PG8_BAR __builtin_amdgcn_s_barrier()
#define PG8_SCHED __builtin_amdgcn_sched_barrier(0)
    Unit cur, nxt; int ui = 0;
    if (!S.next(0, cur)) return;
    f32x4 acc[2][2][4][2];
#pragma unroll
    for (int a = 0; a < 2; ++a)
#pragma unroll
        for (int b = 0; b < 2; ++b)
#pragma unroll
            for (int m = 0; m < 4; ++m)
#pragma unroll
                for (int n = 0; n < 2; ++n) acc[a][b][m][n] = (f32x4){0.f, 0.f, 0.f, 0.f};
    bf16x8 At[4][2], B0[2][2], B1[2][2];
    const char* cA = (const char*)g.A + (size_t)cur.pm * tstep + (SPLITK ? (size_t)cur.kc * kcb : 0); const char* cB = (const char*)g.Bt + (size_t)cur.pn * tstep + (SPLITK ? (size_t)cur.kc * kcb : 0);
    S.a_ready(cur);
    if constexpr (SP2) {
        PG8_STAGE(PG8_SB(0, 0), cB, voffB); PG8_STAGE(PG8_SB(0, 1), cB + hstep, voffB); PG8_STAGE(PG8_SA(0, 0), cA, voffA); PG8_STAGE(PG8_SA(0, 1), cA + hstep, voffA);
        if (wr == 1) PG8_BAR;
        PG8_WAIT_V(2); PG8_BAR;
        PG8_STAGE(PG8_SB(1, 0), cB + kstep, voffB); PG8_STAGE(PG8_SA(1, 0), cA + kstep, voffA); PG8_STAGE(PG8_SB(1, 1), cB + hstep + kstep, voffB);
        PG8_WAIT_V(6); PG8_BAR;
    } else {
        PG8_STAGE(PG8_SB(0, 0), cB, voffB); PG8_STAGE(PG8_SA(0, 0), cA, voffA); PG8_STAGE(PG8_SB(0, 1), cB + hstep, voffB); PG8_STAGE(PG8_SA(0, 1), cA + hstep, voffA);
        if (wr == 1) PG8_BAR;
        PG8_WAIT_V(4); PG8_BAR;
        PG8_STAGE(PG8_SB(1, 0), cB + kstep, voffB); PG8_STAGE(PG8_SA(1, 0), cA + kstep, voffA); PG8_STAGE(PG8_SB(1, 1), cB + hstep + kstep, voffB);
        PG8_WAIT_V(6); PG8_BAR;
    }
    for (;;) {
        const bool has_next = S.next(ui + 1, nxt);
        const char* nA = has_next ? (const char*)g.A + (size_t)nxt.pm * tstep + (SPLITK ? (size_t)nxt.kc * kcb : 0) : cA; const char* nB = has_next ? (const char*)g.Bt + (size_t)nxt.pn * tstep + (SPLITK ? (size_t)nxt.kc * kcb : 0) : cB;
#pragma unroll 1
        for (int t = 0; t < nt; t += 2) {
            const bool last = (t == nt - 2);
            const char* a1 = cA + (size_t)(t + 1) * kstep;
            const char* a2 = last ? nA : cA + (size_t)(t + 2) * kstep; const char* b2 = last ? nB : cB + (size_t)(t + 2) * kstep;
            const char* a3 = a2 + kstep; const char* b3 = b2 + kstep;
            if (last && has_next) S.a_ready(nxt);
            if constexpr (SP2) {
            PG8_LDB(B0, 0, 0); PG8_LDB(B1, 0, 1); PG8_SCHED; PG8_LDA(At, 0, 0); PG8_STAGE(PG8_SA(1, 1), a1 + hstep, voffA);
            PG8_WAIT_V(8); PG8_WAIT_L(0); PG8_BAR; PG8_MMA(0, 0, At, B0); PG8_MMA(0, 1, At, B1); PG8_BAR; PG8_SCHED;
            PG8_LDA(At, 0, 1); PG8_STAGE(PG8_SB(0, 0), b2, voffB); PG8_STAGE(PG8_SB(0, 1), b2 + hstep, voffB); PG8_STAGE(PG8_SA(0, 0), a2, voffA);
            PG8_WAIT_V(8); PG8_WAIT_L(0); PG8_BAR; PG8_MMA(1, 0, At, B0); PG8_MMA(1, 1, At, B1); PG8_BAR; PG8_SCHED;
            PG8_LDB(B0, 1, 0); PG8_LDB(B1, 1, 1); PG8_SCHED; PG8_LDA(At, 1, 0); PG8_STAGE(PG8_SA(0, 1), a2 + hstep, voffA);
            PG8_WAIT_V(8); PG8_WAIT_L(0); PG8_BAR; PG8_MMA(0, 0, At, B0); PG8_MMA(0, 1, At, B1); PG8_BAR; PG8_SCHED;
            PG8_LDA(At, 1, 1); PG8_STAGE(PG8_SB(1, 0), b3, voffB); PG8_STAGE(PG8_SB(1, 1), b3 + hstep, voffB); PG8_STAGE(PG8_SA(1, 0), a3, voffA);
            PG8_WAIT_V(8); PG8_WAIT_L(0); PG8_BAR; PG8_MMA(1, 0, At, B0); PG8_MMA(1, 1, At, B1); PG8_BAR; PG8_SCHED;
            } else {
            PG8_LDB(B0, 0, 0); PG8_SCHED; PG8_LDA(At, 0, 0); PG8_STAGE(PG8_SA(1, 1), a1 + hstep, voffA);
            PG8_WAIT_L(8); PG8_BAR; PG8_WAIT_L(0); PG8_MMA(0, 0, At, B0); PG8_BAR; PG8_SCHED;
            PG8_LDB(B1, 0, 1); PG8_STAGE(PG8_SB(0, 0), b2, voffB);
            PG8_BAR; PG8_WAIT_L(0); PG8_MMA(0, 1, At, B1); PG8_BAR;
            PG8_LDA(At, 0, 1); PG8_STAGE(PG8_SA(0, 0), a2, voffA);
            PG8_BAR; PG8_WAIT_L(0); PG8_MMA(1, 0, At, B0); PG8_BAR; PG8_SCHED;
            PG8_STAGE(PG8_SB(0, 1), b2 + hstep, voffB);
            PG8_WAIT_V(6); PG8_BAR; PG8_MMA(1, 1, At, B1); PG8_BAR;
            PG8_LDB(B0, 1, 0); PG8_SCHED; PG8_LDA(At, 1, 0); PG8_STAGE(PG8_SA(0, 1), a2 + hstep, voffA);
            PG8_WAIT_L(8); PG8_BAR; PG8_WAIT_L(0); PG8_MMA(0, 0, At, B0); PG8_BAR; PG8_SCHED;
            PG8_LDB(B1, 1, 1); PG8_STAGE(PG8_SB(1, 0), b3, voffB);
            PG8_BAR; PG8_WAIT_L(0); PG8_MMA(0, 1, At, B1); PG8_BAR;
            PG8_LDA(At, 1, 1); PG8_STAGE(PG8_SA(1, 0), a3, voffA);
            PG8_BAR; PG8_WAIT_L(0); PG8_MMA(1, 0, At, B0); PG8_BAR; PG8_SCHED;
            PG8_STAGE(PG8_SB(1, 1), b3 + hstep, voffB);
            PG8_WAIT_V(6); PG8_BAR; PG8_MMA(1, 1, At, B1); PG8_BAR;
            }
        }
        if constexpr (ALIGN_EPI) { if (wr == 0) PG8_BAR; }
        if constexpr (!Epi::AFTER_DRAIN) { E(acc, cur, wr, wc, fr, fq); S.done(cur); }
        if (!has_next) break;
#pragma unroll
        for (int a = 0; a < 2; ++a)
#pragma unroll
            for (int b = 0; b < 2; ++b)
#pragma unroll
                for (int m = 0; m < 4; ++m)
#pragma unroll
                    for (int n = 0; n < 2; ++n) acc[a][b][m][n] = (f32x4){0.f, 0.f, 0.f, 0.f};
        cur = nxt; cA = nA; cB = nB; ++ui;
        if constexpr (ALIGN_EPI) { if (wr == 1) PG8_BAR; }
    }
    PG8_WAIT_V(0);
    if constexpr (!ALIGN_EPI) { if (wr == 0) PG8_BAR; }
    PG8_BAR;
    if constexpr (Epi::AFTER_DRAIN) { E.fused(acc, cur, wr, wc, fr, fq, lds, wid, lane); S.done(cur); }
#undef PG8_SA
#undef PG8_SB
#undef PG8_STAGE
#undef PG8_LDA
#undef PG8_LDB
#undef PG8_MMA
#undef PG8_WAIT_V
#undef PG8_WAIT_L
#undef PG8_BAR
#undef PG8_SCHED
}
}

#define LAS __attribute__((address_space(3)))
typedef unsigned short bf16_t;
typedef float f32x4 __attribute__((ext_vector_type(4)));
typedef float f32x2 __attribute__((ext_vector_type(2)));
typedef float f32x16 __attribute__((ext_vector_type(16)));
typedef unsigned u32x4 __attribute__((ext_vector_type(4)));
typedef unsigned u32x2 __attribute__((ext_vector_type(2)));
typedef short bf16x8 __attribute__((ext_vector_type(8)));

constexpr int DM = 1024, NB = 32, SEQ = 2048, NMETA = 16, LP = 2064, DSQ = 32, PAST = 4096, KSAMP = 4128;
constexpr int MP = NB * LP;
constexpr int MS = NB * DSQ;
constexpr int M1 = MP + MS;
constexpr int M2P = NB * SEQ;
constexpr int M2 = M2P + MS;
constexpr int KPB = 2112;
constexpr int MKP = NB * KPB;
constexpr int MK = MKP + NB * KSAMP;
constexpr int NPROJ = 2304, INCOLS = 2208, RW0 = 416, RWC = 1792, DFF = 2816;
constexpr float EPS = 1e-6f, LNX_EPS = 64e-5f;
constexpr float QSCALE = 0.10206207261596577f * 1.4426950408889634f;

constexpr size_t OFF_YP = 0, OFF_YS = 67108864, OFF_KVP = 68157440, OFF_KRP = 76611584, OFF_WKVP = 78725120, OFF_SHP = 79773696,
                 OFF_KVS = 79831040, OFF_KRS = 79962112, OFF_WKVS = 79994880, OFF_SHS = 81043456;

constexpr size_t MiB = 1u << 20;
constexpr size_t WS_WIN = 0, WS_WQ = 5 * MiB, WS_WKV = 6 * MiB, WS_WL = 7 * MiB, WS_WOUT = 8 * MiB, WS_WGU = 10 * MiB, WS_WDN = 22 * MiB;
constexpr size_t WS_CTL = 28 * MiB;
constexpr size_t WS_XN = 32 * MiB, WS_PROJ = 163 * MiB;
constexpr size_t WS_CALL = 32 * MiB, WS_KRALL = 81 * MiB, WS_QL = 94 * MiB, WS_LIN = 127 * MiB;
constexpr size_t WS_RKV = 460 * MiB, WS_Q = 163 * MiB, WS_E = 262 * MiB, WS_A = 328 * MiB, WS_G = 394 * MiB;
constexpr size_t WS_MIX = 657 * MiB, WS_KN = 262 * MiB, WS_V = 457 * MiB, WS_ATT = 787 * MiB;
constexpr size_t WS_H = 32 * MiB, WS_U = 292 * MiB, WS_ACT = 422 * MiB;
constexpr size_t WS_PB5 = 430 * MiB, WS_PB7 = 300 * MiB;
constexpr size_t WS_NEED = 852 * MiB;
constexpr int LDS_BYTES = 139264;

struct P {
    const float *xp, *xs, *ckv, *ckr, *swkv, *sshift, *meta, *g_mix, *w_in, *g_q, *w_qup, *g_kv, *w_kvup, *g_qn, *g_qr, *g_kn, *g_kr, *g_ao,
                *mu, *w0, *w2, *a0, *a2, *g2, *k_k, *k_a, *r_k, *lnx_g, *lnx_b, *w_out, *g_ffn, *w_gate, *w_up, *w_down;
    float* out; unsigned char* ws;
};
__device__ __forceinline__ int lane_id() { int l; asm volatile("v_mbcnt_lo_u32_b32 %0, -1, 0\n\tv_mbcnt_hi_u32_b32 %0, -1, %0" : "=v"(l)); return l; }

__device__ __forceinline__ float bf2f(unsigned b) { return __uint_as_float(b << 16); }
__device__ __forceinline__ float bflo(unsigned w) { return __uint_as_float(w << 16); }
__device__ __forceinline__ float bfhi(unsigned w) { return __uint_as_float(w & 0xffff0000u); }
__device__ __forceinline__ unsigned pk2(float lo, float hi) { return pg8::cvt_pk_bf16(lo, hi); }
__device__ __forceinline__ float wave_sum(float v) {
#pragma unroll
    for (int o = 1; o < 64; o <<= 1) v += __shfl_xor(v, o);
    return v;
}
__device__ __forceinline__ float red16(float v) { v += __shfl_xor(v, 1); v += __shfl_xor(v, 2); v += __shfl_xor(v, 4); v += __shfl_xor(v, 8); return v; }
__device__ __forceinline__ float sigmoidf_(float x) { return 1.0f / (1.0f + __expf(-x)); }
__device__ __forceinline__ void rope_cs(float pos, int j, float& c, float& s) {
    const float inv = exp2f(-0.8304820237218406f * (float)j);
    const float ang = pos * inv;
    const float k = rintf(ang * 0.15915494309189535f);
    float r = fmaf(-k, 6.2831854820251465f, ang); r = fmaf(-k, -1.7484555e-7f, r);
    s = __sinf(r); c = __cosf(r);
}
__device__ __forceinline__ float row_pos(int row1) { return row1 < MP ? (float)(row1 % LP) : (float)(PAST + ((row1 - MP) & 31)); }

namespace pg8 {
struct EpiStore {
    static constexpr bool PERM = true, AFTER_DRAIN = false;
    bf16_t* O; int ldc;
    __device__ __forceinline__ void operator()(const f32x4 (&acc)[2][2][4][2], const Unit& u, int wr, int wc, int fr, int fq) const {
        const int row0 = u.pm * BM + wr * 64 + fr, col0 = u.pn * BM + wc * 32 + 8 * fq;
#pragma unroll
        for (int ai = 0; ai < 2; ++ai)
#pragma unroll
            for (int m = 0; m < 4; ++m) { bf16_t* rowp = O + (size_t)(row0 + ai * HALF + m * 16) * ldc + col0;
#pragma unroll
                for (int bj = 0; bj < 2; ++bj) { const f32x4 v0 = acc[ai][bj][m][0], v1 = acc[ai][bj][m][1]; u32x4 w;
                    w.x = cvt_pk_bf16(v0[0], v0[1]); w.y = cvt_pk_bf16(v0[2], v0[3]); w.z = cvt_pk_bf16(v1[0], v1[1]); w.w = cvt_pk_bf16(v1[2], v1[3]);
                    *(u32x4*)(rowp + bj * HALF) = w; } }
    }
};
struct EpiKV {
    static constexpr bool PERM = true, AFTER_DRAIN = false;
    bf16_t* KN; bf16_t* V; const float* gk;
    __device__ __forceinline__ void operator()(const f32x4 (&acc)[2][2][4][2], const Unit& u, int wr, int wc, int fr, int fq) const {
        const int slot = u.pn * 4 + wc, h = slot & 7;
        const size_t off0 = (size_t)(u.pm * BM + wr * 64 + fr) * 512 + h * 64 + 8 * fq;
        if (slot >= 8) {
#pragma unroll
            for (int ai = 0; ai < 2; ++ai)
#pragma unroll
                for (int m = 0; m < 4; ++m) { bf16_t* dst = V + off0 + (size_t)(ai * HALF + m * 16) * 512;
#pragma unroll
                    for (int bj = 0; bj < 2; ++bj) { const f32x4 v0 = acc[ai][bj][m][0], v1 = acc[ai][bj][m][1]; u32x4 w;
                        w.x = cvt_pk_bf16(v0[0], v0[1]); w.y = cvt_pk_bf16(v0[2], v0[3]); w.z = cvt_pk_bf16(v1[0], v1[1]); w.w = cvt_pk_bf16(v1[2], v1[3]);
                        *(u32x4*)(dst + 32 * bj) = w; } }
        } else {
#pragma unroll
            for (int ai = 0; ai < 2; ++ai)
#pragma unroll
                for (int m = 0; m < 4; ++m) {
                    float ss = 0.f;
#pragma unroll
                    for (int bj = 0; bj < 2; ++bj)
#pragma unroll
                        for (int n = 0; n < 2; ++n) { const f32x4 x = acc[ai][bj][m][n]; ss += (x[0] * x[0] + x[1] * x[1]) + (x[2] * x[2] + x[3] * x[3]); }
                    ss += __shfl_xor(ss, 16); ss += __shfl_xor(ss, 32);
                    const float rs = rsqrtf(ss * (1.0f / 64.0f) + EPS);
                    bf16_t* dst = KN + off0 + (size_t)(ai * HALF + m * 16) * 512;
#pragma unroll
                    for (int bj = 0; bj < 2; ++bj) { const f32x4 v0 = acc[ai][bj][m][0] * rs, v1 = acc[ai][bj][m][1] * rs; u32x4 w;
                        w.x = cvt_pk_bf16(v0[0], v0[1]); w.y = cvt_pk_bf16(v0[2], v0[3]); w.z = cvt_pk_bf16(v1[0], v1[1]); w.w = cvt_pk_bf16(v1[2], v1[3]);
                        *(u32x4*)(dst + 32 * bj) = w; }
                    asm volatile("" ::: "memory");
                }
        }
    }
};
struct EpiRes {
    static constexpr bool PERM = false, AFTER_DRAIN = false;
    float* O; const float* r0; const float* r1; int split;
    __device__ __forceinline__ void operator()(const f32x4 (&acc)[2][2][4][2], const Unit& u, int wr, int wc, int fr, int fq) const {
        const int col0 = u.pn * BM + wc * 32 + 4 * fq;
#pragma unroll
        for (int ai = 0; ai < 2; ++ai)
#pragma unroll
            for (int m = 0; m < 4; ++m) {
                const int row = u.pm * BM + ai * HALF + wr * 64 + m * 16 + fr;
                const float* rp = (row < split ? r0 + (size_t)row * 1024 : r1 + (size_t)(row - split) * 1024) + col0;
                float* op = O + (size_t)row * 1024 + col0;
#pragma unroll
                for (int bj = 0; bj < 2; ++bj)
#pragma unroll
                    for (int n = 0; n < 2; ++n) { const f32x4 x = *(const f32x4*)(rp + bj * HALF + n * 16); *(f32x4*)(op + bj * HALF + n * 16) = acc[ai][bj][m][n] + x; }
            }
    }
};
struct EpiSwiglu {
    static constexpr bool PERM = true, AFTER_DRAIN = false;
    bf16_t* O;
    __device__ __forceinline__ void operator()(const f32x4 (&acc)[2][2][4][2], const Unit& u, int wr, int wc, int fr, int fq) const {
        const int col0 = u.pn * HALF + wc * 32 + 8 * fq;
#pragma unroll
        for (int ai = 0; ai < 2; ++ai)
#pragma unroll
            for (int m = 0; m < 4; ++m) {
                const int row = u.pm * BM + ai * HALF + wr * 64 + m * 16 + fr;
                float o[8];
#pragma unroll
                for (int n = 0; n < 2; ++n)
#pragma unroll
                    for (int e = 0; e < 4; ++e) { const float g = acc[ai][0][m][n][e], up = acc[ai][1][m][n][e]; o[4 * n + e] = g * sigmoidf_(g) * up; }
                u32x4 w; w.x = cvt_pk_bf16(o[0], o[1]); w.y = cvt_pk_bf16(o[2], o[3]); w.z = cvt_pk_bf16(o[4], o[5]); w.w = cvt_pk_bf16(o[6], o[7]);
                *(u32x4*)(O + (size_t)row * DFF + col0) = w;
            }
    }
};
struct SplitOrder {
    int pm0, npm, nN, nkc, G, c;
    __device__ bool next(int i, Unit& u) const {
        const long L = (long)i * G + (G - 1 - c); if (L >= (long)npm * nN * nkc) return false;
        const int l = (int)L; u.kc = l % nkc; const int t = l / nkc; u.pn = t % nN; u.pm = pm0 + t / nN; return true;
    }
    __device__ __forceinline__ void a_ready(const Unit&) const {}
    __device__ __forceinline__ void done(const Unit&) const {}
};
struct EpiPartial {
    static constexpr bool PERM = false, AFTER_DRAIN = false;
    float* PB; int row0;
    __device__ __forceinline__ void operator()(const f32x4 (&acc)[2][2][4][2], const Unit& u, int wr, int wc, int fr, int fq) const {
        const int col0 = u.pn * BM + wc * 32 + 4 * fq;
        float* base = PB + ((size_t)u.kc * 1024 + (u.pm * BM + wr * 64 + fr - row0)) * 1024 + col0;
#pragma unroll
        for (int ai = 0; ai < 2; ++ai)
#pragma unroll
            for (int m = 0; m < 4; ++m) {
                float* op = base + (size_t)(ai * HALF + m * 16) * 1024;
#pragma unroll
                for (int bj = 0; bj < 2; ++bj)
#pragma unroll
                    for (int n = 0; n < 2; ++n) *(f32x4*)(op + bj * HALF + n * 16) = acc[ai][bj][m][n];
            }
    }
};
}

__device__ __forceinline__ float wsrc(const P& p, int mat, int n, int k) {
    switch (mat) {
    case 0: return n < INCOLS ? p.w_in[(size_t)k * INCOLS + n] : 0.f;
    case 1: return p.w_qup[(size_t)k * 768 + n];
    case 2: { const int pn = n >> 8, bj = (n >> 7) & 1, wc = (n >> 5) & 3, x = n & 31, slot = pn * 4 + wc;
              const int c = (slot & 7) * 128 + (slot < 8 ? 0 : 64) + 32 * bj + x;
              return p.w_kvup[(size_t)k * 1024 + c]; }
    case 3: { if (n < 512) return k < 64 ? p.w2[(size_t)k * 512 + n] : 0.f;
              if (n < 1024) return (k >= 64 && k < 128) ? p.a2[(size_t)(k - 64) * 512 + (n - 512)] : 0.f;
              return k >= 128 ? p.g2[(size_t)(k - 128) * 512 + (n - 1024)] : 0.f; }
    case 4: return p.w_out[(size_t)k * 1024 + n];
    case 5: { const int pn = n >> 8, r = n & 255; return r < 128 ? p.w_gate[(size_t)k * DFF + pn * 128 + r] : p.w_up[(size_t)k * DFF + pn * 128 + r - 128]; }
    default: return p.w_down[(size_t)k * 1024 + n];
    }
}
__device__ __forceinline__ const float* xn_src(const P& p, int row) {
    if (row < MP) { const int b = row / LP, t = row % LP; return t < NMETA ? p.meta + (size_t)t * DM : p.xp + ((size_t)b * SEQ + (t - NMETA)) * DM; }
    return p.xs + (size_t)(row - MP) * DM;
}
__device__ __forceinline__ void phase_e0(const P& p, int wv, LAS unsigned char* lds) {
    LAS float* T = (LAS float*)lds;
    const int tid_l = wv * 64 + lane_id(); const int tid = tid_l, lane = tid & 63, wave = tid >> 6;
    constexpr int NT = 3120;
#define E0_DECODE(T_, mat, K, n0, k0, dst) do { int r_; \
        if ((T_) < 576)       { mat = 0; r_ = (T_);        K = 1024; dst = (bf16_t*)(p.ws + WS_WIN); } \
        else if ((T_) < 624)  { mat = 1; r_ = (T_) - 576;  K = 256;  dst = (bf16_t*)(p.ws + WS_WQ); } \
        else if ((T_) < 656)  { mat = 2; r_ = (T_) - 624;  K = 128;  dst = (bf16_t*)(p.ws + WS_WKV); } \
        else if ((T_) < 752)  { mat = 3; r_ = (T_) - 656;  K = 256;  dst = (bf16_t*)(p.ws + WS_WL); } \
        else if ((T_) < 1008) { mat = 4; r_ = (T_) - 752;  K = 1024; dst = (bf16_t*)(p.ws + WS_WOUT); } \
        else if ((T_) < 2416) { mat = 5; r_ = (T_) - 1008; K = 1024; dst = (bf16_t*)(p.ws + WS_WGU); } \
        else                  { mat = 6; r_ = (T_) - 2416; K = 2816; dst = (bf16_t*)(p.ws + WS_WDN); } \
        const int nkt_ = K / 64; n0 = (r_ / nkt_) * 64; k0 = (r_ % nkt_) * 64; } while (0)
    {
        float v[8];
        int t = blockIdx.x;
        if (t < NT) { int mat, K, n0, k0; bf16_t* dst; E0_DECODE(t, mat, K, n0, k0, dst); (void)dst;
#pragma unroll
            for (int i = 0; i < 8; ++i) v[i] = wsrc(p, mat, n0 + (tid & 63), k0 + (tid >> 6) + 8 * i); }
        for (; t < NT; t += gridDim.x) {
            int mat, K, n0, k0; bf16_t* dst; E0_DECODE(t, mat, K, n0, k0, dst); (void)mat;
#pragma unroll
            for (int i = 0; i < 8; ++i) T[((tid >> 6) + 8 * i) * 65 + (tid & 63)] = v[i];
            __syncthreads();
            const int tn = t + gridDim.x;
            if (tn < NT) { int mat2, K2, n02, k02; bf16_t* dst2; E0_DECODE(tn, mat2, K2, n02, k02, dst2); (void)dst2;
#pragma unroll
                for (int i = 0; i < 8; ++i) v[i] = wsrc(p, mat2, n02 + (tid & 63), k02 + (tid >> 6) + 8 * i); }
#pragma unroll
            for (int i = 0; i < 4; ++i) { const int n = (tid >> 5) + 16 * i, kq = tid & 31;
                *(unsigned*)(dst + (size_t)(n0 + n) * K + k0 + 2 * kq) = pk2(T[(2 * kq) * 65 + n], T[(2 * kq + 1) * 65 + n]); }
            __syncthreads();
        }
    }
#undef E0_DECODE
    bf16_t* XN = (bf16_t*)(p.ws + WS_XN);
    f32x4 g[4];
#pragma unroll
    for (int j = 0; j < 4; ++j) g[j] = *(const f32x4*)(p.g_mix + 4 * lane + 256 * j);
    const int xstride = gridDim.x * 8;
    for (int row = blockIdx.x * 8 + wave; row < M1; row += 2 * xstride) {
        const int rowb = row + xstride; const bool hb = rowb < M1;
        const float* sa = xn_src(p, row); const float* sb = xn_src(p, hb ? rowb : row);
        f32x4 va[4], vb[4]; float ssa = 0.f, ssb = 0.f;
#pragma unroll
        for (int j = 0; j < 4; ++j) { va[j] = *(const f32x4*)(sa + 4 * lane + 256 * j); vb[j] = *(const f32x4*)(sb + 4 * lane + 256 * j); }
#pragma unroll
        for (int j = 0; j < 4; ++j) { ssa += (va[j][0] * va[j][0] + va[j][1] * va[j][1]) + (va[j][2] * va[j][2] + va[j][3] * va[j][3]);
                                      ssb += (vb[j][0] * vb[j][0] + vb[j][1] * vb[j][1]) + (vb[j][2] * vb[j][2] + vb[j][3] * vb[j][3]); }
        const float rsa = rsqrtf(wave_sum(ssa) * (1.0f / DM) + EPS), rsb = rsqrtf(wave_sum(ssb) * (1.0f / DM) + EPS);
#pragma unroll
        for (int j = 0; j < 4; ++j) { const f32x4 o = va[j] * g[j] * rsa; u32x2 w; w.x = pk2(o[0], o[1]); w.y = pk2(o[2], o[3]);
            *(u32x2*)(XN + (size_t)row * DM + 4 * lane + 256 * j) = w; }
        if (hb) {
#pragma unroll
            for (int j = 0; j < 4; ++j) { const f32x4 o = vb[j] * g[j] * rsb; u32x2 w; w.x = pk2(o[0], o[1]); w.y = pk2(o[2], o[3]);
                *(u32x2*)(XN + (size_t)rowb * DM + 4 * lane + 256 * j) = w; } }
    }
}

struct E1Raw { u32x2 q; unsigned c, kr; u32x2 cur[7], prv[7]; };
__device__ __forceinline__ void e1_load(E1Raw& R, const bf16_t* PROJ, int row, int lane) {
    const bf16_t* pr = PROJ + (size_t)row * NPROJ;
    R.q = *(const u32x2*)(pr + 4 * lane); R.c = *(const unsigned*)(pr + 256 + 2 * lane); R.kr = pr[384 + (lane & 31)];
#pragma unroll
    for (int idx = 0; idx < 7; ++idx) R.cur[idx] = *(const u32x2*)(pr + RW0 + 4 * lane + 256 * idx);
    const bool nofirst = row < MP ? (row % LP != 0) : (((row - MP) & 31) != 0);
#pragma unroll
    for (int idx = 0; idx < 7; ++idx) R.prv[idx] = nofirst ? *(const u32x2*)(pr - NPROJ + RW0 + 4 * lane + 256 * idx) : (u32x2){0u, 0u};
}
__device__ __forceinline__ void e1_finish(const P& p, const E1Raw& R, int row, int lane, f32x4 gq, f32x2 gkv, float gkr) {
    bf16_t* QL = (bf16_t*)(p.ws + WS_QL); bf16_t* CALL = (bf16_t*)(p.ws + WS_CALL); bf16_t* KRALL = (bf16_t*)(p.ws + WS_KRALL);
    bf16_t* RKV = (bf16_t*)(p.ws + WS_RKV); bf16_t* LIN = (bf16_t*)(p.ws + WS_LIN);
    const bool isP = row < MP;
        int b, t; if (isP) { b = row / LP; t = row % LP; } else { b = (row - MP) >> 5; t = (row - MP) & 31; }
        const int rowk = isP ? b * KPB + 48 + t : MKP + b * KSAMP + PAST + t;
        const float pos = isP ? (float)t : (float)(PAST + t);
        { const u32x2 raw = R.q; const float x0 = bflo(raw.x), x1 = bfhi(raw.x), x2 = bflo(raw.y), x3 = bfhi(raw.y);
          const float rs = rsqrtf(wave_sum((x0 * x0 + x1 * x1) + (x2 * x2 + x3 * x3)) * (1.0f / 256.0f) + EPS);
          u32x2 w; w.x = pk2(x0 * rs * gq[0], x1 * rs * gq[1]); w.y = pk2(x2 * rs * gq[2], x3 * rs * gq[3]);
          *(u32x2*)(QL + (size_t)row * 256 + 4 * lane) = w; }
        { const unsigned raw = R.c; const float x0 = bflo(raw), x1 = bfhi(raw);
          const float rs = rsqrtf(wave_sum(x0 * x0 + x1 * x1) * (1.0f / 128.0f) + EPS);
          const float c0 = x0 * rs * gkv[0], c1 = x1 * rs * gkv[1];
          float* dst = isP ? p.out + OFF_KVP + ((size_t)b * LP + t) * 128 : p.out + OFF_KVS + ((size_t)b * DSQ + t) * 128;
          *(f32x2*)(dst + 2 * lane) = (f32x2){c0, c1};
          *(unsigned*)(CALL + (size_t)rowk * 128 + 2 * lane) = pk2(c0, c1); }
        { const int j = lane & 31; const float x = bf2f(R.kr);
          float ss = x * x; ss += __shfl_xor(ss, 1); ss += __shfl_xor(ss, 2); ss += __shfl_xor(ss, 4); ss += __shfl_xor(ss, 8); ss += __shfl_xor(ss, 16);
          const float y = x * rsqrtf(ss * (1.0f / 32.0f) + EPS) * gkr;
          const float pa = __shfl_xor(y, 16);
          float c, s; rope_cs(pos, j & 15, c, s);
          const float o = j < 16 ? y * c - pa * s : pa * s + y * c;
          if (lane < 32) {
              float* dst = isP ? p.out + OFF_KRP + ((size_t)b * LP + t) * 32 : p.out + OFF_KRS + ((size_t)b * DSQ + t) * 32;
              dst[j] = o; KRALL[(size_t)rowk * 32 + j] = (bf16_t)(pk2(o, 0.f) & 0xffffu);
          } }
        const bool first = (t == 0), last = isP ? (t == LP - 1) : (t == DSQ - 1);
        float* shdst = isP ? p.out + OFF_SHP + (size_t)b * RWC : p.out + OFF_SHS + (size_t)b * RWC;
#pragma unroll
        for (int idx = 0; idx < 7; ++idx) {
            const int c = 4 * lane + 256 * idx;
            const u32x2 raw = R.cur[idx];
            const f32x4 cur = {bflo(raw.x), bfhi(raw.x), bflo(raw.y), bfhi(raw.y)};
            f32x4 prev;
            if (first) { if (isP) prev = (f32x4){0.f, 0.f, 0.f, 0.f}; else prev = *(const f32x4*)(p.sshift + (size_t)b * RWC + c); }
            else { const u32x2 rp = R.prv[idx]; prev = (f32x4){bflo(rp.x), bfhi(rp.x), bflo(rp.y), bfhi(rp.y)}; }
            const f32x4 mu = *(const f32x4*)(p.mu + c);
            f32x4 xm = cur + (prev - cur) * mu;
            if (last) *(f32x4*)(shdst + c) = cur;
            if (idx < 6) { u32x2 w; w.x = pk2(xm[0], xm[1]); w.y = pk2(xm[2], xm[3]); *(u32x2*)(RKV + (size_t)row * 1536 + c) = w; }
            else {
                const int lc = 4 * lane;
                if (lc < 64) {
#pragma unroll
                    for (int e = 0; e < 4; ++e) xm[e] = tanhf(xm[e]); }
                else if (lc >= 128) {
#pragma unroll
                    for (int e = 0; e < 4; ++e) xm[e] = sigmoidf_(xm[e]); }
                u32x2 w; w.x = pk2(xm[0], xm[1]); w.y = pk2(xm[2], xm[3]); *(u32x2*)(LIN + (size_t)row * 256 + lc) = w;
            }
        }
    }
__device__ __forceinline__ void phase_e1(const P& p, int wv) {
    const int tid_l = wv * 64 + lane_id(); const int tid = tid_l, lane = tid & 63, wave = tid >> 6;
    const bf16_t* PROJ = (const bf16_t*)(p.ws + WS_PROJ);
    bf16_t* QL = (bf16_t*)(p.ws + WS_QL); bf16_t* CALL = (bf16_t*)(p.ws + WS_CALL); bf16_t* KRALL = (bf16_t*)(p.ws + WS_KRALL);
    bf16_t* RKV = (bf16_t*)(p.ws + WS_RKV); bf16_t* LIN = (bf16_t*)(p.ws + WS_LIN);
    {
        const size_t gt = (size_t)blockIdx.x * 512 + tid, gs = (size_t)gridDim.x * 512;
        {
            constexpr size_t NV1 = (size_t)NB * PAST * 128 / 4, NV2 = (size_t)NB * PAST * 32 / 4;
            for (size_t e = gt; e < NV1; e += 4 * gs) {
                f32x4 v[4];
#pragma unroll
                for (int u = 0; u < 4; ++u) { const size_t ee = e + u * gs; v[u] = ee < NV1 ? *(const f32x4*)(p.ckv + ee * 4) : (f32x4){0.f, 0.f, 0.f, 0.f}; }
#pragma unroll
                for (int u = 0; u < 4; ++u) { const size_t ee = e + u * gs; if (ee < NV1) { const size_t idx = ee * 4; const int b = (int)(idx / ((size_t)PAST * 128)); const size_t rem = idx - (size_t)b * PAST * 128;
                    u32x2 w; w.x = pk2(v[u][0], v[u][1]); w.y = pk2(v[u][2], v[u][3]); *(u32x2*)(CALL + ((size_t)MKP + (size_t)b * KSAMP) * 128 + rem) = w; } }
            }
            for (size_t e = gt; e < NV2; e += 4 * gs) {
                f32x4 v[4];
#pragma unroll
                for (int u = 0; u < 4; ++u) { const size_t ee = e + u * gs; v[u] = ee < NV2 ? *(const f32x4*)(p.ckr + ee * 4) : (f32x4){0.f, 0.f, 0.f, 0.f}; }
#pragma unroll
                for (int u = 0; u < 4; ++u) { const size_t ee = e + u * gs; if (ee < NV2) { const size_t idx = ee * 4; const int b = (int)(idx / ((size_t)PAST * 32)); const size_t rem = idx - (size_t)b * PAST * 32;
                    u32x2 w; w.x = pk2(v[u][0], v[u][1]); w.y = pk2(v[u][2], v[u][3]); *(u32x2*)(KRALL + ((size_t)MKP + (size_t)b * KSAMP) * 32 + rem) = w; } }
            }
        }
        for (size_t e = gt; e < (size_t)NB * 48 * 128 / 4; e += gs) {
            const size_t idx = e * 4; const int b = (int)(idx / (48 * 128)); const size_t rem = idx - (size_t)b * 48 * 128;
            *(u32x2*)(CALL + (size_t)b * KPB * 128 + rem) = (u32x2){0u, 0u};
        }
        for (size_t e = gt; e < (size_t)NB * 48 * 32 / 4; e += gs) {
            const size_t idx = e * 4; const int b = (int)(idx / (48 * 32)); const size_t rem = idx - (size_t)b * 48 * 32;
            *(u32x2*)(KRALL + (size_t)b * KPB * 32 + rem) = (u32x2){0u, 0u};
        }
    }
    const f32x4 gq = *(const f32x4*)(p.g_q + 4 * lane);
    const f32x2 gkv = *(const f32x2*)(p.g_kv + 2 * lane);
    const float gkr = p.g_kr[lane & 31];
    const int e1stride = gridDim.x * 8;
    for (int row = blockIdx.x * 8 + wave; row < M1; row += 2 * e1stride) {
        const int rowb = row + e1stride; const bool hb = rowb < M1;
        E1Raw ra, rb;
        e1_load(ra, PROJ, row, lane); e1_load(rb, PROJ, hb ? rowb : row, lane);
        e1_finish(p, ra, row, lane, gq, gkv, gkr);
        if (hb) e1_finish(p, rb, rowb, lane, gq, gkv, gkr);
    }

}

template <int CTRL> __device__ __forceinline__ float dppf(float v) { return __uint_as_float(__builtin_amdgcn_update_dpp(0u, __float_as_uint(v), CTRL, 0xF, 0xF, true)); }
__device__ __forceinline__ float red8(float v) { v += dppf<0xB1>(v); v += dppf<0x4E>(v); v += dppf<0x141>(v); return v; }
__device__ __forceinline__ float red16d(float v) { v += dppf<0xB1>(v); v += dppf<0x4E>(v); v += dppf<0x141>(v); v += dppf<0x140>(v); return v; }

struct ScanPre { u32x2 r, k, v, lw, la, g; };
struct ScanKeep { f32x4 v; float bon; u32x2 g; };
struct ScanConst { f32x4 kk, ka, rk, lg, lb, w0, a0; };
constexpr int SC_BUF = 12416;

__device__ __forceinline__ void scan_load(ScanPre& q, const bf16_t* RKV, const bf16_t* LO, size_t row, int hc) {
    q.r = *(const u32x2*)(RKV + row * 1536 + hc); q.k = *(const u32x2*)(RKV + row * 1536 + 512 + hc); q.v = *(const u32x2*)(RKV + row * 1536 + 1024 + hc);
    q.lw = *(const u32x2*)(LO + row * 1536 + hc); q.la = *(const u32x2*)(LO + row * 1536 + 512 + hc); q.g = *(const u32x2*)(LO + row * 1536 + 1024 + hc);
}
__device__ __forceinline__ void scan_stage_a(const ScanPre& q, const ScanConst& C, LAS float* buf, int tt, int dq, ScanKeep& keep) {
    const f32x4 r = {bflo(q.r.x), bfhi(q.r.x), bflo(q.r.y), bfhi(q.r.y)}, k = {bflo(q.k.x), bfhi(q.k.x), bflo(q.k.y), bfhi(q.k.y)}, v = {bflo(q.v.x), bfhi(q.v.x), bflo(q.v.y), bfhi(q.v.y)};
    const f32x4 lw = (f32x4){bflo(q.lw.x), bfhi(q.lw.x), bflo(q.lw.y), bfhi(q.lw.y)} + C.w0, la = (f32x4){bflo(q.la.x), bfhi(q.la.x), bflo(q.la.y), bfhi(q.la.y)} + C.a0;
    f32x4 w, a;
#pragma unroll
    for (int c = 0; c < 4; ++c) { w[c] = __expf(-0.6065306597126334f * sigmoidf_(lw[c])); a[c] = sigmoidf_(la[c]); }
    const f32x4 kkr = k * C.kk;
    const float ss = red16d((kkr[0] * kkr[0] + kkr[1] * kkr[1]) + (kkr[2] * kkr[2] + kkr[3] * kkr[3]));
    const float inv = 1.0f / fmaxf(sqrtf(ss), 1e-12f);
    const f32x4 kk = kkr * inv;
    const f32x4 keff = k * (1.0f + (a - 1.0f) * C.ka);
    const f32x4 bb = a * kk, wr = w * r;
    const f32x4 t1 = bb * r, t2 = keff * r, t3 = t2 * C.rk;
    const float br = red16d((t1[0] + t1[1]) + (t1[2] + t1[3])), kr = red16d((t2[0] + t2[1]) + (t2[2] + t2[3])), bon = red16d((t3[0] + t3[1]) + (t3[2] + t3[3]));
    const int o = tt * 64 + 4 * dq;
    *(LAS f32x4*)(buf + o) = w; *(LAS f32x4*)(buf + 2048 + o) = bb; *(LAS f32x4*)(buf + 4096 + o) = keff; *(LAS f32x4*)(buf + 6144 + o) = kk; *(LAS f32x4*)(buf + 8192 + o) = wr; *(LAS f32x4*)(buf + 10240 + o) = v;
    if (dq == 0) *(LAS f32x4*)(buf + 12288 + tt * 4) = (f32x4){br, kr, bon, 0.f};
    keep.v = v; keep.bon = bon; keep.g = q.g;
}

struct ScanVec { f32x4 k0, k1, q0, q1, w0, w1, b0, b1, e0, e1, sc; float vi0, vi1; };
#define SV_DSR128(dst, addr, off) asm volatile("ds_read_b128 %0, %1 offset:" #off : "=v"(dst) : "v"(addr))
#define SV_DSR32(dst, addr, off) asm volatile("ds_read_b32 %0, %1 offset:" #off : "=v"(dst) : "v"(addr))
__device__ __forceinline__ void sv_issue(ScanVec& s, unsigned a_vec, unsigned a_sc, unsigned a_v) {
    SV_DSR128(s.k0, a_vec, 24576); SV_DSR128(s.k1, a_vec, 24592); SV_DSR128(s.q0, a_vec, 32768); SV_DSR128(s.q1, a_vec, 32784);
    SV_DSR128(s.sc, a_sc, 49152); SV_DSR32(s.vi0, a_v, 40960); SV_DSR32(s.vi1, a_v, 41088);
    SV_DSR128(s.w0, a_vec, 0); SV_DSR128(s.w1, a_vec, 16); SV_DSR128(s.b0, a_vec, 8192); SV_DSR128(s.b1, a_vec, 8208);
    SV_DSR128(s.e0, a_vec, 16384); SV_DSR128(s.e1, a_vec, 16400);
}
__device__ __forceinline__ void sv_wait(ScanVec& s) {
    asm volatile("s_waitcnt lgkmcnt(0)" : "+v"(s.k0), "+v"(s.k1), "+v"(s.q0), "+v"(s.q1), "+v"(s.w0), "+v"(s.w1), "+v"(s.b0), "+v"(s.b1), "+v"(s.e0), "+v"(s.e1), "+v"(s.sc), "+v"(s.vi0), "+v"(s.vi1));
}
__device__ __forceinline__ f32x2 lo2(f32x4 v) { return __builtin_shufflevector(v, v, 0, 1); }
__device__ __forceinline__ f32x2 hi2(f32x4 v) { return __builtin_shufflevector(v, v, 2, 3); }
__device__ __forceinline__ f32x2 fma2(f32x2 a, f32x2 b, f32x2 c) { return __builtin_elementwise_fma(a, b, c); }
__device__ __forceinline__ float sv_row(f32x2 (&S)[4], const ScanVec& s, float vi) {
    f32x2 a1 = S[0] * lo2(s.k0), a2 = S[0] * lo2(s.q0);
    a1 = fma2(S[1], hi2(s.k0), a1); a2 = fma2(S[1], hi2(s.q0), a2);
    a1 = fma2(S[2], lo2(s.k1), a1); a2 = fma2(S[2], lo2(s.q1), a2);
    a1 = fma2(S[3], hi2(s.k1), a1); a2 = fma2(S[3], hi2(s.q1), a2);
    const float d1 = red8(a1.x + a1.y), d2 = red8(a2.x + a2.y);
    const float sa = -d1;
    const float y = d2 + sa * s.sc[0] + vi * s.sc[1];
    const f32x2 sa2 = {sa, sa}, vi2 = {vi, vi};
    S[0] = fma2(S[0], lo2(s.w0), fma2(sa2, lo2(s.b0), vi2 * lo2(s.e0)));
    S[1] = fma2(S[1], hi2(s.w0), fma2(sa2, hi2(s.b0), vi2 * hi2(s.e0)));
    S[2] = fma2(S[2], lo2(s.w1), fma2(sa2, lo2(s.b1), vi2 * lo2(s.e1)));
    S[3] = fma2(S[3], hi2(s.w1), fma2(sa2, hi2(s.b1), vi2 * hi2(s.e1)));
    return y;
}
__device__ __forceinline__ void sv_step(f32x2 (&S0)[4], f32x2 (&S1)[4], const ScanVec& s, LAS float* Yc, int t, int i2, int j) {
    const float y0 = sv_row(S0, s, s.vi0), y1 = sv_row(S1, s, s.vi1);
    if (j == 0) { Yc[t * 64 + i2] = y0; Yc[t * 64 + 32 + i2] = y1; }
}
__device__ __forceinline__ void scan_stage_c(const ScanConst& C, const LAS float* buf, const LAS float* Yc, int tl, int dq, bool valid, u32x2 graw, bf16_t* dst) {
    const f32x4 y = *(const LAS f32x4*)(Yc + tl * 64 + 4 * dq);
    const float mean = red16d((y[0] + y[1]) + (y[2] + y[3])) * (1.0f / 64.0f);
    const f32x4 d = y - mean;
    const float var = red16d((d[0] * d[0] + d[1] * d[1]) + (d[2] * d[2] + d[3] * d[3])) * (1.0f / 64.0f);
    const f32x4 v = *(const LAS f32x4*)(buf + 10240 + tl * 64 + 4 * dq);
    const float bon = buf[12288 + tl * 4 + 2];
    if (valid) {
        const float rstd = rsqrtf(var + LNX_EPS);
        const f32x4 g = {bflo(graw.x), bfhi(graw.x), bflo(graw.y), bfhi(graw.y)};
        const f32x4 o = (d * rstd * C.lg + C.lb + v * bon) * g;
        u32x2 w; w.x = pk2(o[0], o[1]); w.y = pk2(o[2], o[3]);
        *(u32x2*)dst = w;
    }
}

__device__ __forceinline__ void scan_unit(const P& p, int wv, LAS unsigned char* lds, int row1_base, int nsteps, const float* s0, float* s_out, int first_out, int row2_base, int h) {
    const int tid_l = wv * 64 + lane_id(); const int tid = tid_l;
    const bool is_rec = tid < 256;
    LAS float* BUF = (LAS float*)lds;
    LAS float* Y = BUF + 2 * SC_BUF;
    const bf16_t* RKV = (const bf16_t*)(p.ws + WS_RKV); const bf16_t* LO = (const bf16_t*)(p.ws + WS_E);
    bf16_t* MIX = (bf16_t*)(p.ws + WS_MIX);
    const int nch = (nsteps + 31) >> 5;
    __syncthreads();
    if (is_rec) {
        const int i2 = tid >> 3, j = tid & 7;
        f32x2 S0[4], S1[4];
        if (s0) { const f32x4 a = *(const f32x4*)(s0 + i2 * 64 + 8 * j), b = *(const f32x4*)(s0 + i2 * 64 + 8 * j + 4), c = *(const f32x4*)(s0 + (i2 + 32) * 64 + 8 * j), d = *(const f32x4*)(s0 + (i2 + 32) * 64 + 8 * j + 4);
            S0[0] = lo2(a); S0[1] = hi2(a); S0[2] = lo2(b); S0[3] = hi2(b); S1[0] = lo2(c); S1[1] = hi2(c); S1[2] = lo2(d); S1[3] = hi2(d); }
        else {
#pragma unroll
            for (int cc = 0; cc < 4; ++cc) { S0[cc] = (f32x2){0.f, 0.f}; S1[cc] = (f32x2){0.f, 0.f}; } }
        const unsigned lbase = (unsigned)(unsigned long long)BUF;
        __syncthreads();
        __builtin_amdgcn_s_setprio(3);
        for (int c = 0; c < nch; ++c) {
            const int c0 = c * 32, T = (nsteps - c0) < 32 ? (nsteps - c0) : 32;
            LAS float* Yc = Y + (c & 1) * 2048;
            const unsigned bb = lbase + (unsigned)(c & 1) * (SC_BUF * 4u);
            unsigned a_vec = bb + 32u * j, a_sc = bb, a_v = bb + 4u * i2;
            ScanVec va, vb;
            sv_issue(va, a_vec, a_sc, a_v); sv_wait(va);
            for (int t = 0; t < T; t += 2) {
                sv_issue(vb, a_vec + 256u, a_sc + 16u, a_v + 256u);
                sv_step(S0, S1, va, Yc, t, i2, j);
                sv_wait(vb);
                const unsigned adv = (t + 2 < T) ? 2u : 1u;
                a_vec += 256u * adv; a_sc += 16u * adv; a_v += 256u * adv;
                sv_issue(va, a_vec, a_sc, a_v);
                sv_step(S0, S1, vb, Yc, t + 1, i2, j);
                sv_wait(va);
            }
            __syncthreads();
        }
        __builtin_amdgcn_s_setprio(0);
        float* so = s_out + i2 * 64 + 8 * j;
        *(f32x4*)so = (f32x4){S0[0].x, S0[0].y, S0[1].x, S0[1].y}; *(f32x4*)(so + 4) = (f32x4){S0[2].x, S0[2].y, S0[3].x, S0[3].y};
        *(f32x4*)(so + 2048) = (f32x4){S1[0].x, S1[0].y, S1[1].x, S1[1].y}; *(f32x4*)(so + 2052) = (f32x4){S1[2].x, S1[2].y, S1[3].x, S1[3].y};
    } else {
        const int ptid = tid - 256, tt = ptid >> 4, dq = ptid & 15, hc = h * 64 + 4 * dq;
        ScanConst C;
        C.kk = *(const f32x4*)(p.k_k + hc); C.ka = *(const f32x4*)(p.k_a + hc); C.rk = *(const f32x4*)(p.r_k + hc);
        C.lg = *(const f32x4*)(p.lnx_g + hc); C.lb = *(const f32x4*)(p.lnx_b + hc); C.w0 = *(const f32x4*)(p.w0 + hc); C.a0 = *(const f32x4*)(p.a0 + hc);
        ScanPre pa, pb; ScanKeep kdummy;
        pa.r = pa.k = pa.v = pa.lw = pa.la = pa.g = (u32x2){0u, 0u}; pb = pa;
        if (tt < nsteps) scan_load(pa, RKV, LO, (size_t)(row1_base + tt), hc);
        if (tt + 16 < nsteps) scan_load(pb, RKV, LO, (size_t)(row1_base + tt + 16), hc);
        if (tt < nsteps) scan_stage_a(pa, C, BUF, tt, dq, kdummy);
        if (tt + 16 < nsteps) scan_stage_a(pb, C, BUF, tt + 16, dq, kdummy);
        if (32 + tt < nsteps) scan_load(pa, RKV, LO, (size_t)(row1_base + 32 + tt), hc);
        if (48 + tt < nsteps) scan_load(pb, RKV, LO, (size_t)(row1_base + 48 + tt), hc);
        __syncthreads();
        for (int c = 0; c < nch; ++c) {
            const int c0 = c * 32;
            if (c >= 1) {
                const int pc0 = c0 - 32; const LAS float* bufp = BUF + ((c - 1) & 1) * SC_BUF; const LAS float* Yp = Y + ((c - 1) & 1) * 2048;
                const int tok0 = pc0 + tt, tok1 = pc0 + tt + 16;
                const bool v0 = tok0 >= first_out, v1 = tok1 >= first_out;
                u32x2 g0 = {0u, 0u}, g1 = {0u, 0u};
                if (v0) g0 = *(const u32x2*)(LO + (size_t)(row1_base + tok0) * 1536 + 1024 + hc);
                if (v1) g1 = *(const u32x2*)(LO + (size_t)(row1_base + tok1) * 1536 + 1024 + hc);
                scan_stage_c(C, bufp, Yp, tt, dq, v0, g0, MIX + (size_t)(row2_base + tok0 - first_out) * 1024 + 512 + hc);
                scan_stage_c(C, bufp, Yp, tt + 16, dq, v1, g1, MIX + (size_t)(row2_base + tok1 - first_out) * 1024 + 512 + hc);
            }
            if (c0 + 32 + tt < nsteps) scan_stage_a(pa, C, BUF + ((c + 1) & 1) * SC_BUF, tt, dq, kdummy);
            if (c0 + 48 + tt < nsteps) scan_stage_a(pb, C, BUF + ((c + 1) & 1) * SC_BUF, tt + 16, dq, kdummy);
            if (c0 + 64 + tt < nsteps) scan_load(pa, RKV, LO, (size_t)(row1_base + c0 + 64 + tt), hc);
            if (c0 + 80 + tt < nsteps) scan_load(pb, RKV, LO, (size_t)(row1_base + c0 + 80 + tt), hc);
            __syncthreads();
        }
        {
            const int c = nch - 1, pc0 = c * 32, T = nsteps - pc0; const LAS float* bufp = BUF + (c & 1) * SC_BUF; const LAS float* Yp = Y + (c & 1) * 2048;
            const int tok0 = pc0 + tt, tok1 = pc0 + tt + 16;
            const bool v0 = tt < T && tok0 >= first_out, v1 = tt + 16 < T && tok1 >= first_out;
            u32x2 g0 = {0u, 0u}, g1 = {0u, 0u};
            if (v0) g0 = *(const u32x2*)(LO + (size_t)(row1_base + tok0) * 1536 + 1024 + hc);
            if (v1) g1 = *(const u32x2*)(LO + (size_t)(row1_base + tok1) * 1536 + 1024 + hc);
            scan_stage_c(C, bufp, Yp, tt, dq, v0, g0, MIX + (size_t)(row2_base + tok0 - first_out) * 1024 + 512 + hc);
            scan_stage_c(C, bufp, Yp, tt + 16, dq, v1, g1, MIX + (size_t)(row2_base + tok1 - first_out) * 1024 + 512 + hc);
        }
    }
}
__device__ __forceinline__ void phase_scan(const P& p, int wv, LAS unsigned char* lds) {
    for (int u = blockIdx.x; u < 512; u += gridDim.x) {
        const int uu = u & 255, b = uu >> 3, h = uu & 7;
        if (u < 256) scan_unit(p, wv, lds, b * LP, LP, nullptr, p.out + OFF_WKVP + (size_t)uu * 4096, NMETA, b * SEQ, h);
        else scan_unit(p, wv, lds, MP + b * DSQ, DSQ, p.swkv + (size_t)uu * 4096, p.out + OFF_WKVS + (size_t)uu * 4096, 0, M2P + b * DSQ, h);
    }
}

__device__ __forceinline__ int crow(int r, int hi) { return (r & 3) + 8 * (r >> 2) + 4 * hi; }
constexpr float ATT_THR = 12.0f;
__device__ __forceinline__ float xhalf_max(float v) { const auto rr = __builtin_amdgcn_permlane32_swap(__float_as_uint(v), __float_as_uint(v), false, false); return fmaxf(__uint_as_float(rr[0]), __uint_as_float(rr[1])); }
__device__ __forceinline__ float xhalf_sum(float v) { const auto rr = __builtin_amdgcn_permlane32_swap(__float_as_uint(v), __float_as_uint(v), false, false); return __uint_as_float(rr[0]) + __uint_as_float(rr[1]); }
__device__ __forceinline__ void att_blk(const LAS unsigned char* Kc, const LAS unsigned char* Vimg, const bf16x8 (&qf)[6], float& m, float& l, f32x16 (&O)[2], int lane, int nmask) {
    const int q = lane & 31, hi = lane >> 5;
    f32x16 s; const float nm = -m;
#pragma unroll
    for (int r = 0; r < 16; ++r) s[r] = nm;
#pragma unroll
    for (int i = 0; i < 6; ++i) { const bf16x8 kf = *(const LAS bf16x8*)(Kc + q * 208 + (16 * i + 8 * hi) * 2); s = __builtin_amdgcn_mfma_f32_32x32x16_bf16(kf, qf[i], s, 0, 0, 0); }
    if (nmask > 0) {
#pragma unroll
        for (int r = 0; r < 16; ++r) if (crow(r, hi) < nmask) s[r] = -1e30f; }
    float mx = fmaxf(s[0], s[1]);
#pragma unroll
    for (int r = 2; r < 16; r += 2) mx = fmaxf(fmaxf(mx, s[r]), s[r + 1]);
    if (__builtin_amdgcn_ballot_w64(mx > ATT_THR) != 0ull) {
        const float delta = fmaxf(xhalf_max(mx), 0.f), alpha = __builtin_amdgcn_exp2f(-delta);
        m += delta; l *= alpha;
#pragma unroll
        for (int r = 0; r < 16; ++r) { O[0][r] *= alpha; O[1][r] *= alpha; s[r] -= delta; }
    }
    float rsum = 0.f;
#pragma unroll
    for (int r = 0; r < 16; ++r) { s[r] = __builtin_amdgcn_exp2f(s[r]); rsum += s[r]; }
    l += rsum;
    bf16x8 pb[2];
#pragma unroll
    for (int i = 0; i < 2; ++i) { u32x4 w; w.x = pk2(s[8 * i + 0], s[8 * i + 1]); w.y = pk2(s[8 * i + 2], s[8 * i + 3]); w.z = pk2(s[8 * i + 4], s[8 * i + 5]); w.w = pk2(s[8 * i + 6], s[8 * i + 7]);
        pb[i] = __builtin_bit_cast(bf16x8, w); }
    typedef short v4i16_t __attribute__((ext_vector_type(4)));
    const int li = lane & 15, g16 = lane >> 4;
    const LAS unsigned char* vb = Vimg + (4 * hi + (li >> 2)) * 192 + (16 * (g16 & 1) + 4 * (li & 3)) * 2;
#pragma unroll
    for (int db = 0; db < 2; ++db)
#pragma unroll
        for (int i = 0; i < 2; ++i) {
            const v4i16_t lo = __builtin_amdgcn_ds_read_tr16_b64_v4i16((LAS v4i16_t*)(vb + (16 * i) * 192 + 64 * db));
            const v4i16_t hh = __builtin_amdgcn_ds_read_tr16_b64_v4i16((LAS v4i16_t*)(vb + (16 * i + 8) * 192 + 64 * db));
            const bf16x8 vf = {lo[0], lo[1], lo[2], lo[3], hh[0], hh[1], hh[2], hh[3]};
            O[db] = __builtin_amdgcn_mfma_f32_32x32x16_bf16(vf, pb[i], O[db], 0, 0, 0); }
}
__device__ __forceinline__ void att_tile64(const LAS unsigned char* Kc, const LAS unsigned char* Vimg, const bf16x8 (&qf)[6], float& m, float& l, f32x16 (&O)[2], int lane) {
    const int q = lane & 31, hi = lane >> 5;
    f32x16 s0, s1; const float nm = -m;
#pragma unroll
    for (int r = 0; r < 16; ++r) { s0[r] = nm; s1[r] = nm; }
#pragma unroll
    for (int i = 0; i < 6; ++i) {
        const bf16x8 k0 = *(const LAS bf16x8*)(Kc + q * 208 + (16 * i + 8 * hi) * 2), k1 = *(const LAS bf16x8*)(Kc + (32 + q) * 208 + (16 * i + 8 * hi) * 2);
        s0 = __builtin_amdgcn_mfma_f32_32x32x16_bf16(k0, qf[i], s0, 0, 0, 0); s1 = __builtin_amdgcn_mfma_f32_32x32x16_bf16(k1, qf[i], s1, 0, 0, 0); }
    float mx = fmaxf(s0[0], s1[0]);
#pragma unroll
    for (int r = 1; r < 16; ++r) mx = fmaxf(fmaxf(mx, s0[r]), s1[r]);
    if (__builtin_amdgcn_ballot_w64(mx > ATT_THR) != 0ull) {
        const float delta = fmaxf(xhalf_max(mx), 0.f), alpha = __builtin_amdgcn_exp2f(-delta);
        m += delta; l *= alpha;
#pragma unroll
        for (int r = 0; r < 16; ++r) { O[0][r] *= alpha; O[1][r] *= alpha; s0[r] -= delta; s1[r] -= delta; }
    }
    float rs0 = 0.f, rs1 = 0.f;
#pragma unroll
    for (int r = 0; r < 16; ++r) { s0[r] = __builtin_amdgcn_exp2f(s0[r]); s1[r] = __builtin_amdgcn_exp2f(s1[r]); rs0 += s0[r]; rs1 += s1[r]; }
    l += rs0 + rs1;
    bf16x8 pb[4];
#pragma unroll
    for (int i = 0; i < 2; ++i) { u32x4 w; w.x = pk2(s0[8 * i + 0], s0[8 * i + 1]); w.y = pk2(s0[8 * i + 2], s0[8 * i + 3]); w.z = pk2(s0[8 * i + 4], s0[8 * i + 5]); w.w = pk2(s0[8 * i + 6], s0[8 * i + 7]);
        pb[i] = __builtin_bit_cast(bf16x8, w);
        u32x4 x; x.x = pk2(s1[8 * i + 0], s1[8 * i + 1]); x.y = pk2(s1[8 * i + 2], s1[8 * i + 3]); x.z = pk2(s1[8 * i + 4], s1[8 * i + 5]); x.w = pk2(s1[8 * i + 6], s1[8 * i + 7]);
        pb[2 + i] = __builtin_bit_cast(bf16x8, x); }
    typedef short v4i16_t __attribute__((ext_vector_type(4)));
    const int li = lane & 15, g16 = lane >> 4;
    const LAS unsigned char* vb = Vimg + (4 * hi + (li >> 2)) * 192 + (16 * (g16 & 1) + 4 * (li & 3)) * 2;
#pragma unroll
    for (int i = 0; i < 4; ++i)
#pragma unroll
        for (int db = 0; db < 2; ++db) {
            const v4i16_t lo = __builtin_amdgcn_ds_read_tr16_b64_v4i16((LAS v4i16_t*)(vb + (16 * i) * 192 + 64 * db));
            const v4i16_t hh = __builtin_amdgcn_ds_read_tr16_b64_v4i16((LAS v4i16_t*)(vb + (16 * i + 8) * 192 + 64 * db));
            const bf16x8 vf = {lo[0], lo[1], lo[2], lo[3], hh[0], hh[1], hh[2], hh[3]};
            O[db] = __builtin_amdgcn_mfma_f32_32x32x16_bf16(vf, pb[i], O[db], 0, 0, 0); }
}
__device__ __forceinline__ int kpos(int key) { return (key & ~12) | ((key & 4) << 1) | ((key & 8) >> 1); }

__device__ __forceinline__ void load_q(bf16x8 (&qf)[6], const bf16_t* qrow, float pos, const float* gn, const float* gr, const float* gkn, int hi) {
    float x[6][8];
#pragma unroll
    for (int i = 0; i < 6; ++i) { const u32x4 raw = *(const u32x4*)(qrow + 16 * i + 8 * hi);
        x[i][0] = bflo(raw.x); x[i][1] = bfhi(raw.x); x[i][2] = bflo(raw.y); x[i][3] = bfhi(raw.y); x[i][4] = bflo(raw.z); x[i][5] = bfhi(raw.z); x[i][6] = bflo(raw.w); x[i][7] = bfhi(raw.w); }
    float ssn = 0.f, ssr = 0.f;
#pragma unroll
    for (int i = 0; i < 4; ++i)
#pragma unroll
        for (int e = 0; e < 8; ++e) ssn += x[i][e] * x[i][e];
#pragma unroll
    for (int i = 4; i < 6; ++i)
#pragma unroll
        for (int e = 0; e < 8; ++e) ssr += x[i][e] * x[i][e];
    ssn += __shfl_xor(ssn, 32); ssr += __shfl_xor(ssr, 32);
    const float rsn = rsqrtf(ssn * (1.0f / 64.0f) + EPS) * QSCALE, rsr = rsqrtf(ssr * (1.0f / 32.0f) + EPS) * QSCALE;
#pragma unroll
    for (int i = 0; i < 4; ++i) { float o[8];
#pragma unroll
        for (int e = 0; e < 8; ++e) o[e] = x[i][e] * rsn * (gn[16 * i + 8 * hi + e] * gkn[16 * i + 8 * hi + e]);
        u32x4 w; w.x = pk2(o[0], o[1]); w.y = pk2(o[2], o[3]); w.z = pk2(o[4], o[5]); w.w = pk2(o[6], o[7]); qf[i] = __builtin_bit_cast(bf16x8, w); }
    float o1[8], o2[8];
#pragma unroll
    for (int e = 0; e < 8; ++e) { const int j = 8 * hi + e; float c, s; rope_cs(pos, j, c, s);
        const float x1 = x[4][e] * rsr * gr[j], x2 = x[5][e] * rsr * gr[16 + j];
        o1[e] = x1 * c - x2 * s; o2[e] = x1 * s + x2 * c; }
    { u32x4 w; w.x = pk2(o1[0], o1[1]); w.y = pk2(o1[2], o1[3]); w.z = pk2(o1[4], o1[5]); w.w = pk2(o1[6], o1[7]); qf[4] = __builtin_bit_cast(bf16x8, w); }
    { u32x4 w; w.x = pk2(o2[0], o2[1]); w.y = pk2(o2[2], o2[3]); w.z = pk2(o2[4], o2[5]); w.w = pk2(o2[6], o2[7]); qf[5] = __builtin_bit_cast(bf16x8, w); }
}

constexpr int AT_KB = 64 * 208, AT_VB = 64 * 192, AT_BUF = AT_KB + AT_VB;
__device__ __forceinline__ void attn_prompt_unit(const P& p, int wv, LAS unsigned char* lds, int b, int h) {
    const int tid_l = wv * 64 + lane_id(); const int tid = tid_l, lane = tid & 63, w = tid >> 6, q = lane & 31, hi = lane >> 5;
    const bf16_t* Qb = (const bf16_t*)(p.ws + WS_Q); const bf16_t* KN = (const bf16_t*)(p.ws + WS_KN); const bf16_t* Vb = (const bf16_t*)(p.ws + WS_V);
    const bf16_t* KR = (const bf16_t*)(p.ws + WS_KRALL); bf16_t* ATT = (bf16_t*)(p.ws + WS_ATT);
    const int key = tid >> 3, part = tid & 7, key2 = tid >> 2, part2 = tid & 3;
    const size_t rowk_b = (size_t)b * KPB;
    for (int qt = 0; qt < 8; ++qt) {
        const size_t row1 = (size_t)b * LP + NMETA + 256 * qt + 32 * w + q;
        bf16x8 qf[6];
        load_q(qf, Qb + row1 * 768 + h * 96, (float)(NMETA + 256 * qt + 32 * w + q), p.g_qn, p.g_qr, p.g_kn, hi);
        const int cmax = 4 * qt + (w >> 1) + 1, ntile = 4 * qt + 5;
        float m = 0.f, l = 0.f; f32x16 O[2];
#pragma unroll
        for (int r = 0; r < 16; ++r) { O[0][r] = 0.f; O[1][r] = 0.f; }
        u32x4 rkn0, rkr0, rv0, rkn1, rkr1, rv1;
        rkr0 = rkr1 = (u32x4){0u, 0u, 0u, 0u};
#define AT_LOAD(S, JT) do { const size_t rk_ = rowk_b + 64 * (size_t)(JT); \
            rkn##S = *(const u32x4*)(KN + (rk_ + key) * 512 + h * 64 + 8 * part); rv##S = *(const u32x4*)(Vb + (rk_ + key) * 512 + h * 64 + 8 * part); \
            if (tid < 256) rkr##S = *(const u32x4*)(KR + (rk_ + key2) * 32 + 8 * part2); } while (0)
#define AT_STAGE(S, BUFI) do { LAS unsigned char* Kc_ = lds + (BUFI) * AT_BUF; LAS unsigned char* VT_ = Kc_ + AT_KB; \
            *(LAS u32x4*)(Kc_ + key * 208 + part * 16) = rkn##S; if (tid < 256) *(LAS u32x4*)(Kc_ + key2 * 208 + 128 + part2 * 16) = rkr##S; \
            *(LAS u32x4*)(VT_ + key * 192 + part * 16) = rv##S; } while (0)
#define AT_COMPUTE(JT, BUFI) do { if ((JT) <= cmax) { const LAS unsigned char* Kc_ = lds + (BUFI) * AT_BUF; const LAS unsigned char* VT_ = Kc_ + AT_KB; \
            if ((JT) > 0) att_tile64(Kc_, VT_, qf, m, l, O, lane); else att_blk(Kc_ + 32 * 208, VT_ + 32 * 192, qf, m, l, O, lane, 16); } } while (0)
        AT_LOAD(0, 0); AT_LOAD(1, 1);
        for (int jt = 0; jt < ntile; jt += 2) {
            AT_STAGE(0, 0);
            if (jt + 2 < ntile) AT_LOAD(0, jt + 2);
            __syncthreads();
            AT_COMPUTE(jt, 0);
            if (jt + 1 < ntile) {
                AT_STAGE(1, 1);
                if (jt + 3 < ntile) AT_LOAD(1, jt + 3);
                __syncthreads();
                AT_COMPUTE(jt + 1, 1);
            }
        }
#undef AT_LOAD
#undef AT_STAGE
#undef AT_COMPUTE
        __syncthreads();
        const float il = 1.0f / xhalf_sum(l);
        const size_t row2 = (size_t)b * SEQ + 256 * qt + 32 * w + q;
#pragma unroll
        for (int db = 0; db < 2; ++db)
#pragma unroll
            for (int rg = 0; rg < 4; ++rg) { u32x2 wv; wv.x = pk2(O[db][4 * rg] * il, O[db][4 * rg + 1] * il); wv.y = pk2(O[db][4 * rg + 2] * il, O[db][4 * rg + 3] * il);
                *(u32x2*)(ATT + row2 * 512 + h * 64 + 32 * db + 8 * rg + 4 * hi) = wv; }
    }
}
typedef __bf16 bf16x2_cv __attribute__((ext_vector_type(2)));
__device__ __forceinline__ unsigned pk2c(float lo, float hi) { const f32x2 v = {lo, hi}; const bf16x2_cv b = __builtin_convertvector(v, bf16x2_cv); return __builtin_bit_cast(unsigned, b); }
constexpr int AS_WIMG = 128 * 272;
constexpr int AS_KB = 32 * 208, AS_VB = 32 * 192, AS_WB = AS_KB + AS_VB;
__device__ __forceinline__ void attn_sample_unit(const P& p, int wv, LAS unsigned char* lds, int b, int h) {
    const int tid_l = wv * 64 + lane_id(); const int tid = tid_l, lane = tid & 63, w = tid >> 6, q = lane & 31, hi = lane >> 5;
    const bf16_t* Qb = (const bf16_t*)(p.ws + WS_Q); const bf16_t* CA = (const bf16_t*)(p.ws + WS_CALL); const bf16_t* WKV = (const bf16_t*)(p.ws + WS_WKV);
    const bf16_t* KR = (const bf16_t*)(p.ws + WS_KRALL); bf16_t* ATT = (bf16_t*)(p.ws + WS_ATT);
    for (int e = tid; e < 128 * 16; e += 512) { const int j = e >> 4, ch = e & 15, d = j & 63, slot = (j < 64) ? h : 8 + h;
        const int prow = 256 * (slot >> 2) + 128 * (d >> 5) + 32 * (slot & 3) + (d & 31);
        *(LAS u32x4*)(lds + j * 272 + ch * 16) = *(const u32x4*)(WKV + (size_t)prow * 128 + 8 * ch); }
    const size_t row1 = (size_t)MP + b * DSQ + q;
    bf16x8 qf[6];
    load_q(qf, Qb + row1 * 768 + h * 96, (float)(PAST + q), p.g_qn, p.g_qr, p.g_kn, hi);
    float m = 0.f, l = 0.f; f32x16 O[2];
#pragma unroll
    for (int r = 0; r < 16; ++r) { O[0][r] = 0.f; O[1][r] = 0.f; }
    LAS unsigned char* Kc = lds + AS_WIMG + w * AS_WB; LAS unsigned char* VT = Kc + AS_KB;
    const size_t rowk_b = (size_t)MKP + (size_t)b * KSAMP;
    __syncthreads();
    bf16x8 cf[8]; u32x4 rr2[2];
#define AS_LOAD(JT) do { const size_t rk_ = rowk_b + 32 * (size_t)(JT); \
        _Pragma("unroll") for (int i = 0; i < 8; ++i) cf[i] = *(const bf16x8*)(CA + (rk_ + q) * 128 + 16 * i + 8 * hi); \
        _Pragma("unroll") for (int n = 0; n < 2; ++n) { const int key = (lane >> 2) + 16 * n, part = lane & 3; rr2[n] = *(const u32x4*)(KR + (rk_ + key) * 32 + 8 * part); } } while (0)
    AS_LOAD(w);
    for (int jt = w; jt < 129; jt += 8) {
#pragma unroll
        for (int n = 0; n < 2; ++n) { const int key = (lane >> 2) + 16 * n, part = lane & 3; *(LAS u32x4*)(Kc + key * 208 + 128 + part * 16) = rr2[n]; }
        {
            f32x16 k0, k1;
#pragma unroll
            for (int r = 0; r < 16; ++r) { k0[r] = 0.f; k1[r] = 0.f; }
#pragma unroll
            for (int i = 0; i < 8; ++i) {
                const bf16x8 w0 = *(const LAS bf16x8*)(lds + q * 272 + (16 * i + 8 * hi) * 2), w1 = *(const LAS bf16x8*)(lds + (32 + q) * 272 + (16 * i + 8 * hi) * 2);
                k0 = __builtin_amdgcn_mfma_f32_32x32x16_bf16(w0, cf[i], k0, 0, 0, 0); k1 = __builtin_amdgcn_mfma_f32_32x32x16_bf16(w1, cf[i], k1, 0, 0, 0); }
            float ss = 0.f;
#pragma unroll
            for (int r = 0; r < 16; ++r) ss += k0[r] * k0[r] + k1[r] * k1[r];
            const float rs = rsqrtf(xhalf_sum(ss) * (1.0f / 64.0f) + EPS);
#pragma unroll
            for (int rg = 0; rg < 4; ++rg) {
                u32x2 a; a.x = pk2c(k0[4 * rg] * rs, k0[4 * rg + 1] * rs); a.y = pk2c(k0[4 * rg + 2] * rs, k0[4 * rg + 3] * rs);
                *(LAS u32x2*)(Kc + q * 208 + (8 * rg + 4 * hi) * 2) = a;
                u32x2 c; c.x = pk2c(k1[4 * rg] * rs, k1[4 * rg + 1] * rs); c.y = pk2c(k1[4 * rg + 2] * rs, k1[4 * rg + 3] * rs);
                *(LAS u32x2*)(Kc + q * 208 + (32 + 8 * rg + 4 * hi) * 2) = c; }
        }
        {
            f32x16 v0, v1;
#pragma unroll
            for (int r = 0; r < 16; ++r) { v0[r] = 0.f; v1[r] = 0.f; }
#pragma unroll
            for (int i = 0; i < 8; ++i) {
                const bf16x8 w0 = *(const LAS bf16x8*)(lds + (64 + q) * 272 + (16 * i + 8 * hi) * 2), w1 = *(const LAS bf16x8*)(lds + (96 + q) * 272 + (16 * i + 8 * hi) * 2);
                v0 = __builtin_amdgcn_mfma_f32_32x32x16_bf16(w0, cf[i], v0, 0, 0, 0); v1 = __builtin_amdgcn_mfma_f32_32x32x16_bf16(w1, cf[i], v1, 0, 0, 0); }
#pragma unroll
            for (int rg = 0; rg < 4; ++rg) {
                u32x2 a; a.x = pk2c(v0[4 * rg], v0[4 * rg + 1]); a.y = pk2c(v0[4 * rg + 2], v0[4 * rg + 3]);
                *(LAS u32x2*)(VT + q * 192 + (8 * rg + 4 * hi) * 2) = a;
                u32x2 c; c.x = pk2c(v1[4 * rg], v1[4 * rg + 1]); c.y = pk2c(v1[4 * rg + 2], v1[4 * rg + 3]);
                *(LAS u32x2*)(VT + q * 192 + (32 + 8 * rg + 4 * hi) * 2) = c; }
        }
        if (jt + 8 < 129) AS_LOAD(jt + 8);
        asm volatile("" ::: "memory"); __builtin_amdgcn_wave_barrier();
        att_blk(Kc, VT, qf, m, l, O, lane, 0);
        asm volatile("" ::: "memory"); __builtin_amdgcn_wave_barrier();
    }
#undef AS_LOAD
    __syncthreads();
    LAS float* Ox = (LAS float*)lds;
    LAS float* Mx = (LAS float*)(lds + 65536);
    LAS float* Lx = Mx + 256;
#pragma unroll
    for (int db = 0; db < 2; ++db)
#pragma unroll
        for (int r = 0; r < 16; ++r) Ox[(w * 64 + 32 * db + crow(r, hi)) * 32 + q] = O[db][r];
    { const float lt = xhalf_sum(l); if (hi == 0) { Mx[w * 32 + q] = m; Lx[w * 32 + q] = lt; } }
    __syncthreads();
    {
        const int qq = tid & 31, dg = tid >> 5;
        float M = -3e30f;
#pragma unroll
        for (int ww = 0; ww < 8; ++ww) M = fmaxf(M, Mx[ww * 32 + qq]);
        float L = 0.f, o[4] = {0.f, 0.f, 0.f, 0.f};
#pragma unroll
        for (int ww = 0; ww < 8; ++ww) { const float sc = __builtin_amdgcn_exp2f(Mx[ww * 32 + qq] - M); L += Lx[ww * 32 + qq] * sc;
#pragma unroll
            for (int e = 0; e < 4; ++e) o[e] += Ox[(ww * 64 + 4 * dg + e) * 32 + qq] * sc; }
        const float il = 1.0f / L;
        u32x2 wv; wv.x = pk2(o[0] * il, o[1] * il); wv.y = pk2(o[2] * il, o[3] * il);
        *(u32x2*)(ATT + ((size_t)M2P + b * DSQ + qq) * 512 + h * 64 + 4 * dg) = wv;
    }
    __syncthreads();
}
__device__ __forceinline__ void phase_attn(const P& p, int wv, LAS unsigned char* lds) {
    for (int u = blockIdx.x; u < 256; u += gridDim.x) attn_prompt_unit(p, wv, lds, u >> 3, u & 7);
    for (int u = blockIdx.x; u < 256; u += gridDim.x) attn_sample_unit(p, wv, lds, u >> 3, u & 7);
}

__device__ __forceinline__ void phase_e2(const P& p, int wv) {
    const int tid_l = wv * 64 + lane_id(); const int lane = tid_l & 63, wave = tid_l >> 6;
    const bf16_t* ATT = (const bf16_t*)(p.ws + WS_ATT); bf16_t* MIX = (bf16_t*)(p.ws + WS_MIX);
    const f32x4 g0 = *(const f32x4*)(p.g_ao + 8 * lane), g1 = *(const f32x4*)(p.g_ao + 8 * lane + 4);
    const int stride = gridDim.x * 8;
    for (int row0 = blockIdx.x * 8 + wave; row0 < M2; row0 += 4 * stride) {
        u32x4 raw[4];
#pragma unroll
        for (int u = 0; u < 4; ++u) { const int row = row0 + u * stride; raw[u] = *(const u32x4*)(ATT + (size_t)(row < M2 ? row : row0) * 512 + 8 * lane); }
#pragma unroll
        for (int u = 0; u < 4; ++u) { const int row = row0 + u * stride;
            const f32x4 a = {bflo(raw[u].x), bfhi(raw[u].x), bflo(raw[u].y), bfhi(raw[u].y)}, c = {bflo(raw[u].z), bfhi(raw[u].z), bflo(raw[u].w), bfhi(raw[u].w)};
            const float ss = (a[0] * a[0] + a[1] * a[1]) + (a[2] * a[2] + a[3] * a[3]) + (c[0] * c[0] + c[1] * c[1]) + (c[2] * c[2] + c[3] * c[3]);
            const float rs = rsqrtf(wave_sum(ss) * (1.0f / 512.0f) + EPS);
            const f32x4 o0 = a * g0 * rs, o1 = c * g1 * rs;
            u32x4 w; w.x = pk2(o0[0], o0[1]); w.y = pk2(o0[2], o0[3]); w.z = pk2(o1[0], o1[1]); w.w = pk2(o1[2], o1[3]);
            if (row < M2) *(u32x4*)(MIX + (size_t)row * 1024 + 8 * lane) = w; }
    }
}
__device__ __forceinline__ void phase_e3(const P& p, int wv) {
    const int tid_l = wv * 64 + lane_id(); const int lane = tid_l & 63, wave = tid_l >> 6;
    const float* H = (const float*)(p.ws + WS_H); bf16_t* U = (bf16_t*)(p.ws + WS_U);
    f32x4 g[4];
#pragma unroll
    for (int j = 0; j < 4; ++j) g[j] = *(const f32x4*)(p.g_ffn + 4 * lane + 256 * j);
    const int stride = gridDim.x * 8;
    for (int row = blockIdx.x * 8 + wave; row < M2P; row += 2 * stride) {
        const int rowb = row + stride; const bool hb = rowb < M2P; const int rb = hb ? rowb : row;
        f32x4 va[4], vb[4]; float ssa = 0.f, ssb = 0.f;
#pragma unroll
        for (int j = 0; j < 4; ++j) { va[j] = *(const f32x4*)(H + (size_t)row * 1024 + 4 * lane + 256 * j); vb[j] = *(const f32x4*)(H + (size_t)rb * 1024 + 4 * lane + 256 * j); }
#pragma unroll
        for (int j = 0; j < 4; ++j) { ssa += (va[j][0] * va[j][0] + va[j][1] * va[j][1]) + (va[j][2] * va[j][2] + va[j][3] * va[j][3]);
                                      ssb += (vb[j][0] * vb[j][0] + vb[j][1] * vb[j][1]) + (vb[j][2] * vb[j][2] + vb[j][3] * vb[j][3]); }
        const float rsa = rsqrtf(wave_sum(ssa) * (1.0f / 1024.0f) + EPS), rsb = rsqrtf(wave_sum(ssb) * (1.0f / 1024.0f) + EPS);
#pragma unroll
        for (int j = 0; j < 4; ++j) { const f32x4 o = va[j] * g[j] * rsa; u32x2 w; w.x = pk2(o[0], o[1]); w.y = pk2(o[2], o[3]);
            *(u32x2*)(U + (size_t)row * 1024 + 4 * lane + 256 * j) = w; }
        if (hb) {
#pragma unroll
            for (int j = 0; j < 4; ++j) { const f32x4 o = vb[j] * g[j] * rsb; u32x2 w; w.x = pk2(o[0], o[1]); w.y = pk2(o[2], o[3]);
                *(u32x2*)(U + (size_t)rowb * 1024 + 4 * lane + 256 * j) = w; } }
    }
    { const float* PB = (const float*)(p.ws + WS_PB5); float* Hw = (float*)(p.ws + WS_H);
      for (int r = blockIdx.x * 8 + wave; r < MS; r += stride) {
          f32x4 v[4]; float ss = 0.f;
#pragma unroll
          for (int j = 0; j < 4; ++j) { const size_t o = (size_t)r * 1024 + 4 * lane + 256 * j;
              v[j] = (*(const f32x4*)(PB + o) + *(const f32x4*)(PB + 1048576 + o)) + (*(const f32x4*)(PB + 2 * 1048576 + o) + *(const f32x4*)(PB + 3 * 1048576 + o)) + *(const f32x4*)(p.xs + o);
              *(f32x4*)(Hw + (size_t)(M2P + r) * 1024 + 4 * lane + 256 * j) = v[j];
              ss += (v[j][0] * v[j][0] + v[j][1] * v[j][1]) + (v[j][2] * v[j][2] + v[j][3] * v[j][3]); }
          const float rs = rsqrtf(wave_sum(ss) * (1.0f / 1024.0f) + EPS);
#pragma unroll
          for (int j = 0; j < 4; ++j) { const f32x4 o = v[j] * g[j] * rs; u32x2 w; w.x = pk2(o[0], o[1]); w.y = pk2(o[2], o[3]);
              *(u32x2*)(U + (size_t)(M2P + r) * 1024 + 4 * lane + 256 * j) = w; }
      } }
}

#define XB_TMO      128
#define XB_XCNT(j)  (256  + 64 * (j))
#define XB_XSUB(j)  (1280 + 64 * (j))
#define XB_XGEN(j)  (2304 + 64 * (j))
#define XB_TOP      3328
#define XB_TOPGEN   3392
#define XCD_BAR_WORDS 3456
#define XB_SPIN_CAP (1u << 18)

__device__ __forceinline__ unsigned xb_ld(unsigned* p)              { return __hip_atomic_load(p, __ATOMIC_RELAXED, __HIP_MEMORY_SCOPE_AGENT); }
__device__ __forceinline__ unsigned xb_add(unsigned* p, unsigned v) { return __hip_atomic_fetch_add(p, v, __ATOMIC_RELAXED, __HIP_MEMORY_SCOPE_AGENT); }
__device__ __forceinline__ unsigned xb_xcc_id() { return (unsigned)__builtin_amdgcn_s_getreg((3 << 11) | 20) & 0xFu; }
#define XB_SPIN(cond, bar) do { unsigned _sp = 0; while (cond) { __builtin_amdgcn_s_sleep(1); \
    if ((++_sp & 255u) == 0u) { if (xb_ld(&(bar)[XB_TMO])) break; if (_sp > XB_SPIN_CAP) { atomicAdd(&(bar)[XB_TMO], 1u); break; } } } } while (0)

struct XcdBarrier {
    int wv;
    unsigned* bar; unsigned x;
    volatile LAS unsigned* st;
};

__device__ __forceinline__ XcdBarrier xcd_barrier_post(unsigned* bar, volatile LAS unsigned* st) {
    XcdBarrier b; b.wv = 0; b.bar = bar; b.x = xb_xcc_id(); b.st = st;
    if (threadIdx.x == 0) (void)xb_add(&bar[XB_XCNT(b.x)], 1u);
    return b;
}
__device__ __forceinline__ void xcd_barrier_complete(unsigned* bar, unsigned x, unsigned& nloc, unsigned& nx) {
    const unsigned G = gridDim.x * gridDim.y * gridDim.z;
    unsigned sum, cnt, mine, sp = 0u;
    for (;;) {
        sum = 0u; cnt = 0u; mine = 0u;
#pragma unroll
        for (unsigned j = 0; j < 16; ++j) { const unsigned c = xb_ld(&bar[XB_XCNT(j)]); sum += c; cnt += (c > 0u) ? 1u : 0u; mine = (j == x) ? c : mine; }
        if (sum == G) break;
        __builtin_amdgcn_s_sleep(1);
        if ((++sp & 255u) == 0u) { if (xb_ld(&bar[XB_TMO])) break; if (sp > XB_SPIN_CAP) { atomicAdd(&bar[XB_TMO], 1u); break; } }
    }
    nloc = mine > 0u ? mine : 1u; nx = cnt > 0u ? cnt : 1u;
}

__device__ __forceinline__ void xcd_barrier(const XcdBarrier& b) {
    asm volatile("s_waitcnt vmcnt(0)" ::: "memory");
    __syncthreads();
    if (b.wv == 0 && lane_id() == 0) {
        unsigned* bar = b.bar;
        __builtin_amdgcn_s_waitcnt(0);
        unsigned nloc = b.st[0], nx = b.st[1];
        if (nloc == 0u) { xcd_barrier_complete(bar, b.x, nloc, nx); b.st[0] = nloc; b.st[1] = nx; }
        const unsigned old = xb_add(&bar[XB_XSUB(b.x)], 1u);
        const unsigned gen = old / nloc;
        if (old + 1u == (gen + 1u) * nloc) {
            __builtin_amdgcn_fence(__ATOMIC_RELEASE, "agent");
            asm volatile("s_waitcnt vmcnt(0)" ::: "memory");
            const unsigned og = xb_add(&bar[XB_TOP], 1u);
            const unsigned tg = og / nx;
            if (og + 1u == (tg + 1u) * nx) xb_add(&bar[XB_TOPGEN], 1u);
            else XB_SPIN(xb_ld(&bar[XB_TOPGEN]) == tg, bar);
            __builtin_amdgcn_fence(__ATOMIC_ACQUIRE, "agent");
            xb_add(&bar[XB_XGEN(b.x)], 1u);
            asm volatile("s_waitcnt vmcnt(0)" ::: "memory");
        } else {
            XB_SPIN(xb_ld(&bar[XB_XGEN(b.x)]) == gen, bar);
            __builtin_amdgcn_fence(__ATOMIC_ACQUIRE, "agent");
            asm volatile("s_waitcnt vmcnt(0)" ::: "memory");
        }
    }
    __syncthreads();
}

template <class Epi> __device__ __forceinline__ void run_gemm(int wv, LAS unsigned char* lds, const bf16_t* A, const bf16_t* Bt, int M, int N, int K, const Epi& E) {
    pg8::Gemm g{A, Bt, M, N, K, K, wv}; pg8::StaticOrder S; S.init(M, N, (int)gridDim.x, (int)blockIdx.x);
    pg8::gemm_phase<Epi, pg8::StaticOrder, true, true>(lds, g, S, E);
}

#ifndef PH_MASK
#define PH_MASK 0xFFFF
#endif
#ifndef PH_TWICE
#define PH_TWICE 0
#ifndef EXTRA_SYNCS
#define EXTRA_SYNCS 0
#endif
#endif
__device__ __forceinline__ void run_gemm_split(int wv, LAS unsigned char* lds, const bf16_t* A, const bf16_t* Bt, int N, int K, int Kc, int pm0, int npm, const pg8::EpiPartial& E) {
    pg8::Gemm g{A, Bt, 0, N, K, Kc, wv}; pg8::SplitOrder S{pm0, npm, N / 256, K / Kc, (int)gridDim.x, (int)blockIdx.x};
    pg8::gemm_phase<pg8::EpiPartial, pg8::SplitOrder, true, true, true>(lds, g, S, E);
}
__global__ void __launch_bounds__(512, 2) hymba_fwd(P p) {
    extern __shared__ __attribute__((aligned(16))) unsigned char lds_raw[];
    LAS unsigned char* lds = (LAS unsigned char*)lds_raw;
    cg::grid_group grid = cg::this_grid();
    unsigned char* ws = p.ws;
    volatile LAS unsigned* bst = (volatile LAS unsigned*)(lds + LDS_BYTES - 64);
    if (threadIdx.x < 16) bst[threadIdx.x] = 0u;
    __syncthreads();
    XcdBarrier xbar = xcd_barrier_post((unsigned*)(ws + WS_CTL), bst);
    const int wv = __builtin_amdgcn_readfirstlane((int)(threadIdx.x >> 6)); xbar.wv = wv;
#define GBAR() xcd_barrier(xbar)
    if (PH_MASK & 1) phase_e0(p, wv, lds);
    if (PH_TWICE & 1) { __syncthreads(); phase_e0(p, wv, lds); }
    if (p.ws == nullptr) grid.sync();
    GBAR();
    if (PH_MASK & 2) { pg8::EpiStore E{(bf16_t*)(ws + WS_PROJ), NPROJ}; run_gemm(wv, lds, (const bf16_t*)(ws + WS_XN), (const bf16_t*)(ws + WS_WIN), M1, NPROJ, 1024, E); }
    if (PH_TWICE & 2) { pg8::EpiStore E{(bf16_t*)(ws + WS_PROJ), NPROJ}; run_gemm(wv, lds, (const bf16_t*)(ws + WS_XN), (const bf16_t*)(ws + WS_WIN), M1, NPROJ, 1024, E); }
    GBAR();
    for (int es = 0; es < EXTRA_SYNCS; ++es) GBAR();
    if (PH_MASK & 4) phase_e1(p, wv);
    if (PH_TWICE & 4) phase_e1(p, wv);
    GBAR();
    if (PH_MASK & 16) { pg8::EpiStore E{(bf16_t*)(ws + WS_E), 1536}; run_gemm(wv, lds, (const bf16_t*)(ws + WS_LIN), (const bf16_t*)(ws + WS_WL), M1, 1536, 256, E); }
    if (PH_TWICE & 16) { pg8::EpiStore E{(bf16_t*)(ws + WS_E), 1536}; run_gemm(wv, lds, (const bf16_t*)(ws + WS_LIN), (const bf16_t*)(ws + WS_WL), M1, 1536, 256, E); }
    GBAR();
    if (PH_MASK & 32) phase_scan(p, wv, lds);
    if (PH_TWICE & 32) phase_scan(p, wv, lds);
    GBAR();
    if (PH_MASK & 8) { pg8::EpiStore E{(bf16_t*)(ws + WS_Q), 768}; run_gemm(wv, lds, (const bf16_t*)(ws + WS_QL), (const bf16_t*)(ws + WS_WQ), M1, 768, 256, E); }
    if (PH_TWICE & 8) { pg8::EpiStore E{(bf16_t*)(ws + WS_Q), 768}; run_gemm(wv, lds, (const bf16_t*)(ws + WS_QL), (const bf16_t*)(ws + WS_WQ), M1, 768, 256, E); }
    if (PH_MASK & 64) { pg8::EpiKV E{(bf16_t*)(ws + WS_KN), (bf16_t*)(ws + WS_V), p.g_kn}; run_gemm(wv, lds, (const bf16_t*)(ws + WS_CALL), (const bf16_t*)(ws + WS_WKV), MKP, 1024, 128, E); }
    if (PH_TWICE & 64) { pg8::EpiKV E{(bf16_t*)(ws + WS_KN), (bf16_t*)(ws + WS_V), p.g_kn}; run_gemm(wv, lds, (const bf16_t*)(ws + WS_CALL), (const bf16_t*)(ws + WS_WKV), MKP, 1024, 128, E); }
    GBAR();
    if (PH_MASK & 128) phase_attn(p, wv, lds);
    if (PH_TWICE & 128) phase_attn(p, wv, lds);
    GBAR();
    if (PH_MASK & 256) phase_e2(p, wv);
    if (PH_TWICE & 256) phase_e2(p, wv);
    GBAR();
    if (PH_MASK & 512) { pg8::EpiRes E{(float*)(ws + WS_H), p.xp, p.xs, M2P}; run_gemm(wv, lds, (const bf16_t*)(ws + WS_MIX), (const bf16_t*)(ws + WS_WOUT), M2P, 1024, 1024, E);
        pg8::EpiPartial E2{(float*)(ws + WS_PB5), M2P}; run_gemm_split(wv, lds, (const bf16_t*)(ws + WS_MIX), (const bf16_t*)(ws + WS_WOUT), 1024, 1024, 256, M2P / 256, MS / 256, E2); }
    GBAR();
    if (PH_MASK & 1024) phase_e3(p, wv);
    if (PH_TWICE & 1024) phase_e3(p, wv);
    GBAR();
    if (PH_MASK & 2048) { pg8::EpiSwiglu E{(bf16_t*)(ws + WS_ACT)}; run_gemm(wv, lds, (const bf16_t*)(ws + WS_U), (const bf16_t*)(ws + WS_WGU), M2, 2 * DFF, 1024, E); }
    if (PH_TWICE & 2048) { pg8::EpiSwiglu E{(bf16_t*)(ws + WS_ACT)}; run_gemm(wv, lds, (const bf16_t*)(ws + WS_U), (const bf16_t*)(ws + WS_WGU), M2, 2 * DFF, 1024, E); }
    GBAR();
    if (PH_MASK & 4096) { pg8::EpiRes E{p.out, (const float*)(ws + WS_H), (const float*)(ws + WS_H), M2}; run_gemm(wv, lds, (const bf16_t*)(ws + WS_ACT), (const bf16_t*)(ws + WS_WDN), M2P, 1024, DFF, E);
        pg8::EpiPartial E2{(float*)(ws + WS_PB7), M2P}; run_gemm_split(wv, lds, (const bf16_t*)(ws + WS_ACT), (const bf16_t*)(ws + WS_WDN), 1024, DFF, 256, M2P / 256, MS / 256, E2); }
    GBAR();
    {
        const float* PB = (const float*)(ws + WS_PB7); float* ys = p.out + OFF_YS;
        const int tid_l = wv * 64 + lane_id();
        for (size_t e = (size_t)blockIdx.x * 512 + tid_l; e < (size_t)MS * 1024 / 4; e += (size_t)gridDim.x * 512) {
            f32x4 a = *(const f32x4*)(PB + 4 * e) + *(const f32x4*)((const float*)(ws + WS_H) + (size_t)M2P * 1024 + 4 * e);
#pragma unroll
            for (int kc = 1; kc < 11; ++kc) a += *(const f32x4*)(PB + (size_t)kc * 1048576 + 4 * e);
            *(f32x4*)(ys + 4 * e) = a; }
    }
}

extern "C" void kernel_launch(void* const* d_in, const int* in_sizes, int n_in, void* d_out, int out_size, void* d_ws, size_t ws_size, hipStream_t stream) {
    static int grid_blocks = 0;
    if (grid_blocks == 0) {
        if (n_in != 34 || ws_size < WS_NEED) { fprintf(stderr, "kernel_launch: unexpected n_in %d / ws_size %zu\n", n_in, ws_size); grid_blocks = -1; return; }
        int dev = 0, cus = 0, per_cu = 0;
        hipGetDevice(&dev);
        hipDeviceGetAttribute(&cus, hipDeviceAttributeMultiprocessorCount, dev);
        if (hipFuncSetAttribute((const void*)hymba_fwd, hipFuncAttributeMaxDynamicSharedMemorySize, LDS_BYTES) != hipSuccess) { fprintf(stderr, "kernel_launch: hipFuncSetAttribute failed\n"); }
        if (hipOccupancyMaxActiveBlocksPerMultiprocessor(&per_cu, (const void*)hymba_fwd, 512, LDS_BYTES) != hipSuccess || per_cu < 1) per_cu = 1;
        (void)hipGetLastError();
        if (per_cu > 1) per_cu = 1;
        grid_blocks = cus * per_cu;
    }
    if (grid_blocks < 0) return;
    P p{};
    const float** f = (const float**)&p;
    for (int i = 0; i < 34; ++i) f[i] = (const float*)d_in[i];
    p.out = (float*)d_out; p.ws = (unsigned char*)d_ws;
    (void)hipMemsetAsync((char*)d_ws + WS_CTL, 0, 16384, stream);
    void* args[] = {&p};
    hipError_t e = hipLaunchCooperativeKernel((const void*)hymba_fwd, dim3(grid_blocks), dim3(512), args, LDS_BYTES, stream);
    if (e != hipSuccess) fprintf(stderr, "cooperative launch failed: %s (grid %d)\n", hipGetErrorString(e), grid_blocks);
}
```

```cpp
#include <hip/hip_runtime.h>
#include <hip/hip_cooperative_groups.h>
#include <cstdio>
#include <cstdint>
namespace cg = cooperative_groups;

namespace pg8 {
#define PG8_LAS __attribute__((address_space(3)))
typedef unsigned short bf16_t;
typedef short bf16x8 __attribute__((ext_vector_type(8)));
typedef float f32x4 __attribute__((ext_vector_type(4)));
typedef unsigned u32x4 __attribute__((ext_vector_type(4)));
constexpr int BM = 256, BK = 64, HALF = 128, HTB = HALF * BK * 2  , STAGE_BYTES = 8 * HTB, NXCD = 8, WGM = 8;

__host__ __device__ __forceinline__ int lds_byte(int r, int c) { const int st = (r >> 4) * 2 + (c >> 5), rr = r & 15, cc = c & 31, ob = rr * 64 + cc * 2; return st * 1024 + (ob ^ (((ob >> 9) & 1) << 5)); }
__host__ __device__ __forceinline__ void stage_rc(int b, int& R, int& C) { const int st = b / 1024, sb = b % 1024, swz = sb ^ (((sb >> 9) & 1) << 5); R = (st >> 1) * 16 + swz / 64; C = (st & 1) * 32 + (swz % 64) / 2; }
__host__ __device__ __forceinline__ int perm32(int rho) { const int n = rho >> 4, i = rho & 15; return 8 * (i >> 2) + 4 * n + (i & 3); }

struct Unit { int pm, pn, kc; };
struct Gemm { const bf16_t* A; const bf16_t* Bt; int M, N, K, Kc, wv; };

struct StaticOrder {
    int nM, nN, nwg, G, c;
    __host__ __device__ void init(int M, int N, int G_, int c_) { nM = M / BM; nN = N / BM; nwg = nM * nN; G = G_; c = c_; }
    __host__ __device__ bool next(int i, Unit& u) const {
        const long L = (long)i * G + c; if (L >= nwg) return false;
        int wgid = (int)L; { const int q = nwg / NXCD, r = nwg % NXCD, xcd = wgid % NXCD, off = wgid / NXCD; wgid = (xcd < r ? xcd * (q + 1) : r * (q + 1) + (xcd - r) * q) + off; }
        const int nig = WGM * nN, gid = wgid / nig, fm = gid * WGM, gsz = (nM - fm) < WGM ? (nM - fm) : WGM;
        u.pm = fm + ((wgid % nig) % gsz); u.pn = (wgid % nig) / gsz; u.kc = 0; return true;
    }
    __device__ __forceinline__ void a_ready(const Unit&) const {}
    __device__ __forceinline__ void done(const Unit&) const {}
};

__device__ __forceinline__ unsigned cvt_pk_bf16(float lo, float hi) { unsigned r; asm volatile("v_cvt_pk_bf16_f32 %0, %1, %2" : "=v"(r) : "v"(lo), "v"(hi)); return r; }
template <class Epi, class Sched, bool ALIGN_EPI = false, bool SP2 = false, bool SPLITK = false>
__device__ __forceinline__ void gemm_phase(PG8_LAS unsigned char* lds, const Gemm g, const Sched& S, const Epi& E) {
    int tid_l; asm volatile("v_mbcnt_lo_u32_b32 %0, -1, 0\n\tv_mbcnt_hi_u32_b32 %0, -1, %0" : "=v"(tid_l)); const int tid = g.wv * 64 + tid_l, wid = __builtin_amdgcn_readfirstlane(tid >> 6), lane = tid & 63, wr = wid >> 2, wc = wid & 3, fr = lane & 15, fq = lane >> 4;
    const int K = g.K, nt = (SPLITK ? g.Kc : g.K) / BK; const size_t kcb = SPLITK ? (size_t)g.Kc * 2 : 0;
    unsigned voffA[2], voffB[2];
#pragma unroll
    for (int i = 0; i < 2; ++i) { int R, C; stage_rc(tid * 16 + i * 8192, R, C); const int Rb = Epi::PERM ? ((R & ~31) + perm32(R & 31)) : R;
        voffA[i] = (unsigned)(R * K + C) * 2u; voffB[i] = (unsigned)(Rb * K + C) * 2u; }
    const size_t kstep = (size_t)(BK * 2);
    const size_t hstep = (size_t)HALF * K * 2;
    const size_t tstep = 2 * hstep;
    const unsigned ldsw = (unsigned)wid * 1024u;
    const int aoff = lds_byte(wr * 64 + fr, fq * 8), boff = lds_byte(wc * 32 + fr, fq * 8);
#define PG8_SA(b, h) (((b) * 2 + (h)) * HTB)
#define PG8_SB(b, h) ((4 + (b) * 2 + (h)) * HTB)
#define PG8_STAGE(bufoff, gbase, voff) do { _Pragma("unroll") for (int _i = 0; _i < 2; ++_i) \
        __builtin_amdgcn_global_load_lds((const unsigned*)((const char*)(gbase) + (voff)[_i]), (PG8_LAS unsigned*)(lds + (bufoff) + ldsw + _i * 8192), 16, 0, 0); } while (0)
#define PG8_LDA(dst, b, h) do { _Pragma("unroll") for (int m = 0; m < 4; ++m) _Pragma("unroll") for (int k = 0; k < 2; ++k) dst[m][k] = *(const PG8_LAS bf16x8*)(lds + PG8_SA(b, h) + aoff + m * 2048 + k * 1024); } while (0)
#define PG8_LDB(dst, b, h) do { _Pragma("unroll") for (int n = 0; n < 2; ++n) _Pragma("unroll") for (int k = 0; k < 2; ++k) dst[n][k] = *(const PG8_LAS bf16x8*)(lds + PG8_SB(b, h) + boff + n * 2048 + k * 1024); } while (0)
#define PG8_MMA(ai, bj, At, Bt) do { __builtin_amdgcn_s_setprio(1); _Pragma("unroll") for (int m = 0; m < 4; ++m) _Pragma("unroll") for (int n = 0; n < 2; ++n) _Pragma("unroll") for (int k = 0; k < 2; ++k) \
        acc[ai][bj][m][n] = __builtin_amdgcn_mfma_f32_16x16x32_bf16(Bt[n][k], At[m][k], acc[ai][bj][m][n], 0, 0, 0); __builtin_amdgcn_s_setprio(0); } while (0)
#define PG8_WAIT_V(n) asm volatile("s_waitcnt vmcnt(" #n ")" ::: "memory")
#define PG8_WAIT_L(n) asm volatile("s_waitcnt lgkmcnt(" #n ")" ::: "memory")
#define PG8_BAR __builtin_amdgcn_s_barrier()
#define PG8_SCHED __builtin_amdgcn_sched_barrier(0)
    Unit cur, nxt; int ui = 0;
    if (!S.next(0, cur)) return;
    f32x4 acc[2][2][4][2];
#pragma unroll
    for (int a = 0; a < 2; ++a)
#pragma unroll
        for (int b = 0; b < 2; ++b)
#pragma unroll
            for (int m = 0; m < 4; ++m)
#pragma unroll
                for (int n = 0; n < 2; ++n) acc[a][b][m][n] = (f32x4){0.f, 0.f, 0.f, 0.f};
    bf16x8 At[4][2], B0[2][2], B1[2][2];
    const char* cA = (const char*)g.A + (size_t)cur.pm * tstep + (SPLITK ? (size_t)cur.kc * kcb : 0); const char* cB = (const char*)g.Bt + (size_t)cur.pn * tstep + (SPLITK ? (size_t)cur.kc * kcb : 0);
    S.a_ready(cur);
    if constexpr (SP2) {
        PG8_STAGE(PG8_SB(0, 0), cB, voffB); PG8_STAGE(PG8_SB(0, 1), cB + hstep, voffB); PG8_STAGE(PG8_SA(0, 0), cA, voffA); PG8_STAGE(PG8_SA(0, 1), cA + hstep, voffA);
        if (wr == 1) PG8_BAR;
        PG8_WAIT_V(2); PG8_BAR;
        PG8_STAGE(PG8_SB(1, 0), cB + kstep, voffB); PG8_STAGE(PG8_SA(1, 0), cA + kstep, voffA); PG8_STAGE(PG8_SB(1, 1), cB + hstep + kstep, voffB);
        PG8_WAIT_V(6); PG8_BAR;
    } else {
        PG8_STAGE(PG8_SB(0, 0), cB, voffB); PG8_STAGE(PG8_SA(0, 0), cA, voffA); PG8_STAGE(PG8_SB(0, 1), cB + hstep, voffB); PG8_STAGE(PG8_SA(0, 1), cA + hstep, voffA);
        if (wr == 1) PG8_BAR;
        PG8_WAIT_V(4); PG8_BAR;
        PG8_STAGE(PG8_SB(1, 0), cB + kstep, voffB); PG8_STAGE(PG8_SA(1, 0), cA + kstep, voffA); PG8_STAGE(PG8_SB(1, 1), cB + hstep + kstep, voffB);
        PG8_WAIT_V(6); PG8_BAR;
    }
    for (;;) {
        const bool has_next = S.next(ui + 1, nxt);
        const char* nA = has_next ? (const char*)g.A + (size_t)nxt.pm * tstep + (SPLITK ? (size_t)nxt.kc * kcb : 0) : cA; const char* nB = has_next ? (const char*)g.Bt + (size_t)nxt.pn * tstep + (SPLITK ? (size_t)nxt.kc * kcb : 0) : cB;
#pragma unroll 1
        for (int t = 0; t < nt; t += 2) {
            const bool last = (t == nt - 2);
            const char* a1 = cA + (size_t)(t + 1) * kstep;
            const char* a2 = last ? nA : cA + (size_t)(t + 2) * kstep; const char* b2 = last ? nB : cB + (size_t)(t + 2) * kstep;
            const char* a3 = a2 + kstep; const char* b3 = b2 + kstep;
            if (last && has_next) S.a_ready(nxt);
            if constexpr (SP2) {
            PG8_LDB(B0, 0, 0); PG8_LDB(B1, 0, 1); PG8_SCHED; PG8_LDA(At, 0, 0); PG8_STAGE(PG8_SA(1, 1), a1 + hstep, voffA);
            PG8_WAIT_V(8); PG8_WAIT_L(0); PG8_BAR; PG8_MMA(0, 0, At, B0); PG8_MMA(0, 1, At, B1); PG8_BAR; PG8_SCHED;
            PG8_LDA(At, 0, 1); PG8_STAGE(PG8_SB(0, 0), b2, voffB); PG8_STAGE(PG8_SB(0, 1), b2 + hstep, voffB); PG8_STAGE(PG8_SA(0, 0), a2, voffA);
            PG8_WAIT_V(8); PG8_WAIT_L(0); PG8_BAR; PG8_MMA(1, 0, At, B0); PG8_MMA(1, 1, At, B1); PG8_BAR; PG8_SCHED;
            PG8_LDB(B0, 1, 0); PG8_LDB(B1, 1, 1); PG8_SCHED; PG8_LDA(At, 1, 0); PG8_STAGE(PG8_SA(0, 1), a2 + hstep, voffA);
            PG8_WAIT_V(8); PG8_WAIT_L(0); PG8_BAR; PG8_MMA(0, 0, At, B0); PG8_MMA(0, 1, At, B1); PG8_BAR; PG8_SCHED;
            PG8_LDA(At, 1, 1); PG8_STAGE(PG8_SB(1, 0), b3, voffB); PG8_STAGE(PG8_SB(1, 1), b3 + hstep, voffB); PG8_STAGE(PG8_SA(1, 0), a3, voffA);
            PG8_WAIT_V(8); PG8_WAIT_L(0); PG8_BAR; PG8_MMA(1, 0, At, B0); PG8_MMA(1, 1, At, B1); PG8_BAR; PG8_SCHED;
            } else {
            PG8_LDB(B0, 0, 0); PG8_SCHED; PG8_LDA(At, 0, 0); PG8_STAGE(PG8_SA(1, 1), a1 + hstep, voffA);
            PG8_WAIT_L(8); PG8_BAR; PG8_WAIT_L(0); PG8_MMA(0, 0, At, B0); PG8_BAR; PG8_SCHED;
            PG8_LDB(B1, 0, 1); PG8_STAGE(PG8_SB(0, 0), b2, voffB);
            PG8_BAR; PG8_WAIT_L(0); PG8_MMA(0, 1, At, B1); PG8_BAR;
            PG8_LDA(At, 0, 1); PG8_STAGE(PG8_SA(0, 0), a2, voffA);
            PG8_BAR; PG8_WAIT_L(0); PG8_MMA(1, 0, At, B0); PG8_BAR; PG8_SCHED;
            PG8_STAGE(PG8_SB(0, 1), b2 + hstep, voffB);
            PG8_WAIT_V(6); PG8_BAR; PG8_MMA(1, 1, At, B1); PG8_BAR;
            PG8_LDB(B0, 1, 0); PG8_SCHED; PG8_LDA(At, 1, 0); PG8_STAGE(PG8_SA(0, 1), a2 + hstep, voffA);
            PG8_WAIT_L(8); PG8_BAR; PG8_WAIT_L(0); PG8_MMA(0, 0, At, B0); PG8_BAR; PG8_SCHED;
            PG8_LDB(B1, 1, 1); PG8_STAGE(PG8_SB(1, 0), b3, voffB);
            PG8_BAR; PG8_WAIT_L(0); PG8_MMA(0, 1, At, B1); PG8_BAR;
            PG8_LDA(At, 1, 1); PG8_STAGE(PG8_SA(1, 0), a3, voffA);
            PG8_BAR; PG8_WAIT_L(0); PG8_MMA(1, 0, At, B0); PG8_BAR; PG8_SCHED;
            PG8_STAGE(PG8_SB(1, 1), b3 + hstep, voffB);
            PG8_WAIT_V(6); PG8_BAR; PG8_MMA(1, 1, At, B1); PG8_BAR;
            }
        }
        if constexpr (ALIGN_EPI) { if (wr == 0) PG8_BAR; }
        if constexpr (!Epi::AFTER_DRAIN) { E(acc, cur, wr, wc, fr, fq); S.done(cur); }
        if (!has_next) break;
#pragma unroll
        for (int a = 0; a < 2; ++a)
#pragma unroll
            for (int b = 0; b < 2; ++b)
#pragma unroll
                for (int m = 0; m < 4; ++m)
#pragma unroll
                    for (int n = 0; n < 2; ++n) acc[a][b][m][n] = (f32x4){0.f, 0.f, 0.f, 0.f};
        cur = nxt; cA = nA; cB = nB; ++ui;
        if constexpr (ALIGN_EPI) { if (wr == 1) PG8_BAR; }
    }
    PG8_WAIT_V(0);
    if constexpr (!ALIGN_EPI) { if (wr == 0) PG8_BAR; }
    PG8_BAR;
    if constexpr (Epi::AFTER_DRAIN) { E.fused(acc, cur, wr, wc, fr, fq, lds, wid, lane); S.done(cur); }
#undef PG8_SA
#undef PG8_SB
#undef PG8_STAGE
#undef PG8_LDA
#undef PG8_LDB
#undef PG8_MMA
#undef PG8_WAIT_V
#undef PG8_WAIT_L
#undef PG8_BAR
#undef PG8_SCHED
}
}

#define LAS __attribute__((address_space(3)))
typedef unsigned short bf16_t;
typedef float f32x4 __attribute__((ext_vector_type(4)));
typedef float f32x2 __attribute__((ext_vector_type(2)));
typedef float f32x16 __attribute__((ext_vector_type(16)));
typedef unsigned u32x4 __attribute__((ext_vector_type(4)));
typedef unsigned u32x2 __attribute__((ext_vector_type(2)));
typedef short bf16x8 __attribute__((ext_vector_type(8)));

constexpr int DM = 1024, NB = 32, SEQ = 2048, NMETA = 16, LP = 2064, DSQ = 32, PAST = 4096, KSAMP = 4128;
constexpr int MP = NB * LP;
constexpr int MS = NB * DSQ;
constexpr int M1 = MP + MS;
constexpr int M2P = NB * SEQ;
constexpr int M2 = M2P + MS;
constexpr int KPB = 2112;
constexpr int MKP = NB * KPB;
constexpr int MK = MKP + NB * KSAMP;
constexpr int NPROJ = 2304, INCOLS = 2208, RW0 = 416, RWC = 1792, DFF = 2816;
constexpr float EPS = 1e-6f, LNX_EPS = 64e-5f;
constexpr float QSCALE = 0.10206207261596577f * 1.4426950408889634f;

constexpr size_t OFF_YP = 0, OFF_YS = 67108864, OFF_KVP = 68157440, OFF_KRP = 76611584, OFF_WKVP = 78725120, OFF_SHP = 79773696,
                 OFF_KVS = 79831040, OFF_KRS = 79962112, OFF_WKVS = 79994880, OFF_SHS = 81043456;

constexpr size_t MiB = 1u << 20;
constexpr size_t WS_WIN = 0, WS_WQ = 5 * MiB, WS_WKV = 6 * MiB, WS_WL = 7 * MiB, WS_WOUT = 8 * MiB, WS_WGU = 10 * MiB, WS_WDN = 22 * MiB;
constexpr size_t WS_CTL = 28 * MiB;
constexpr size_t WS_XN = 32 * MiB, WS_PROJ = 163 * MiB;
constexpr size_t WS_CALL = 32 * MiB, WS_KRALL = 81 * MiB, WS_QL = 94 * MiB, WS_LIN = 127 * MiB;
constexpr size_t WS_RKV = 460 * MiB, WS_Q = 163 * MiB, WS_E = 262 * MiB, WS_A = 328 * MiB, WS_G = 394 * MiB;
constexpr size_t WS_MIX = 657 * MiB, WS_KN = 262 * MiB, WS_V = 457 * MiB, WS_ATT = 787 * MiB;
constexpr size_t WS_H = 32 * MiB, WS_U = 292 * MiB, WS_ACT = 422 * MiB;
constexpr size_t WS_PB5 = 430 * MiB, WS_PB7 = 300 * MiB;
constexpr size_t WS_NEED = 852 * MiB;
constexpr int LDS_BYTES = 139264;

struct P {
    const float *xp, *xs, *ckv, *ckr, *swkv, *sshift, *meta, *g_mix, *w_in, *g_q, *w_qup, *g_kv, *w_kvup, *g_qn, *g_qr, *g_kn, *g_kr, *g_ao,
                *mu, *w0, *w2, *a0, *a2, *g2, *k_k, *k_a, *r_k, *lnx_g, *lnx_b, *w_out, *g_ffn, *w_gate, *w_up, *w_down;
    float* out; unsigned char* ws;
};
__device__ __forceinline__ int lane_id() { int l; asm volatile("v_mbcnt_lo_u32_b32 %0, -1, 0\n\tv_mbcnt_hi_u32_b32 %0, -1, %0" : "=v"(l)); return l; }

__device__ __forceinline__ float bf2f(unsigned b) { return __uint_as_float(b << 16); }
__device__ __forceinline__ float bflo(unsigned w) { return __uint_as_float(w << 16); }
__device__ __forceinline__ float bfhi(unsigned w) { return __uint_as_float(w & 0xffff0000u); }
__device__ __forceinline__ unsigned pk2(float lo, float hi) { return pg8::cvt_pk_bf16(lo, hi); }
__device__ __forceinline__ float wave_sum(float v) {
#pragma unroll
    for (int o = 1; o < 64; o <<= 1) v += __shfl_xor(v, o);
    return v;
}
__device__ __forceinline__ float red16(float v) { v += __shfl_xor(v, 1); v += __shfl_xor(v, 2); v += __shfl_xor(v, 4); v += __shfl_xor(v, 8); return v; }
__device__ __forceinline__ float sigmoidf_(float x) { return 1.0f / (1.0f + __expf(-x)); }
__device__ __forceinline__ void rope_cs(float pos, int j, float& c, float& s) {
    const float inv = exp2f(-0.8304820237218406f * (float)j);
    const float ang = pos * inv;
    const float k = rintf(ang * 0.15915494309189535f);
    float r = fmaf(-k, 6.2831854820251465f, ang); r = fmaf(-k, -1.7484555e-7f, r);
    s = __sinf(r); c = __cosf(r);
}
__device__ __forceinline__ float row_pos(int row1) { return row1 < MP ? (float)(row1 % LP) : (float)(PAST + ((row1 - MP) & 31)); }

namespace pg8 {
struct EpiStore {
    static constexpr bool PERM = true, AFTER_DRAIN = false;
    bf16_t* O; int ldc;
    __device__ __forceinline__ void operator()(const f32x4 (&acc)[2][2][4][2], const Unit& u, int wr, int wc, int fr, int fq) const {
        const int row0 = u.pm * BM + wr * 64 + fr, col0 = u.pn * BM + wc * 32 + 8 * fq;
#pragma unroll
        for (int ai = 0; ai < 2; ++ai)
#pragma unroll
            for (int m = 0; m < 4; ++m) { bf16_t* rowp = O + (size_t)(row0 + ai * HALF + m * 16) * ldc + col0;
#pragma unroll
                for (int bj = 0; bj < 2; ++bj) { const f32x4 v0 = acc[ai][bj][m][0], v1 = acc[ai][bj][m][1]; u32x4 w;
                    w.x = cvt_pk_bf16(v0[0], v0[1]); w.y = cvt_pk_bf16(v0[2], v0[3]); w.z = cvt_pk_bf16(v1[0], v1[1]); w.w = cvt_pk_bf16(v1[2], v1[3]);
                    *(u32x4*)(rowp + bj * HALF) = w; } }
    }
};
struct EpiKV {
    static constexpr bool PERM = true, AFTER_DRAIN = false;
    bf16_t* KN; bf16_t* V; const float* gk;
    __device__ __forceinline__ void operator()(const f32x4 (&acc)[2][2][4][2], const Unit& u, int wr, int wc, int fr, int fq) const {
        const int slot = u.pn * 4 + wc, h = slot & 7;
        const size_t off0 = (size_t)(u.pm * BM + wr * 64 + fr) * 512 + h * 64 + 8 * fq;
        if (slot >= 8) {
#pragma unroll
            for (int ai = 0; ai < 2; ++ai)
#pragma unroll
                for (int m = 0; m < 4; ++m) { bf16_t* dst = V + off0 + (size_t)(ai * HALF + m * 16) * 512;
#pragma unroll
                    for (int bj = 0; bj < 2; ++bj) { const f32x4 v0 = acc[ai][bj][m][0], v1 = acc[ai][bj][m][1]; u32x4 w;
                        w.x = cvt_pk_bf16(v0[0], v0[1]); w.y = cvt_pk_bf16(v0[2], v0[3]); w.z = cvt_pk_bf16(v1[0], v1[1]); w.w = cvt_pk_bf16(v1[2], v1[3]);
                        *(u32x4*)(dst + 32 * bj) = w; } }
        } else {
#pragma unroll
            for (int ai = 0; ai < 2; ++ai)
#pragma unroll
                for (int m = 0; m < 4; ++m) {
                    float ss = 0.f;
#pragma unroll
                    for (int bj = 0; bj < 2; ++bj)
#pragma unroll
                        for (int n = 0; n < 2; ++n) { const f32x4 x = acc[ai][bj][m][n]; ss += (x[0] * x[0] + x[1] * x[1]) + (x[2] * x[2] + x[3] * x[3]); }
                    ss += __shfl_xor(ss, 16); ss += __shfl_xor(ss, 32);
                    const float rs = rsqrtf(ss * (1.0f / 64.0f) + EPS);
                    bf16_t* dst = KN + off0 + (size_t)(ai * HALF + m * 16) * 512;
#pragma unroll
                    for (int bj = 0; bj < 2; ++bj) { const f32x4 v0 = acc[ai][bj][m][0] * rs, v1 = acc[ai][bj][m][1] * rs; u32x4 w;
                        w.x = cvt_pk_bf16(v0[0], v0[1]); w.y = cvt_pk_bf16(v0[2], v0[3]); w.z = cvt_pk_bf16(v1[0], v1[1]); w.w = cvt_pk_bf16(v1[2], v1[3]);
                        *(u32x4*)(dst + 32 * bj) = w; }
                    asm volatile("" ::: "memory");
                }
        }
    }
};
struct EpiRes {
    static constexpr bool PERM = false, AFTER_DRAIN = false;
    float* O; const float* r0; const float* r1; int split;
    __device__ __forceinline__ void operator()(const f32x4 (&acc)[2][2][4][2], const Unit& u, int wr, int wc, int fr, int fq) const {
        const int col0 = u.pn * BM + wc * 32 + 4 * fq;
#pragma unroll
        for (int ai = 0; ai < 2; ++ai)
#pragma unroll
            for (int m = 0; m < 4; ++m) {
                const int row = u.pm * BM + ai * HALF + wr * 64 + m * 16 + fr;
                const float* rp = (row < split ? r0 + (size_t)row * 1024 : r1 + (size_t)(row - split) * 1024) + col0;
                float* op = O + (size_t)row * 1024 + col0;
#pragma unroll
                for (int bj = 0; bj < 2; ++bj)
#pragma unroll
                    for (int n = 0; n < 2; ++n) { const f32x4 x = *(const f32x4*)(rp + bj * HALF + n * 16); *(f32x4*)(op + bj * HALF + n * 16) = acc[ai][bj][m][n] + x; }
            }
    }
};
struct EpiSwiglu {
    static constexpr bool PERM = true, AFTER_DRAIN = false;
    bf16_t* O;
    __device__ __forceinline__ void operator()(const f32x4 (&acc)[2][2][4][2], const Unit& u, int wr, int wc, int fr, int fq) const {
        const int col0 = u.pn * HALF + wc * 32 + 8 * fq;
#pragma unroll
        for (int ai = 0; ai < 2; ++ai)
#pragma unroll
            for (int m = 0; m < 4; ++m) {
                const int row = u.pm * BM + ai * HALF + wr * 64 + m * 16 + fr;
                float o[8];
#pragma unroll
                for (int n = 0; n < 2; ++n)
#pragma unroll
                    for (int e = 0; e < 4; ++e) { const float g = acc[ai][0][m][n][e], up = acc[ai][1][m][n][e]; o[4 * n + e] = g * sigmoidf_(g) * up; }
                u32x4 w; w.x = cvt_pk_bf16(o[0], o[1]); w.y = cvt_pk_bf16(o[2], o[3]); w.z = cvt_pk_bf16(o[4], o[5]); w.w = cvt_pk_bf16(o[6], o[7]);
                *(u32x4*)(O + (size_t)row * DFF + col0) = w;
            }
    }
};
struct SplitOrder {
    int pm0, npm, nN, nkc, G, c;
    __device__ bool next(int i, Unit& u) const {
        const long L = (long)i * G + (G - 1 - c); if (L >= (long)npm * nN * nkc) return false;
        const int l = (int)L; u.kc = l % nkc; const int t = l / nkc; u.pn = t % nN; u.pm = pm0 + t / nN; return true;
    }
    __device__ __forceinline__ void a_ready(const Unit&) const {}
    __device__ __forceinline__ void done(const Unit&) const {}
};
struct EpiPartial {
    static constexpr bool PERM = false, AFTER_DRAIN = false;
    float* PB; int row0;
    __device__ __forceinline__ void operator()(const f32x4 (&acc)[2][2][4][2], const Unit& u, int wr, int wc, int fr, int fq) const {
        const int col0 = u.pn * BM + wc * 32 + 4 * fq;
        float* base = PB + ((size_t)u.kc * 1024 + (u.pm * BM + wr * 64 + fr - row0)) * 1024 + col0;
#pragma unroll
        for (int ai = 0; ai < 2; ++ai)
#pragma unroll
            for (int m = 0; m < 4; ++m) {
                float* op = base + (size_t)(ai * HALF + m * 16) * 1024;
#pragma unroll
                for (int bj = 0; bj < 2; ++bj)
#pragma unroll
                    for (int n = 0; n < 2; ++n) *(f32x4*)(op + bj * HALF + n * 16) = acc[ai][bj][m][n];
            }
    }
};
}

__device__ __forceinline__ float wsrc(const P& p, int mat, int n, int k) {
    switch (mat) {
    case 0: return n < INCOLS ? p.w_in[(size_t)k * INCOLS + n] : 0.f;
    case 1: return p.w_qup[(size_t)k * 768 + n];
    case 2: { const int pn = n >> 8, bj = (n >> 7) & 1, wc = (n >> 5) & 3, x = n & 31, slot = pn * 4 + wc;
              const int c = (slot & 7) * 128 + (slot < 8 ? 0 : 64) + 32 * bj + x;
              return p.w_kvup[(size_t)k * 1024 + c]; }
    case 3: { if (n < 512) return k < 64 ? p.w2[(size_t)k * 512 + n] : 0.f;
              if (n < 1024) return (k >= 64 && k < 128) ? p.a2[(size_t)(k - 64) * 512 + (n - 512)] : 0.f;
              return k >= 128 ? p.g2[(size_t)(k - 128) * 512 + (n - 1024)] : 0.f; }
    case 4: return p.w_out[(size_t)k * 1024 + n];
    case 5: { const int pn = n >> 8, r = n & 255; return r < 128 ? p.w_gate[(size_t)k * DFF + pn * 128 + r] : p.w_up[(size_t)k * DFF + pn * 128 + r - 128]; }
    default: return p.w_down[(size_t)k * 1024 + n];
    }
}
__device__ __forceinline__ const float* xn_src(const P& p, int row) {
    if (row < MP) { const int b = row / LP, t = row % LP; return t < NMETA ? p.meta + (size_t)t * DM : p.xp + ((size_t)b * SEQ + (t - NMETA)) * DM; }
    return p.xs + (size_t)(row - MP) * DM;
}
__device__ __forceinline__ void phase_e0(const P& p, int wv, LAS unsigned char* lds) {
    LAS float* T = (LAS float*)lds;
    const int tid_l = wv * 64 + lane_id(); const int tid = tid_l, lane = tid & 63, wave = tid >> 6;
    constexpr int NT = 3120;
#define E0_DECODE(T_, mat, K, n0, k0, dst) do { int r_; \
        if ((T_) < 576)       { mat = 0; r_ = (T_);        K = 1024; dst = (bf16_t*)(p.ws + WS_WIN); } \
        else if ((T_) < 624)  { mat = 1; r_ = (T_) - 576;  K = 256;  dst = (bf16_t*)(p.ws + WS_WQ); } \
        else if ((T_) < 656)  { mat = 2; r_ = (T_) - 624;  K = 128;  dst = (bf16_t*)(p.ws + WS_WKV); } \
        else if ((T_) < 752)  { mat = 3; r_ = (T_) - 656;  K = 256;  dst = (bf16_t*)(p.ws + WS_WL); } \
        else if ((T_) < 1008) { mat = 4; r_ = (T_) - 752;  K = 1024; dst = (bf16_t*)(p.ws + WS_WOUT); } \
        else if ((T_) < 2416) { mat = 5; r_ = (T_) - 1008; K = 1024; dst = (bf16_t*)(p.ws + WS_WGU); } \
        else                  { mat = 6; r_ = (T_) - 2416; K = 2816; dst = (bf16_t*)(p.ws + WS_WDN); } \
        const int nkt_ = K / 64; n0 = (r_ / nkt_) * 64; k0 = (r_ % nkt_) * 64; } while (0)
    {
        float v[8];
        int t = blockIdx.x;
        if (t < NT) { int mat, K, n0, k0; bf16_t* dst; E0_DECODE(t, mat, K, n0, k0, dst); (void)dst;
#pragma unroll
            for (int i = 0; i < 8; ++i) v[i] = wsrc(p, mat, n0 + (tid & 63), k0 + (tid >> 6) + 8 * i); }
        for (; t < NT; t += gridDim.x) {
            int mat, K, n0, k0; bf16_t* dst; E0_DECODE(t, mat, K, n0, k0, dst); (void)mat;
#pragma unroll
            for (int i = 0; i < 8; ++i) T[((tid >> 6) + 8 * i) * 65 + (tid & 63)] = v[i];
            __syncthreads();
            const int tn = t + gridDim.x;
            if (tn < NT) { int mat2, K2, n02, k02; bf16_t* dst2; E0_DECODE(tn, mat2, K2, n02, k02, dst2); (void)dst2;
#pragma unroll
                for (int i = 0; i < 8; ++i) v[i] = wsrc(p, mat2, n02 + (tid & 63), k02 + (tid >> 6) + 8 * i); }
#pragma unroll
            for (int i = 0; i < 4; ++i) { const int n = (tid >> 5) + 16 * i, kq = tid & 31;
                *(unsigned*)(dst + (size_t)(n0 + n) * K + k0 + 2 * kq) = pk2(T[(2 * kq) * 65 + n], T[(2 * kq + 1) * 65 + n]); }
            __syncthreads();
        }
    }
#undef E0_DECODE
    bf16_t* XN = (bf16_t*)(p.ws + WS_XN);
    f32x4 g[4];
#pragma unroll
    for (int j = 0; j < 4; ++j) g[j] = *(const f32x4*)(p.g_mix + 4 * lane + 256 * j);
    const int xstride = gridDim.x * 8;
    for (int row = blockIdx.x * 8 + wave; row < M1; row += 2 * xstride) {
        const int rowb = row + xstride; const bool hb = rowb < M1;
        const float* sa = xn_src(p, row); const float* sb = xn_src(p, hb ? rowb : row);
        f32x4 va[4], vb[4]; float ssa = 0.f, ssb = 0.f;
#pragma unroll
        for (int j = 0; j < 4; ++j) { va[j] = *(const f32x4*)(sa + 4 * lane + 256 * j); vb[j] = *(const f32x4*)(sb + 4 * lane + 256 * j); }
#pragma unroll
        for (int j = 0; j < 4; ++j) { ssa += (va[j][0] * va[j][0] + va[j][1] * va[j][1]) + (va[j][2] * va[j][2] + va[j][3] * va[j][3]);
                                      ssb += (vb[j][0] * vb[j][0] + vb[j][1] * vb[j][1]) + (vb[j][2] * vb[j][2] + vb[j][3] * vb[j][3]); }
        const float rsa = rsqrtf(wave_sum(ssa) * (1.0f / DM) + EPS), rsb = rsqrtf(wave_sum(ssb) * (1.0f / DM) + EPS);
#pragma unroll
        for (int j = 0; j < 4; ++j) { const f32x4 o = va[j] * g[j] * rsa; u32x2 w; w.x = pk2(o[0], o[1]); w.y = pk2(o[2], o[3]);
            *(u32x2*)(XN + (size_t)row * DM + 4 * lane + 256 * j) = w; }
        if (hb) {
#pragma unroll
            for (int j = 0; j < 4; ++j) { const f32x4 o = vb[j] * g[j] * rsb; u32x2 w; w.x = pk2(o[0], o[1]); w.y = pk2(o[2], o[3]);
                *(u32x2*)(XN + (size_t)rowb * DM + 4 * lane + 256 * j) = w; } }
    }
}

struct E1Raw { u32x2 q; unsigned c, kr; u32x2 cur[7], prv[7]; };
__device__ __forceinline__ void e1_load(E1Raw& R, const bf16_t* PROJ, int row, int lane) {
    const bf16_t* pr = PROJ + (size_t)row * NPROJ;
    R.q = *(const u32x2*)(pr + 4 * lane); R.c = *(const unsigned*)(pr + 256 + 2 * lane); R.kr = pr[384 + (lane & 31)];
#pragma unroll
    for (int idx = 0; idx < 7; ++idx) R.cur[idx] = *(const u32x2*)(pr + RW0 + 4 * lane + 256 * idx);
    const bool nofirst = row < MP ? (row % LP != 0) : (((row - MP) & 31) != 0);
#pragma unroll
    for (int idx = 0; idx < 7; ++idx) R.prv[idx] = nofirst ? *(const u32x2*)(pr - NPROJ + RW0 + 4 * lane + 256 * idx) : (u32x2){0u, 0u};
}
__device__ __forceinline__ void e1_finish(const P& p, const E1Raw& R, int row, int lane, f32x4 gq, f32x2 gkv, float gkr) {
    bf16_t* QL = (bf16_t*)(p.ws + WS_QL); bf16_t* CALL = (bf16_t*)(p.ws + WS_CALL); bf16_t* KRALL = (bf16_t*)(p.ws + WS_KRALL);
    bf16_t* RKV = (bf16_t*)(p.ws + WS_RKV); bf16_t* LIN = (bf16_t*)(p.ws + WS_LIN);
    const bool isP = row < MP;
        int b, t; if (isP) { b = row / LP; t = row % LP; } else { b = (row - MP) >> 5; t = (row - MP) & 31; }
        const int rowk = isP ? b * KPB + 48 + t : MKP + b * KSAMP + PAST + t;
        const float pos = isP ? (float)t : (float)(PAST + t);
        { const u32x2 raw = R.q; const float x0 = bflo(raw.x), x1 = bfhi(raw.x), x2 = bflo(raw.y), x3 = bfhi(raw.y);
          const float rs = rsqrtf(wave_sum((x0 * x0 + x1 * x1) + (x2 * x2 + x3 * x3)) * (1.0f / 256.0f) + EPS);
          u32x2 w; w.x = pk2(x0 * rs * gq[0], x1 * rs * gq[1]); w.y = pk2(x2 * rs * gq[2], x3 * rs * gq[3]);
          *(u32x2*)(QL + (size_t)row * 256 + 4 * lane) = w; }
        { const unsigned raw = R.c; const float x0 = bflo(raw), x1 = bfhi(raw);
          const float rs = rsqrtf(wave_sum(x0 * x0 + x1 * x1) * (1.0f / 128.0f) + EPS);
          const float c0 = x0 * rs * gkv[0], c1 = x1 * rs * gkv[1];
          float* dst = isP ? p.out + OFF_KVP + ((size_t)b * LP + t) * 128 : p.out + OFF_KVS + ((size_t)b * DSQ + t) * 128;
          *(f32x2*)(dst + 2 * lane) = (f32x2){c0, c1};
          *(unsigned*)(CALL + (size_t)rowk * 128 + 2 * lane) = pk2(c0, c1); }
        { const int j = lane & 31; const float x = bf2f(R.kr);
          float ss = x * x; ss += __shfl_xor(ss, 1); ss += __shfl_xor(ss, 2); ss += __shfl_xor(ss, 4); ss += __shfl_xor(ss, 8); ss += __shfl_xor(ss, 16);
          const float y = x * rsqrtf(ss * (1.0f / 32.0f) + EPS) * gkr;
          const float pa = __shfl_xor(y, 16);
          float c, s; rope_cs(pos, j & 15, c, s);
          const float o = j < 16 ? y * c - pa * s : pa * s + y * c;
          if (lane < 32) {
              float* dst = isP ? p.out + OFF_KRP + ((size_t)b * LP + t) * 32 : p.out + OFF_KRS + ((size_t)b * DSQ + t) * 32;
              dst[j] = o; KRALL[(size_t)rowk * 32 + j] = (bf16_t)(pk2(o, 0.f) & 0xffffu);
          } }
        const bool first = (t == 0), last = isP ? (t == LP - 1) : (t == DSQ - 1);
        float* shdst = isP ? p.out + OFF_SHP + (size_t)b * RWC : p.out + OFF_SHS + (size_t)b * RWC;
#pragma unroll
        for (int idx = 0; idx < 7; ++idx) {
            const int c = 4 * lane + 256 * idx;
            const u32x2 raw = R.cur[idx];
            const f32x4 cur = {bflo(raw.x), bfhi(raw.x), bflo(raw.y), bfhi(raw.y)};
            f32x4 prev;
            if (first) { if (isP) prev = (f32x4){0.f, 0.f, 0.f, 0.f}; else prev = *(const f32x4*)(p.sshift + (size_t)b * RWC + c); }
            else { const u32x2 rp = R.prv[idx]; prev = (f32x4){bflo(rp.x), bfhi(rp.x), bflo(rp.y), bfhi(rp.y)}; }
            const f32x4 mu = *(const f32x4*)(p.mu + c);
            f32x4 xm = cur + (prev - cur) * mu;
            if (last) *(f32x4*)(shdst + c) = cur;
            if (idx < 6) { u32x2 w; w.x = pk2(xm[0], xm[1]); w.y = pk2(xm[2], xm[3]); *(u32x2*)(RKV + (size_t)row * 1536 + c) = w; }
            else {
                const int lc = 4 * lane;
                if (lc < 64) {
#pragma unroll
                    for (int e = 0; e < 4; ++e) xm[e] = tanhf(xm[e]); }
                else if (lc >= 128) {
#pragma unroll
                    for (int e = 0; e < 4; ++e) xm[e] = sigmoidf_(xm[e]); }
                u32x2 w; w.x = pk2(xm[0], xm[1]); w.y = pk2(xm[2], xm[3]); *(u32x2*)(LIN + (size_t)row * 256 + lc) = w;
            }
        }
    }
__device__ __forceinline__ void phase_e1(const P& p, int wv) {
    const int tid_l = wv * 64 + lane_id(); const int tid = tid_l, lane = tid & 63, wave = tid >> 6;
    const bf16_t* PROJ = (const bf16_t*)(p.ws + WS_PROJ);
    bf16_t* QL = (bf16_t*)(p.ws + WS_QL); bf16_t* CALL = (bf16_t*)(p.ws + WS_CALL); bf16_t* KRALL = (bf16_t*)(p.ws + WS_KRALL);
    bf16_t* RKV = (bf16_t*)(p.ws + WS_RKV); bf16_t* LIN = (bf16_t*)(p.ws + WS_LIN);
    {
        const size_t gt = (size_t)blockIdx.x * 512 + tid, gs = (size_t)gridDim.x * 512;
        {
            constexpr size_t NV1 = (size_t)NB * PAST * 128 / 4, NV2 = (size_t)NB * PAST * 32 / 4;
            for (size_t e = gt; e < NV1; e += 4 * gs) {
                f32x4 v[4];
#pragma unroll
                for (int u = 0; u < 4; ++u) { const size_t ee = e + u * gs; v[u] = ee < NV1 ? *(const f32x4*)(p.ckv + ee * 4) : (f32x4){0.f, 0.f, 0.f, 0.f}; }
#pragma unroll
                for (int u = 0; u < 4; ++u) { const size_t ee = e + u * gs; if (ee < NV1) { const size_t idx = ee * 4; const int b = (int)(idx / ((size_t)PAST * 128)); const size_t rem = idx - (size_t)b * PAST * 128;
                    u32x2 w; w.x = pk2(v[u][0], v[u][1]); w.y = pk2(v[u][2], v[u][3]); *(u32x2*)(CALL + ((size_t)MKP + (size_t)b * KSAMP) * 128 + rem) = w; } }
            }
            for (size_t e = gt; e < NV2; e += 4 * gs) {
                f32x4 v[4];
#pragma unroll
                for (int u = 0; u < 4; ++u) { const size_t ee = e + u * gs; v[u] = ee < NV2 ? *(const f32x4*)(p.ckr + ee * 4) : (f32x4){0.f, 0.f, 0.f, 0.f}; }
#pragma unroll
                for (int u = 0; u < 4; ++u) { const size_t ee = e + u * gs; if (ee < NV2) { const size_t idx = ee * 4; const int b = (int)(idx / ((size_t)PAST * 32)); const size_t rem = idx - (size_t)b * PAST * 32;
                    u32x2 w; w.x = pk2(v[u][0], v[u][1]); w.y = pk2(v[u][2], v[u][3]); *(u32x2*)(KRALL + ((size_t)MKP + (size_t)b * KSAMP) * 32 + rem) = w; } }
            }
        }
        for (size_t e = gt; e < (size_t)NB * 48 * 128 / 4; e += gs) {
            const size_t idx = e * 4; const int b = (int)(idx / (48 * 128)); const size_t rem = idx - (size_t)b * 48 * 128;
            *(u32x2*)(CALL + (size_t)b * KPB * 128 + rem) = (u32x2){0u, 0u};
        }
        for (size_t e = gt; e < (size_t)NB * 48 * 32 / 4; e += gs) {
            const size_t idx = e * 4; const int b = (int)(idx / (48 * 32)); const size_t rem = idx - (size_t)b * 48 * 32;
            *(u32x2*)(KRALL + (size_t)b * KPB * 32 + rem) = (u32x2){0u, 0u};
        }
    }
    const f32x4 gq = *(const f32x4*)(p.g_q + 4 * lane);
    const f32x2 gkv = *(const f32x2*)(p.g_kv + 2 * lane);
    const float gkr = p.g_kr[lane & 31];
    const int e1stride = gridDim.x * 8;
    for (int row = blockIdx.x * 8 + wave; row < M1; row += 2 * e1stride) {
        const int rowb = row + e1stride; const bool hb = rowb < M1;
        E1Raw ra, rb;
        e1_load(ra, PROJ, row, lane); e1_load(rb, PROJ, hb ? rowb : row, lane);
        e1_finish(p, ra, row, lane, gq, gkv, gkr);
        if (hb) e1_finish(p, rb, rowb, lane, gq, gkv, gkr);
    }

}

template <int CTRL> __device__ __forceinline__ float dppf(float v) { return __uint_as_float(__builtin_amdgcn_update_dpp(0u, __float_as_uint(v), CTRL, 0xF, 0xF, true)); }
__device__ __forceinline__ float red8(float v) { v += dppf<0xB1>(v); v += dppf<0x4E>(v); v += dppf<0x141>(v); return v; }
__device__ __forceinline__ float red16d(float v) { v += dppf<0xB1>(v); v += dppf<0x4E>(v); v += dppf<0x141>(v); v += dppf<0x140>(v); return v; }

struct ScanPre { u32x2 r, k, v, lw, la, g; };
struct ScanKeep { f32x4 v; float bon; u32x2 g; };
struct ScanConst { f32x4 kk, ka, rk, lg, lb, w0, a0; };
constexpr int SC_BUF = 12416;

__device__ __forceinline__ void scan_load(ScanPre& q, const bf16_t* RKV, const bf16_t* LO, size_t row, int hc) {
    q.r = *(const u32x2*)(RKV + row * 1536 + hc); q.k = *(const u32x2*)(RKV + row * 1536 + 512 + hc); q.v = *(const u32x2*)(RKV + row * 1536 + 1024 + hc);
    q.lw = *(const u32x2*)(LO + row * 1536 + hc); q.la = *(const u32x2*)(LO + row * 1536 + 512 + hc); q.g = *(const u32x2*)(LO + row * 1536 + 1024 + hc);
}
__device__ __forceinline__ void scan_stage_a(const ScanPre& q, const ScanConst& C, LAS float* buf, int tt, int dq, ScanKeep& keep) {
    const f32x4 r = {bflo(q.r.x), bfhi(q.r.x), bflo(q.r.y), bfhi(q.r.y)}, k = {bflo(q.k.x), bfhi(q.k.x), bflo(q.k.y), bfhi(q.k.y)}, v = {bflo(q.v.x), bfhi(q.v.x), bflo(q.v.y), bfhi(q.v.y)};
    const f32x4 lw = (f32x4){bflo(q.lw.x), bfhi(q.lw.x), bflo(q.lw.y), bfhi(q.lw.y)} + C.w0, la = (f32x4){bflo(q.la.x), bfhi(q.la.x), bflo(q.la.y), bfhi(q.la.y)} + C.a0;
    f32x4 w, a;
#pragma unroll
    for (int c = 0; c < 4; ++c) { w[c] = __expf(-0.6065306597126334f * sigmoidf_(lw[c])); a[c] = sigmoidf_(la[c]); }
    const f32x4 kkr = k * C.kk;
    const float ss = red16d((kkr[0] * kkr[0] + kkr[1] * kkr[1]) + (kkr[2] * kkr[2] + kkr[3] * kkr[3]));
    const float inv = 1.0f / fmaxf(sqrtf(ss), 1e-12f);
    const f32x4 kk = kkr * inv;
    const f32x4 keff = k * (1.0f + (a - 1.0f) * C.ka);
    const f32x4 bb = a * kk, wr = w * r;
    const f32x4 t1 = bb * r, t2 = keff * r, t3 = t2 * C.rk;
    const float br = red16d((t1[0] + t1[1]) + (t1[2] + t1[3])), kr = red16d((t2[0] + t2[1]) + (t2[2] + t2[3])), bon = red16d((t3[0] + t3[1]) + (t3[2] + t3[3]));
    const int o = tt * 64 + 4 * dq;
    *(LAS f32x4*)(buf + o) = w; *(LAS f32x4*)(buf + 2048 + o) = bb; *(LAS f32x4*)(buf + 4096 + o) = keff; *(LAS f32x4*)(buf + 6144 + o) = kk; *(LAS f32x4*)(buf + 8192 + o) = wr; *(LAS f32x4*)(buf + 10240 + o) = v;
    if (dq == 0) *(LAS f32x4*)(buf + 12288 + tt * 4) = (f32x4){br, kr, bon, 0.f};
    keep.v = v; keep.bon = bon; keep.g = q.g;
}

struct ScanVec { f32x4 k0, k1, q0, q1, w0, w1, b0, b1, e0, e1, sc; float vi0, vi1; };
#define SV_DSR128(dst, addr, off) asm volatile("ds_read_b128 %0, %1 offset:" #off : "=v"(dst) : "v"(addr))
#define SV_DSR32(dst, addr, off) asm volatile("ds_read_b32 %0, %1 offset:" #off : "=v"(dst) : "v"(addr))
__device__ __forceinline__ void sv_issue(ScanVec& s, unsigned a_vec, unsigned a_sc, unsigned a_v) {
    SV_DSR128(s.k0, a_vec, 24576); SV_DSR128(s.k1, a_vec, 24592); SV_DSR128(s.q0, a_vec, 32768); SV_DSR128(s.q1, a_vec, 32784);
    SV_DSR128(s.sc, a_sc, 49152); SV_DSR32(s.vi0, a_v, 40960); SV_DSR32(s.vi1, a_v, 41088);
    SV_DSR128(s.w0, a_vec, 0); SV_DSR128(s.w1, a_vec, 16); SV_DSR128(s.b0, a_vec, 8192); SV_DSR128(s.b1, a_vec, 8208);
    SV_DSR128(s.e0, a_vec, 16384); SV_DSR128(s.e1, a_vec, 16400);
}
__device__ __forceinline__ void sv_wait(ScanVec& s) {
    asm volatile("s_waitcnt lgkmcnt(0)" : "+v"(s.k0), "+v"(s.k1), "+v"(s.q0), "+v"(s.q1), "+v"(s.w0), "+v"(s.w1), "+v"(s.b0), "+v"(s.b1), "+v"(s.e0), "+v"(s.e1), "+v"(s.sc), "+v"(s.vi0), "+v"(s.vi1));
}
__device__ __forceinline__ f32x2 lo2(f32x4 v) { return __builtin_shufflevector(v, v, 0, 1); }
__device__ __forceinline__ f32x2 hi2(f32x4 v) { return __builtin_shufflevector(v, v, 2, 3); }
__device__ __forceinline__ f32x2 fma2(f32x2 a, f32x2 b, f32x2 c) { return __builtin_elementwise_fma(a, b, c); }
__device__ __forceinline__ float sv_row(f32x2 (&S)[4], const ScanVec& s, float vi) {
    f32x2 a1 = S[0] * lo2(s.k0), a2 = S[0] * lo2(s.q0);
    a1 = fma2(S[1], hi2(s.k0), a1); a2 = fma2(S[1], hi2(s.q0), a2);
    a1 = fma2(S[2], lo2(s.k1), a1); a2 = fma2(S[2], lo2(s.q1), a2);
    a1 = fma2(S[3], hi2(s.k1), a1); a2 = fma2(S[3], hi2(s.q1), a2);
    const float d1 = red8(a1.x + a1.y), d2 = red8(a2.x + a2.y);
    const float sa = -d1;
    const float y = d2 + sa * s.sc[0] + vi * s.sc[1];
    const f32x2 sa2 = {sa, sa}, vi2 = {vi, vi};
    S[0] = fma2(S[0], lo2(s.w0), fma2(sa2, lo2(s.b0), vi2 * lo2(s.e0)));
    S[1] = fma2(S[1], hi2(s.w0), fma2(sa2, hi2(s.b0), vi2 * hi2(s.e0)));
    S[2] = fma2(S[2], lo2(s.w1), fma2(sa2, lo2(s.b1), vi2 * lo2(s.e1)));
    S[3] = fma2(S[3], hi2(s.w1), fma2(sa2, hi2(s.b1), vi2 * hi2(s.e1)));
    return y;
}
__device__ __forceinline__ void sv_step(f32x2 (&S0)[4], f32x2 (&S1)[4], const ScanVec& s, LAS float* Yc, int t, int i2, int j) {
    const float y0 = sv_row(S0, s, s.vi0), y1 = sv_row(S1, s, s.vi1);
    if (j == 0) { Yc[t * 64 + i2] = y0; Yc[t * 64 + 32 + i2] = y1; }
}
__device__ __forceinline__ void scan_stage_c(const ScanConst& C, const LAS float* buf, const LAS float* Yc, int tl, int dq, bool valid, u32x2 graw, bf16_t* dst) {
    const f32x4 y = *(const LAS f32x4*)(Yc + tl * 64 + 4 * dq);
    const float mean = red16d((y[0] + y[1]) + (y[2] + y[3])) * (1.0f / 64.0f);
    const f32x4 d = y - mean;
    const float var = red16d((d[0] * d[0] + d[1] * d[1]) + (d[2] * d[2] + d[3] * d[3])) * (1.0f / 64.0f);
    const f32x4 v = *(const LAS f32x4*)(buf + 10240 + tl * 64 + 4 * dq);
    const float bon = buf[12288 + tl * 4 + 2];
    if (valid) {
        const float rstd = rsqrtf(var + LNX_EPS);
        const f32x4 g = {bflo(graw.x), bfhi(graw.x), bflo(graw.y), bfhi(graw.y)};
        const f32x4 o = (d * rstd * C.lg + C.lb + v * bon) * g;
        u32x2 w; w.x = pk2(o[0], o[1]); w.y = pk2(o[2], o[3]);
        *(u32x2*)dst = w;
    }
}

__device__ __forceinline__ void scan_unit(const P& p, int wv, LAS unsigned char* lds, int row1_base, int nsteps, const float* s0, float* s_out, int first_out, int row2_base, int h) {
    const int tid_l = wv * 64 + lane_id(); const int tid = tid_l;
    const bool is_rec = tid < 256;
    LAS float* BUF = (LAS float*)lds;
    LAS float* Y = BUF + 2 * SC_BUF;
    const bf16_t* RKV = (const bf16_t*)(p.ws + WS_RKV); const bf16_t* LO = (const bf16_t*)(p.ws + WS_E);
    bf16_t* MIX = (bf16_t*)(p.ws + WS_MIX);
    const int nch = (nsteps + 31) >> 5;
    __syncthreads();
    if (is_rec) {
        const int i2 = tid >> 3, j = tid & 7;
        f32x2 S0[4], S1[4];
        if (s0) { const f32x4 a = *(const f32x4*)(s0 + i2 * 64 + 8 * j), b = *(const f32x4*)(s0 + i2 * 64 + 8 * j + 4), c = *(const f32x4*)(s0 + (i2 + 32) * 64 + 8 * j), d = *(const f32x4*)(s0 + (i2 + 32) * 64 + 8 * j + 4);
            S0[0] = lo2(a); S0[1] = hi2(a); S0[2] = lo2(b); S0[3] = hi2(b); S1[0] = lo2(c); S1[1] = hi2(c); S1[2] = lo2(d); S1[3] = hi2(d); }
        else {
#pragma unroll
            for (int cc = 0; cc < 4; ++cc) { S0[cc] = (f32x2){0.f, 0.f}; S1[cc] = (f32x2){0.f, 0.f}; } }
        const unsigned lbase = (unsigned)(unsigned long long)BUF;
        __syncthreads();
        for (int c = 0; c < nch; ++c) {
            const int c0 = c * 32, T = (nsteps - c0) < 32 ? (nsteps - c0) : 32;
            LAS float* Yc = Y + (c & 1) * 2048;
            const unsigned bb = lbase + (unsigned)(c & 1) * (SC_BUF * 4u);
            unsigned a_vec = bb + 32u * j, a_sc = bb, a_v = bb + 4u * i2;
            ScanVec va, vb;
            sv_issue(va, a_vec, a_sc, a_v); sv_wait(va);
            for (int t = 0; t < T; t += 2) {
                sv_issue(vb, a_vec + 256u, a_sc + 16u, a_v + 256u);
                sv_step(S0, S1, va, Yc, t, i2, j);
                sv_wait(vb);
                const unsigned adv = (t + 2 < T) ? 2u : 1u;
                a_vec += 256u * adv; a_sc += 16u * adv; a_v += 256u * adv;
                sv_issue(va, a_vec, a_sc, a_v);
                sv_step(S0, S1, vb, Yc, t + 1, i2, j);
                sv_wait(va);
            }
            __syncthreads();
        }
        float* so = s_out + i2 * 64 + 8 * j;
        *(f32x4*)so = (f32x4){S0[0].x, S0[0].y, S0[1].x, S0[1].y}; *(f32x4*)(so + 4) = (f32x4){S0[2].x, S0[2].y, S0[3].x, S0[3].y};
        *(f32x4*)(so + 2048) = (f32x4){S1[0].x, S1[0].y, S1[1].x, S1[1].y}; *(f32x4*)(so + 2052) = (f32x4){S1[2].x, S1[2].y, S1[3].x, S1[3].y};
    } else {
        const int ptid = tid - 256, tt = ptid >> 4, dq = ptid & 15, hc = h * 64 + 4 * dq;
        ScanConst C;
        C.kk = *(const f32x4*)(p.k_k + hc); C.ka = *(const f32x4*)(p.k_a + hc); C.rk = *(const f32x4*)(p.r_k + hc);
        C.lg = *(const f32x4*)(p.lnx_g + hc); C.lb = *(const f32x4*)(p.lnx_b + hc); C.w0 = *(const f32x4*)(p.w0 + hc); C.a0 = *(const f32x4*)(p.a0 + hc);
        ScanPre pa, pb; ScanKeep kdummy;
        pa.r = pa.k = pa.v = pa.lw = pa.la = pa.g = (u32x2){0u, 0u}; pb = pa;
        if (tt < nsteps) scan_load(pa, RKV, LO, (size_t)(row1_base + tt), hc);
        if (tt + 16 < nsteps) scan_load(pb, RKV, LO, (size_t)(row1_base + tt + 16), hc);
        if (tt < nsteps) scan_stage_a(pa, C, BUF, tt, dq, kdummy);
        if (tt + 16 < nsteps) scan_stage_a(pb, C, BUF, tt + 16, dq, kdummy);
        if (32 + tt < nsteps) scan_load(pa, RKV, LO, (size_t)(row1_base + 32 + tt), hc);
        if (48 + tt < nsteps) scan_load(pb, RKV, LO, (size_t)(row1_base + 48 + tt), hc);
        __syncthreads();
        for (int c = 0; c < nch; ++c) {
            const int c0 = c * 32;
            if (c >= 1) {
                const int pc0 = c0 - 32; const LAS float* bufp = BUF + ((c - 1) & 1) * SC_BUF; const LAS float* Yp = Y + ((c - 1) & 1) * 2048;
                const int tok0 = pc0 + tt, tok1 = pc0 + tt + 16;
                const bool v0 = tok0 >= first_out, v1 = tok1 >= first_out;
                u32x2 g0 = {0u, 0u}, g1 = {0u, 0u};
                if (v0) g0 = *(const u32x2*)(LO + (size_t)(row1_base + tok0) * 1536 + 1024 + hc);
                if (v1) g1 = *(const u32x2*)(LO + (size_t)(row1_base + tok1) * 1536 + 1024 + hc);
                scan_stage_c(C, bufp, Yp, tt, dq, v0, g0, MIX + (size_t)(row2_base + tok0 - first_out) * 1024 + 512 + hc);
                scan_stage_c(C, bufp, Yp, tt + 16, dq, v1, g1, MIX + (size_t)(row2_base + tok1 - first_out) * 1024 + 512 + hc);
            }
            if (c0 + 32 + tt < nsteps) scan_stage_a(pa, C, BUF + ((c + 1) & 1) * SC_BUF, tt, dq, kdummy);
            if (c0 + 48 + tt < nsteps) scan_stage_a(pb, C, BUF + ((c + 1) & 1) * SC_BUF, tt + 16, dq, kdummy);
            if (c0 + 64 + tt < nsteps) scan_load(pa, RKV, LO, (size_t)(row1_base + c0 + 64 + tt), hc);
            if (c0 + 80 + tt < nsteps) scan_load(pb, RKV, LO, (size_t)(row1_base + c0 + 80 + tt), hc);
            __syncthreads();
        }
        {
            const int c = nch - 1, pc0 = c * 32, T = nsteps - pc0; const LAS float* bufp = BUF + (c & 1) * SC_BUF; const LAS float* Yp = Y + (c & 1) * 2048;
            const int tok0 = pc0 + tt, tok1 = pc0 + tt + 16;
            const bool v0 = tt < T && tok0 >= first_out, v1 = tt + 16 < T && tok1 >= first_out;
            u32x2 g0 = {0u, 0u}, g1 = {0u, 0u};
            if (v0) g0 = *(const u32x2*)(LO + (size_t)(row1_base + tok0) * 1536 + 1024 + hc);
            if (v1) g1 = *(const u32x2*)(LO + (size_t)(row1_base + tok1) * 1536 + 1024 + hc);
            scan_stage_c(C, bufp, Yp, tt, dq, v0, g0, MIX + (size_t)(row2_base + tok0 - first_out) * 1024 + 512 + hc);
            scan_stage_c(C, bufp, Yp, tt + 16, dq, v1, g1, MIX + (size_t)(row2_base + tok1 - first_out) * 1024 + 512 + hc);
        }
    }
}
__device__ __forceinline__ void phase_scan(const P& p, int wv, LAS unsigned char* lds) {
    for (int u = blockIdx.x; u < 512; u += gridDim.x) {
        const int uu = u & 255, b = uu >> 3, h = uu & 7;
        if (u < 256) scan_unit(p, wv, lds, b * LP, LP, nullptr, p.out + OFF_WKVP + (size_t)uu * 4096, NMETA, b * SEQ, h);
        else scan_unit(p, wv, lds, MP + b * DSQ, DSQ, p.swkv + (size_t)uu * 4096, p.out + OFF_WKVS + (size_t)uu * 4096, 0, M2P + b * DSQ, h);
    }
}

__device__ __forceinline__ int crow(int r, int hi) { return (r & 3) + 8 * (r >> 2) + 4 * hi; }
constexpr float ATT_THR = 12.0f;
__device__ __forceinline__ float xhalf_max(float v) { const auto rr = __builtin_amdgcn_permlane32_swap(__float_as_uint(v), __float_as_uint(v), false, false); return fmaxf(__uint_as_float(rr[0]), __uint_as_float(rr[1])); }
__device__ __forceinline__ float xhalf_sum(float v) { const auto rr = __builtin_amdgcn_permlane32_swap(__float_as_uint(v), __float_as_uint(v), false, false); return __uint_as_float(rr[0]) + __uint_as_float(rr[1]); }
__device__ __forceinline__ void att_blk(const LAS unsigned char* Kc, const LAS unsigned char* Vimg, const bf16x8 (&qf)[6], float& m, float& l, f32x16 (&O)[2], int lane, int nmask) {
    const int q = lane & 31, hi = lane >> 5;
    f32x16 s; const float nm = -m;
#pragma unroll
    for (int r = 0; r < 16; ++r) s[r] = nm;
#pragma unroll
    for (int i = 0; i < 6; ++i) { const bf16x8 kf = *(const LAS bf16x8*)(Kc + q * 208 + (16 * i + 8 * hi) * 2); s = __builtin_amdgcn_mfma_f32_32x32x16_bf16(kf, qf[i], s, 0, 0, 0); }
    if (nmask > 0) {
#pragma unroll
        for (int r = 0; r < 16; ++r) if (crow(r, hi) < nmask) s[r] = -1e30f; }
    float mx = fmaxf(s[0], s[1]);
#pragma unroll
    for (int r = 2; r < 16; r += 2) mx = fmaxf(fmaxf(mx, s[r]), s[r + 1]);
    if (__builtin_amdgcn_ballot_w64(mx > ATT_THR) != 0ull) {
        const float delta = fmaxf(xhalf_max(mx), 0.f), alpha = __builtin_amdgcn_exp2f(-delta);
        m += delta; l *= alpha;
#pragma unroll
        for (int r = 0; r < 16; ++r) { O[0][r] *= alpha; O[1][r] *= alpha; s[r] -= delta; }
    }
    float rsum = 0.f;
#pragma unroll
    for (int r = 0; r < 16; ++r) { s[r] = __builtin_amdgcn_exp2f(s[r]); rsum += s[r]; }
    l += rsum;
    bf16x8 pb[2];
#pragma unroll
    for (int i = 0; i < 2; ++i) { u32x4 w; w.x = pk2(s[8 * i + 0], s[8 * i + 1]); w.y = pk2(s[8 * i + 2], s[8 * i + 3]); w.z = pk2(s[8 * i + 4], s[8 * i + 5]); w.w = pk2(s[8 * i + 6], s[8 * i + 7]);
        pb[i] = __builtin_bit_cast(bf16x8, w); }
    typedef short v4i16_t __attribute__((ext_vector_type(4)));
    const int li = lane & 15, g16 = lane >> 4;
    const LAS unsigned char* vb = Vimg + (4 * hi + (li >> 2)) * 192 + (16 * (g16 & 1) + 4 * (li & 3)) * 2;
#pragma unroll
    for (int db = 0; db < 2; ++db)
#pragma unroll
        for (int i = 0; i < 2; ++i) {
            const v4i16_t lo = __builtin_amdgcn_ds_read_tr16_b64_v4i16((LAS v4i16_t*)(vb + (16 * i) * 192 + 64 * db));
            const v4i16_t hh = __builtin_amdgcn_ds_read_tr16_b64_v4i16((LAS v4i16_t*)(vb + (16 * i + 8) * 192 + 64 * db));
            const bf16x8 vf = {lo[0], lo[1], lo[2], lo[3], hh[0], hh[1], hh[2], hh[3]};
            O[db] = __builtin_amdgcn_mfma_f32_32x32x16_bf16(vf, pb[i], O[db], 0, 0, 0); }
}
__device__ __forceinline__ void att_tile64(const LAS unsigned char* Kc, const LAS unsigned char* Vimg, const bf16x8 (&qf)[6], float& m, float& l, f32x16 (&O)[2], int lane) {
    const int q = lane & 31, hi = lane >> 5;
    f32x16 s0, s1; const float nm = -m;
#pragma unroll
    for (int r = 0; r < 16; ++r) { s0[r] = nm; s1[r] = nm; }
#pragma unroll
    for (int i = 0; i < 6; ++i) {
        const bf16x8 k0 = *(const LAS bf16x8*)(Kc + q * 208 + (16 * i + 8 * hi) * 2), k1 = *(const LAS bf16x8*)(Kc + (32 + q) * 208 + (16 * i + 8 * hi) * 2);
        s0 = __builtin_amdgcn_mfma_f32_32x32x16_bf16(k0, qf[i], s0, 0, 0, 0); s1 = __builtin_amdgcn_mfma_f32_32x32x16_bf16(k1, qf[i], s1, 0, 0, 0); }
    float mx = fmaxf(s0[0], s1[0]);
#pragma unroll
    for (int r = 1; r < 16; ++r) mx = fmaxf(fmaxf(mx, s0[r]), s1[r]);
    if (__builtin_amdgcn_ballot_w64(mx > ATT_THR) != 0ull) {
        const float delta = fmaxf(xhalf_max(mx), 0.f), alpha = __builtin_amdgcn_exp2f(-delta);
        m += delta; l *= alpha;
#pragma unroll
        for (int r = 0; r < 16; ++r) { O[0][r] *= alpha; O[1][r] *= alpha; s0[r] -= delta; s1[r] -= delta; }
    }
    float rs0 = 0.f, rs1 = 0.f;
#pragma unroll
    for (int r = 0; r < 16; ++r) { s0[r] = __builtin_amdgcn_exp2f(s0[r]); s1[r] = __builtin_amdgcn_exp2f(s1[r]); rs0 += s0[r]; rs1 += s1[r]; }
    l += rs0 + rs1;
    bf16x8 pb[4];
#pragma unroll
    for (int i = 0; i < 2; ++i) { u32x4 w; w.x = pk2(s0[8 * i + 0], s0[8 * i + 1]); w.y = pk2(s0[8 * i + 2], s0[8 * i + 3]); w.z = pk2(s0[8 * i + 4], s0[8 * i + 5]); w.w = pk2(s0[8 * i + 6], s0[8 * i + 7]);
        pb[i] = __builtin_bit_cast(bf16x8, w);
        u32x4 x; x.x = pk2(s1[8 * i + 0], s1[8 * i + 1]); x.y = pk2(s1[8 * i + 2], s1[8 * i + 3]); x.z = pk2(s1[8 * i + 4], s1[8 * i + 5]); x.w = pk2(s1[8 * i + 6], s1[8 * i + 7]);
        pb[2 + i] = __builtin_bit_cast(bf16x8, x); }
    typedef short v4i16_t __attribute__((ext_vector_type(4)));
    const int li = lane & 15, g16 = lane >> 4;
    const LAS unsigned char* vb = Vimg + (4 * hi + (li >> 2)) * 192 + (16 * (g16 & 1) + 4 * (li & 3)) * 2;
#pragma unroll
    for (int i = 0; i < 4; ++i)
#pragma unroll
        for (int db = 0; db < 2; ++db) {
            const v4i16_t lo = __builtin_amdgcn_ds_read_tr16_b64_v4i16((LAS v4i16_t*)(vb + (16 * i) * 192 + 64 * db));
            const v4i16_t hh = __builtin_amdgcn_ds_read_tr16_b64_v4i16((LAS v4i16_t*)(vb + (16 * i + 8) * 192 + 64 * db));
            const bf16x8 vf = {lo[0], lo[1], lo[2], lo[3], hh[0], hh[1], hh[2], hh[3]};
            O[db] = __builtin_amdgcn_mfma_f32_32x32x16_bf16(vf, pb[i], O[db], 0, 0, 0); }
}
__device__ __forceinline__ int kpos(int key) { return (key & ~12) | ((key & 4) << 1) | ((key & 8) >> 1); }

__device__ __forceinline__ void load_q(bf16x8 (&qf)[6], const bf16_t* qrow, float pos, const float* gn, const float* gr, const float* gkn, int hi) {
    float x[6][8];
#pragma unroll
    for (int i = 0; i < 6; ++i) { const u32x4 raw = *(const u32x4*)(qrow + 16 * i + 8 * hi);
        x[i][0] = bflo(raw.x); x[i][1] = bfhi(raw.x); x[i][2] = bflo(raw.y); x[i][3] = bfhi(raw.y); x[i][4] = bflo(raw.z); x[i][5] = bfhi(raw.z); x[i][6] = bflo(raw.w); x[i][7] = bfhi(raw.w); }
    float ssn = 0.f, ssr = 0.f;
#pragma unroll
    for (int i = 0; i < 4; ++i)
#pragma unroll
        for (int e = 0; e < 8; ++e) ssn += x[i][e] * x[i][e];
#pragma unroll
    for (int i = 4; i < 6; ++i)
#pragma unroll
        for (int e = 0; e < 8; ++e) ssr += x[i][e] * x[i][e];
    ssn += __shfl_xor(ssn, 32); ssr += __shfl_xor(ssr, 32);
    const float rsn = rsqrtf(ssn * (1.0f / 64.0f) + EPS) * QSCALE, rsr = rsqrtf(ssr * (1.0f / 32.0f) + EPS) * QSCALE;
#pragma unroll
    for (int i = 0; i < 4; ++i) { float o[8];
#pragma unroll
        for (int e = 0; e < 8; ++e) o[e] = x[i][e] * rsn * (gn[16 * i + 8 * hi + e] * gkn[16 * i + 8 * hi + e]);
        u32x4 w; w.x = pk2(o[0], o[1]); w.y = pk2(o[2], o[3]); w.z = pk2(o[4], o[5]); w.w = pk2(o[6], o[7]); qf[i] = __builtin_bit_cast(bf16x8, w); }
    float o1[8], o2[8];
#pragma unroll
    for (int e = 0; e < 8; ++e) { const int j = 8 * hi + e; float c, s; rope_cs(pos, j, c, s);
        const float x1 = x[4][e] * rsr * gr[j], x2 = x[5][e] * rsr * gr[16 + j];
        o1[e] = x1 * c - x2 * s; o2[e] = x1 * s + x2 * c; }
    { u32x4 w; w.x = pk2(o1[0], o1[1]); w.y = pk2(o1[2], o1[3]); w.z = pk2(o1[4], o1[5]); w.w = pk2(o1[6], o1[7]); qf[4] = __builtin_bit_cast(bf16x8, w); }
    { u32x4 w; w.x = pk2(o2[0], o2[1]); w.y = pk2(o2[2], o2[3]); w.z = pk2(o2[4], o2[5]); w.w = pk2(o2[6], o2[7]); qf[5] = __builtin_bit_cast(bf16x8, w); }
}

constexpr int AT_KB = 64 * 208, AT_VB = 64 * 192, AT_BUF = AT_KB + AT_VB;
__device__ __forceinline__ void attn_prompt_unit(const P& p, int wv, LAS unsigned char* lds, int b, int h) {
    const int tid_l = wv * 64 + lane_id(); const int tid = tid_l, lane = tid & 63, w = tid >> 6, q = lane & 31, hi = lane >> 5;
    const bf16_t* Qb = (const bf16_t*)(p.ws + WS_Q); const bf16_t* KN = (const bf16_t*)(p.ws + WS_KN); const bf16_t* Vb = (const bf16_t*)(p.ws + WS_V);
    const bf16_t* KR = (const bf16_t*)(p.ws + WS_KRALL); bf16_t* ATT = (bf16_t*)(p.ws + WS_ATT);
    const int key = tid >> 3, part = tid & 7, key2 = tid >> 2, part2 = tid & 3;
    const size_t rowk_b = (size_t)b * KPB;
    for (int qt = 0; qt < 8; ++qt) {
        const size_t row1 = (size_t)b * LP + NMETA + 256 * qt + 32 * w + q;
        bf16x8 qf[6];
        load_q(qf, Qb + row1 * 768 + h * 96, (float)(NMETA + 256 * qt + 32 * w + q), p.g_qn, p.g_qr, p.g_kn, hi);
        const int cmax = 4 * qt + (w >> 1) + 1, ntile = 4 * qt + 5;
        float m = 0.f, l = 0.f; f32x16 O[2];
#pragma unroll
        for (int r = 0; r < 16; ++r) { O[0][r] = 0.f; O[1][r] = 0.f; }
        u32x4 rkn0, rkr0, rv0, rkn1, rkr1, rv1;
        rkr0 = rkr1 = (u32x4){0u, 0u, 0u, 0u};
#define AT_LOAD(S, JT) do { const size_t rk_ = rowk_b + 64 * (size_t)(JT); \
            rkn##S = *(const u32x4*)(KN + (rk_ + key) * 512 + h * 64 + 8 * part); rv##S = *(const u32x4*)(Vb + (rk_ + key) * 512 + h * 64 + 8 * part); \
            if (tid < 256) rkr##S = *(const u32x4*)(KR + (rk_ + key2) * 32 + 8 * part2); } while (0)
#define AT_STAGE(S, BUFI) do { LAS unsigned char* Kc_ = lds + (BUFI) * AT_BUF; LAS unsigned char* VT_ = Kc_ + AT_KB; \
            *(LAS u32x4*)(Kc_ + key * 208 + part * 16) = rkn##S; if (tid < 256) *(LAS u32x4*)(Kc_ + key2 * 208 + 128 + part2 * 16) = rkr##S; \
            *(LAS u32x4*)(VT_ + key * 192 + part * 16) = rv##S; } while (0)
#define AT_COMPUTE(JT, BUFI) do { if ((JT) <= cmax) { const LAS unsigned char* Kc_ = lds + (BUFI) * AT_BUF; const LAS unsigned char* VT_ = Kc_ + AT_KB; \
            if ((JT) > 0) att_tile64(Kc_, VT_, qf, m, l, O, lane); else att_blk(Kc_ + 32 * 208, VT_ + 32 * 192, qf, m, l, O, lane, 16); } } while (0)
        AT_LOAD(0, 0); AT_LOAD(1, 1);
        for (int jt = 0; jt < ntile; jt += 2) {
            AT_STAGE(0, 0);
            if (jt + 2 < ntile) AT_LOAD(0, jt + 2);
            __syncthreads();
            AT_COMPUTE(jt, 0);
            if (jt + 1 < ntile) {
                AT_STAGE(1, 1);
                if (jt + 3 < ntile) AT_LOAD(1, jt + 3);
                __syncthreads();
                AT_COMPUTE(jt + 1, 1);
            }
        }
#undef AT_LOAD
#undef AT_STAGE
#undef AT_COMPUTE
        __syncthreads();
        const float il = 1.0f / xhalf_sum(l);
        const size_t row2 = (size_t)b * SEQ + 256 * qt + 32 * w + q;
#pragma unroll
        for (int db = 0; db < 2; ++db)
#pragma unroll
            for (int rg = 0; rg < 4; ++rg) { u32x2 wv; wv.x = pk2(O[db][4 * rg] * il, O[db][4 * rg + 1] * il); wv.y = pk2(O[db][4 * rg + 2] * il, O[db][4 * rg + 3] * il);
                *(u32x2*)(ATT + row2 * 512 + h * 64 + 32 * db + 8 * rg + 4 * hi) = wv; }
    }
}
typedef __bf16 bf16x2_cv __attribute__((ext_vector_type(2)));
__device__ __forceinline__ unsigned pk2c(float lo, float hi) { const f32x2 v = {lo, hi}; const bf16x2_cv b = __builtin_convertvector(v, bf16x2_cv); return __builtin_bit_cast(unsigned, b); }
constexpr int AS_WIMG = 128 * 272;
constexpr int AS_KB = 32 * 208, AS_VB = 32 * 192, AS_WB = AS_KB + AS_VB;
__device__ __forceinline__ void attn_sample_unit(const P& p, int wv, LAS unsigned char* lds, int b, int h) {
    const int tid_l = wv * 64 + lane_id(); const int tid = tid_l, lane = tid & 63, w = tid >> 6, q = lane & 31, hi = lane >> 5;
    const bf16_t* Qb = (const bf16_t*)(p.ws + WS_Q); const bf16_t* CA = (const bf16_t*)(p.ws + WS_CALL); const bf16_t* WKV = (const bf16_t*)(p.ws + WS_WKV);
    const bf16_t* KR = (const bf16_t*)(p.ws + WS_KRALL); bf16_t* ATT = (bf16_t*)(p.ws + WS_ATT);
    for (int e = tid; e < 128 * 16; e += 512) { const int j = e >> 4, ch = e & 15, d = j & 63, slot = (j < 64) ? h : 8 + h;
        const int prow = 256 * (slot >> 2) + 128 * (d >> 5) + 32 * (slot & 3) + (d & 31);
        *(LAS u32x4*)(lds + j * 272 + ch * 16) = *(const u32x4*)(WKV + (size_t)prow * 128 + 8 * ch); }
    const size_t row1 = (size_t)MP + b * DSQ + q;
    bf16x8 qf[6];
    load_q(qf, Qb + row1 * 768 + h * 96, (float)(PAST + q), p.g_qn, p.g_qr, p.g_kn, hi);
    float m = 0.f, l = 0.f; f32x16 O[2];
#pragma unroll
    for (int r = 0; r < 16; ++r) { O[0][r] = 0.f; O[1][r] = 0.f; }
    LAS unsigned char* Kc = lds + AS_WIMG + w * AS_WB; LAS unsigned char* VT = Kc + AS_KB;
    const size_t rowk_b = (size_t)MKP + (size_t)b * KSAMP;
    __syncthreads();
    bf16x8 cf[8]; u32x4 rr2[2];
#define AS_LOAD(JT) do { const size_t rk_ = rowk_b + 32 * (size_t)(JT); \
        _Pragma("unroll") for (int i = 0; i < 8; ++i) cf[i] = *(const bf16x8*)(CA + (rk_ + q) * 128 + 16 * i + 8 * hi); \
        _Pragma("unroll") for (int n = 0; n < 2; ++n) { const int key = (lane >> 2) + 16 * n, part = lane & 3; rr2[n] = *(const u32x4*)(KR + (rk_ + key) * 32 + 8 * part); } } while (0)
    AS_LOAD(w);
    for (int jt = w; jt < 129; jt += 8) {
#pragma unroll
        for (int n = 0; n < 2; ++n) { const int key = (lane >> 2) + 16 * n, part = lane & 3; *(LAS u32x4*)(Kc + key * 208 + 128 + part * 16) = rr2[n]; }
        {
            f32x16 k0, k1;
#pragma unroll
            for (int r = 0; r < 16; ++r) { k0[r] = 0.f; k1[r] = 0.f; }
#pragma unroll
            for (int i = 0; i < 8; ++i) {
                const bf16x8 w0 = *(const LAS bf16x8*)(lds + q * 272 + (16 * i + 8 * hi) * 2), w1 = *(const LAS bf16x8*)(lds + (32 + q) * 272 + (16 * i + 8 * hi) * 2);
                k0 = __builtin_amdgcn_mfma_f32_32x32x16_bf16(w0, cf[i], k0, 0, 0, 0); k1 = __builtin_amdgcn_mfma_f32_32x32x16_bf16(w1, cf[i], k1, 0, 0, 0); }
            float ss = 0.f;
#pragma unroll
            for (int r = 0; r < 16; ++r) ss += k0[r] * k0[r] + k1[r] * k1[r];
            const float rs = rsqrtf(xhalf_sum(ss) * (1.0f / 64.0f) + EPS);
#pragma unroll
            for (int rg = 0; rg < 4; ++rg) {
                u32x2 a; a.x = pk2c(k0[4 * rg] * rs, k0[4 * rg + 1] * rs); a.y = pk2c(k0[4 * rg + 2] * rs, k0[4 * rg + 3] * rs);
                *(LAS u32x2*)(Kc + q * 208 + (8 * rg + 4 * hi) * 2) = a;
                u32x2 c; c.x = pk2c(k1[4 * rg] * rs, k1[4 * rg + 1] * rs); c.y = pk2c(k1[4 * rg + 2] * rs, k1[4 * rg + 3] * rs);
                *(LAS u32x2*)(Kc + q * 208 + (32 + 8 * rg + 4 * hi) * 2) = c; }
        }
        {
            f32x16 v0, v1;
#pragma unroll
            for (int r = 0; r < 16; ++r) { v0[r] = 0.f; v1[r] = 0.f; }
#pragma unroll
            for (int i = 0; i < 8; ++i) {
                const bf16x8 w0 = *(const LAS bf16x8*)(lds + (64 + q) * 272 + (16 * i + 8 * hi) * 2), w1 = *(const LAS bf16x8*)(lds + (96 + q) * 272 + (16 * i + 8 * hi) * 2);
                v0 = __builtin_amdgcn_mfma_f32_32x32x16_bf16(w0, cf[i], v0, 0, 0, 0); v1 = __builtin_amdgcn_mfma_f32_32x32x16_bf16(w1, cf[i], v1, 0, 0, 0); }
#pragma unroll
            for (int rg = 0; rg < 4; ++rg) {
                u32x2 a; a.x = pk2c(v0[4 * rg], v0[4 * rg + 1]); a.y = pk2c(v0[4 * rg + 2], v0[4 * rg + 3]);
                *(LAS u32x2*)(VT + q * 192 + (8 * rg + 4 * hi) * 2) = a;
                u32x2 c; c.x = pk2c(v1[4 * rg], v1[4 * rg + 1]); c.y = pk2c(v1[4 * rg + 2], v1[4 * rg + 3]);
                *(LAS u32x2*)(VT + q * 192 + (32 + 8 * rg + 4 * hi) * 2) = c; }
        }
        if (jt + 8 < 129) AS_LOAD(jt + 8);
        asm volatile("" ::: "memory"); __builtin_amdgcn_wave_barrier();
        att_blk(Kc, VT, qf, m, l, O, lane, 0);
        asm volatile("" ::: "memory"); __builtin_amdgcn_wave_barrier();
    }
#undef AS_LOAD
    __syncthreads();
    LAS float* Ox = (LAS float*)lds;
    LAS float* Mx = (LAS float*)(lds + 65536);
    LAS float* Lx = Mx + 256;
#pragma unroll
    for (int db = 0; db < 2; ++db)
#pragma unroll
        for (int r = 0; r < 16; ++r) Ox[(w * 64 + 32 * db + crow(r, hi)) * 32 + q] = O[db][r];
    { const float lt = xhalf_sum(l); if (hi == 0) { Mx[w * 32 + q] = m; Lx[w * 32 + q] = lt; } }
    __syncthreads();
    {
        const int qq = tid & 31, dg = tid >> 5;
        float M = -3e30f;
#pragma unroll
        for (int ww = 0; ww < 8; ++ww) M = fmaxf(M, Mx[ww * 32 + qq]);
        float L = 0.f, o[4] = {0.f, 0.f, 0.f, 0.f};
#pragma unroll
        for (int ww = 0; ww < 8; ++ww) { const float sc = __builtin_amdgcn_exp2f(Mx[ww * 32 + qq] - M); L += Lx[ww * 32 + qq] * sc;
#pragma unroll
            for (int e = 0; e < 4; ++e) o[e] += Ox[(ww * 64 + 4 * dg + e) * 32 + qq] * sc; }
        const float il = 1.0f / L;
        u32x2 wv; wv.x = pk2(o[0] * il, o[1] * il); wv.y = pk2(o[2] * il, o[3] * il);
        *(u32x2*)(ATT + ((size_t)M2P + b * DSQ + qq) * 512 + h * 64 + 4 * dg) = wv;
    }
    __syncthreads();
}
__device__ __forceinline__ void phase_attn(const P& p, int wv, LAS unsigned char* lds) {
    for (int u = blockIdx.x; u < 256; u += gridDim.x) attn_prompt_unit(p, wv, lds, u >> 3, u & 7);
    for (int u = blockIdx.x; u < 256; u += gridDim.x) attn_sample_unit(p, wv, lds, u >> 3, u & 7);
}

__device__ __forceinline__ void phase_e2(const P& p, int wv) {
    const int tid_l = wv * 64 + lane_id(); const int lane = tid_l & 63, wave = tid_l >> 6;
    const bf16_t* ATT = (const bf16_t*)(p.ws + WS_ATT); bf16_t* MIX = (bf16_t*)(p.ws + WS_MIX);
    const f32x4 g0 = *(const f32x4*)(p.g_ao + 8 * lane), g1 = *(const f32x4*)(p.g_ao + 8 * lane + 4);
    const int stride = gridDim.x * 8;
    for (int row0 = blockIdx.x * 8 + wave; row0 < M2; row0 += 4 * stride) {
        u32x4 raw[4];
#pragma unroll
        for (int u = 0; u < 4; ++u) { const int row = row0 + u * stride; raw[u] = *(const u32x4*)(ATT + (size_t)(row < M2 ? row : row0) * 512 + 8 * lane); }
#pragma unroll
        for (int u = 0; u < 4; ++u) { const int row = row0 + u * stride;
            const f32x4 a = {bflo(raw[u].x), bfhi(raw[u].x), bflo(raw[u].y), bfhi(raw[u].y)}, c = {bflo(raw[u].z), bfhi(raw[u].z), bflo(raw[u].w), bfhi(raw[u].w)};
            const float ss = (a[0] * a[0] + a[1] * a[1]) + (a[2] * a[2] + a[3] * a[3]) + (c[0] * c[0] + c[1] * c[1]) + (c[2] * c[2] + c[3] * c[3]);
            const float rs = rsqrtf(wave_sum(ss) * (1.0f / 512.0f) + EPS);
            const f32x4 o0 = a * g0 * rs, o1 = c * g1 * rs;
            u32x4 w; w.x = pk2(o0[0], o0[1]); w.y = pk2(o0[2], o0[3]); w.z = pk2(o1[0], o1[1]); w.w = pk2(o1[2], o1[3]);
            if (row < M2) *(u32x4*)(MIX + (size_t)row * 1024 + 8 * lane) = w; }
    }
}
__device__ __forceinline__ void phase_e3(const P& p, int wv) {
    const int tid_l = wv * 64 + lane_id(); const int lane = tid_l & 63, wave = tid_l >> 6;
    const float* H = (const float*)(p.ws + WS_H); bf16_t* U = (bf16_t*)(p.ws + WS_U);
    f32x4 g[4];
#pragma unroll
    for (int j = 0; j < 4; ++j) g[j] = *(const f32x4*)(p.g_ffn + 4 * lane + 256 * j);
    const int stride = gridDim.x * 8;
    for (int row = blockIdx.x * 8 + wave; row < M2P; row += 2 * stride) {
        const int rowb = row + stride; const bool hb = rowb < M2P; const int rb = hb ? rowb : row;
        f32x4 va[4], vb[4]; float ssa = 0.f, ssb = 0.f;
#pragma unroll
        for (int j = 0; j < 4; ++j) { va[j] = *(const f32x4*)(H + (size_t)row * 1024 + 4 * lane + 256 * j); vb[j] = *(const f32x4*)(H + (size_t)rb * 1024 + 4 * lane + 256 * j); }
#pragma unroll
        for (int j = 0; j < 4; ++j) { ssa += (va[j][0] * va[j][0] + va[j][1] * va[j][1]) + (va[j][2] * va[j][2] + va[j][3] * va[j][3]);
                                      ssb += (vb[j][0] * vb[j][0] + vb[j][1] * vb[j][1]) + (vb[j][2] * vb[j][2] + vb[j][3] * vb[j][3]); }
        const float rsa = rsqrtf(wave_sum(ssa) * (1.0f / 1024.0f) + EPS), rsb = rsqrtf(wave_sum(ssb) * (1.0f / 1024.0f) + EPS);
#pragma unroll
        for (int j = 0; j < 4; ++j) { const f32x4 o = va[j] * g[j] * rsa; u32x2 w; w.x = pk2(o[0], o[1]); w.y = pk2(o[2], o[3]);
            *(u32x2*)(U + (size_t)row * 1024 + 4 * lane + 256 * j) = w; }
        if (hb) {
#pragma unroll
            for (int j = 0; j < 4; ++j) { const f32x4 o = vb[j] * g[j] * rsb; u32x2 w; w.x = pk2(o[0], o[1]); w.y = pk2(o[2], o[3]);
                *(u32x2*)(U + (size_t)rowb * 1024 + 4 * lane + 256 * j) = w; } }
    }
    { const float* PB = (const float*)(p.ws + WS_PB5); float* Hw = (float*)(p.ws + WS_H);
      for (int r = blockIdx.x * 8 + wave; r < MS; r += stride) {
          f32x4 v[4]; float ss = 0.f;
#pragma unroll
          for (int j = 0; j < 4; ++j) { const size_t o = (size_t)r * 1024 + 4 * lane + 256 * j;
              v[j] = (*(const f32x4*)(PB + o) + *(const f32x4*)(PB + 1048576 + o)) + (*(const f32x4*)(PB + 2 * 1048576 + o) + *(const f32x4*)(PB + 3 * 1048576 + o)) + *(const f32x4*)(p.xs + o);
              *(f32x4*)(Hw + (size_t)(M2P + r) * 1024 + 4 * lane + 256 * j) = v[j];
              ss += (v[j][0] * v[j][0] + v[j][1] * v[j][1]) + (v[j][2] * v[j][2] + v[j][3] * v[j][3]); }
          const float rs = rsqrtf(wave_sum(ss) * (1.0f / 1024.0f) + EPS);
#pragma unroll
          for (int j = 0; j < 4; ++j) { const f32x4 o = v[j] * g[j] * rs; u32x2 w; w.x = pk2(o[0], o[1]); w.y = pk2(o[2], o[3]);
              *(u32x2*)(U + (size_t)(M2P + r) * 1024 + 4 * lane + 256 * j) = w; }
      } }
}

#define XB_TMO      128
#define XB_XCNT(j)  (256  + 64 * (j))
#define XB_XSUB(j)  (1280 + 64 * (j))
#define XB_XGEN(j)  (2304 + 64 * (j))
#define XB_TOP      3328
#define XB_TOPGEN   3392
#define XCD_BAR_WORDS 3456
#define XB_SPIN_CAP (1u << 18)

__device__ __forceinline__ unsigned xb_ld(unsigned* p)              { return __hip_atomic_load(p, __ATOMIC_RELAXED, __HIP_MEMORY_SCOPE_AGENT); }
__device__ __forceinline__ unsigned xb_add(unsigned* p, unsigned v) { return __hip_atomic_fetch_add(p, v, __ATOMIC_RELAXED, __HIP_MEMORY_SCOPE_AGENT); }
__device__ __forceinline__ unsigned xb_xcc_id() { return (unsigned)__builtin_amdgcn_s_getreg((3 << 11) | 20) & 0xFu; }
#define XB_SPIN(cond, bar) do { unsigned _sp = 0; while (cond) { __builtin_amdgcn_s_sleep(1); \
    if ((++_sp & 255u) == 0u) { if (xb_ld(&(bar)[XB_TMO])) break; if (_sp > XB_SPIN_CAP) { atomicAdd(&(bar)[XB_TMO], 1u); break; } } } } while (0)

struct XcdBarrier {
    int wv;
    unsigned* bar; unsigned x;
    volatile LAS unsigned* st;
};

__device__ __forceinline__ XcdBarrier xcd_barrier_post(unsigned* bar, volatile LAS unsigned* st) {
    XcdBarrier b; b.wv = 0; b.bar = bar; b.x = xb_xcc_id(); b.st = st;
    if (threadIdx.x == 0) (void)xb_add(&bar[XB_XCNT(b.x)], 1u);
    return b;
}
__device__ __forceinline__ void xcd_barrier_complete(unsigned* bar, unsigned x, unsigned& nloc, unsigned& nx) {
    const unsigned G = gridDim.x * gridDim.y * gridDim.z;
    unsigned sum, cnt, mine, sp = 0u;
    for (;;) {
        sum = 0u; cnt = 0u; mine = 0u;
#pragma unroll
        for (unsigned j = 0; j < 16; ++j) { const unsigned c = xb_ld(&bar[XB_XCNT(j)]); sum += c; cnt += (c > 0u) ? 1u : 0u; mine = (j == x) ? c : mine; }
        if (sum == G) break;
        __builtin_amdgcn_s_sleep(1);
        if ((++sp & 255u) == 0u) { if (xb_ld(&bar[XB_TMO])) break; if (sp > XB_SPIN_CAP) { atomicAdd(&bar[XB_TMO], 1u); break; } }
    }
    nloc = mine > 0u ? mine : 1u; nx = cnt > 0u ? cnt : 1u;
}

__device__ __forceinline__ void xcd_barrier(const XcdBarrier& b) {
    asm volatile("s_waitcnt vmcnt(0)" ::: "memory");
    __syncthreads();
    if (b.wv == 0 && lane_id() == 0) {
        unsigned* bar = b.bar;
        __builtin_amdgcn_s_waitcnt(0);
        unsigned nloc = b.st[0], nx = b.st[1];
        if (nloc == 0u) { xcd_barrier_complete(bar, b.x, nloc, nx); b.st[0] = nloc; b.st[1] = nx; }
        const unsigned old = xb_add(&bar[XB_XSUB(b.x)], 1u);
        const unsigned gen = old / nloc;
        if (old + 1u == (gen + 1u) * nloc) {
            __builtin_amdgcn_fence(__ATOMIC_RELEASE, "agent");
            asm volatile("s_waitcnt vmcnt(0)" ::: "memory");
            const unsigned og = xb_add(&bar[XB_TOP], 1u);
            const unsigned tg = og / nx;
            if (og + 1u == (tg + 1u) * nx) xb_add(&bar[XB_TOPGEN], 1u);
            else XB_SPIN(xb_ld(&bar[XB_TOPGEN]) == tg, bar);
            __builtin_amdgcn_fence(__ATOMIC_ACQUIRE, "agent");
            xb_add(&bar[XB_XGEN(b.x)], 1u);
            asm volatile("s_waitcnt vmcnt(0)" ::: "memory");
        } else {
            XB_SPIN(xb_ld(&bar[XB_XGEN(b.x)]) == gen, bar);
            __builtin_amdgcn_fence(__ATOMIC_ACQUIRE, "agent");
            asm volatile("s_waitcnt vmcnt(0)" ::: "memory");
        }
    }
    __syncthreads();
}

template <class Epi> __device__ __forceinline__ void run_gemm(int wv, LAS unsigned char* lds, const bf16_t* A, const bf16_t* Bt, int M, int N, int K, const Epi& E) {
    pg8::Gemm g{A, Bt, M, N, K, K, wv}; pg8::StaticOrder S; S.init(M, N, (int)gridDim.x, (int)blockIdx.x);
    pg8::gemm_phase<Epi, pg8::StaticOrder, true, true>(lds, g, S, E);
}

#ifndef PH_MASK
#define PH_MASK 0xFFFF
#endif
#ifndef PH_TWICE
#define PH_TWICE 0
#ifndef EXTRA_SYNCS
#define EXTRA_SYNCS 0
#endif
#endif
__device__ __forceinline__ void run_gemm_split(int wv, LAS unsigned char* lds, const bf16_t* A, const bf16_t* Bt, int N, int K, int Kc, int pm0, int npm, const pg8::EpiPartial& E) {
    pg8::Gemm g{A, Bt, 0, N, K, Kc, wv}; pg8::SplitOrder S{pm0, npm, N / 256, K / Kc, (int)gridDim.x, (int)blockIdx.x};
    pg8::gemm_phase<pg8::EpiPartial, pg8::SplitOrder, true, true, true>(lds, g, S, E);
}
__global__ void __launch_bounds__(512, 2) hymba_fwd(P p) {
    extern __shared__ __attribute__((aligned(16))) unsigned char lds_raw[];
    LAS unsigned char* lds = (LAS unsigned char*)lds_raw;
    cg::grid_group grid = cg::this_grid();
    unsigned char* ws = p.ws;
    volatile LAS unsigned* bst = (volatile LAS unsigned*)(lds + LDS_BYTES - 64);
    if (threadIdx.x < 16) bst[threadIdx.x] = 0u;
    __syncthreads();
    XcdBarrier xbar = xcd_barrier_post((unsigned*)(ws + WS_CTL), bst);
    const int wv = __builtin_amdgcn_readfirstlane((int)(threadIdx.x >> 6)); xbar.wv = wv;
#define GBAR() xcd_barrier(xbar)
    if (PH_MASK & 1) phase_e0(p, wv, lds);
    if (PH_TWICE & 1) { __syncthreads(); phase_e0(p, wv, lds); }
    if (p.ws == nullptr) grid.sync();
    GBAR();
    if (PH_MASK & 2) { pg8::EpiStore E{(bf16_t*)(ws + WS_PROJ), NPROJ}; run_gemm(wv, lds, (const bf16_t*)(ws + WS_XN), (const bf16_t*)(ws + WS_WIN), M1, NPROJ, 1024, E); }
    if (PH_TWICE & 2) { pg8::EpiStore E{(bf16_t*)(ws + WS_PROJ), NPROJ}; run_gemm(wv, lds, (const bf16_t*)(ws + WS_XN), (const bf16_t*)(ws + WS_WIN), M1, NPROJ, 1024, E); }
    GBAR();
    for (int es = 0; es < EXTRA_SYNCS; ++es) GBAR();
    if (PH_MASK & 4) phase_e1(p, wv);
    if (PH_TWICE & 4) phase_e1(p, wv);
    GBAR();
    if (PH_MASK & 16) { pg8::EpiStore E{(bf16_t*)(ws + WS_E), 1536}; run_gemm(wv, lds, (const bf16_t*)(ws + WS_LIN), (const bf16_t*)(ws + WS_WL), M1, 1536, 256, E); }
    if (PH_TWICE & 16) { pg8::EpiStore E{(bf16_t*)(ws + WS_E), 1536}; run_gemm(wv, lds, (const bf16_t*)(ws + WS_LIN), (const bf16_t*)(ws + WS_WL), M1, 1536, 256, E); }
    GBAR();
    if (PH_MASK & 32) phase_scan(p, wv, lds);
    if (PH_TWICE & 32) phase_scan(p, wv, lds);
    GBAR();
    if (PH_MASK & 8) { pg8::EpiStore E{(bf16_t*)(ws + WS_Q), 768}; run_gemm(wv, lds, (const bf16_t*)(ws + WS_QL), (const bf16_t*)(ws + WS_WQ), M1, 768, 256, E); }
    if (PH_TWICE & 8) { pg8::EpiStore E{(bf16_t*)(ws + WS_Q), 768}; run_gemm(wv, lds, (const bf16_t*)(ws + WS_QL), (const bf16_t*)(ws + WS_WQ), M1, 768, 256, E); }
    if (PH_MASK & 64) { pg8::EpiKV E{(bf16_t*)(ws + WS_KN), (bf16_t*)(ws + WS_V), p.g_kn}; run_gemm(wv, lds, (const bf16_t*)(ws + WS_CALL), (const bf16_t*)(ws + WS_WKV), MKP, 1024, 128, E); }
    if (PH_TWICE & 64) { pg8::EpiKV E{(bf16_t*)(ws + WS_KN), (bf16_t*)(ws + WS_V), p.g_kn}; run_gemm(wv, lds, (const bf16_t*)(ws + WS_CALL), (const bf16_t*)(ws + WS_WKV), MKP, 1024, 128, E); }
    GBAR();
    if (PH_MASK & 128) phase_attn(p, wv, lds);
    if (PH_TWICE & 128) phase_attn(p, wv, lds);
    GBAR();
    if (PH_MASK & 256) phase_e2(p, wv);
    if (PH_TWICE & 256) phase_e2(p, wv);
    GBAR();
    if (PH_MASK & 512) { pg8::EpiRes E{(float*)(ws + WS_H), p.xp, p.xs, M2P}; run_gemm(wv, lds, (const bf16_t*)(ws + WS_MIX), (const bf16_t*)(ws + WS_WOUT), M2P, 1024, 1024, E);
        pg8::EpiPartial E2{(float*)(ws + WS_PB5), M2P}; run_gemm_split(wv, lds, (const bf16_t*)(ws + WS_MIX), (const bf16_t*)(ws + WS_WOUT), 1024, 1024, 256, M2P / 256, MS / 256, E2); }
    GBAR();
    if (PH_MASK & 1024) phase_e3(p, wv);
    if (PH_TWICE & 1024) phase_e3(p, wv);
    GBAR();
    if (PH_MASK & 2048) { pg8::EpiSwiglu E{(bf16_t*)(ws + WS_ACT)}; run_gemm(wv, lds, (const bf16_t*)(ws + WS_U), (const bf16_t*)(ws + WS_WGU), M2, 2 * DFF, 1024, E); }
    if (PH_TWICE & 2048) { pg8::EpiSwiglu E{(bf16_t*)(ws + WS_ACT)}; run_gemm(wv, lds, (const bf16_t*)(ws + WS_U), (const bf16_t*)(ws + WS_WGU), M2, 2 * DFF, 1024, E); }
    GBAR();
    if (PH_MASK & 4096) { pg8::EpiRes E{p.out, (const float*)(ws + WS_H), (const float*)(ws + WS_H), M2}; run_gemm(wv, lds, (const bf16_t*)(ws + WS_ACT), (const bf16_t*)(ws + WS_WDN), M2P, 1024, DFF, E);
        pg8::EpiPartial E2{(float*)(ws + WS_PB7), M2P}; run_gemm_split(wv, lds, (const bf16_t*)(ws + WS_ACT), (const bf16_t*)(ws + WS_WDN), 1024, DFF, 256, M2P / 256, MS / 256, E2); }
    GBAR();
    {
        const float* PB = (const float*)(ws + WS_PB7); float* ys = p.out + OFF_YS;
        const int tid_l = wv * 64 + lane_id();
        for (size_t e = (size_t)blockIdx.x * 512 + tid_l; e < (size_t)MS * 1024 / 4; e += (size_t)gridDim.x * 512) {
            f32x4 a = *(const f32x4*)(PB + 4 * e) + *(const f32x4*)((const float*)(ws + WS_H) + (size_t)M2P * 1024 + 4 * e);
#pragma unroll
            for (int kc = 1; kc < 11; ++kc) a += *(const f32x4*)(PB + (size_t)kc * 1048576 + 4 * e);
            *(f32x4*)(ys + 4 * e) = a; }
    }
}

extern "C" void kernel_launch(void* const* d_in, const int* in_sizes, int n_in, void* d_out, int out_size, void* d_ws, size_t ws_size, hipStream_t stream) {
    static int grid_blocks = 0;
    if (grid_blocks == 0) {
        if (n_in != 34 || ws_size < WS_NEED) { fprintf(stderr, "kernel_launch: unexpected n_in %d / ws_size %zu\n", n_in, ws_size); grid_blocks = -1; return; }
        int dev = 0, cus = 0, per_cu = 0;
        hipGetDevice(&dev);
        hipDeviceGetAttribute(&cus, hipDeviceAttributeMultiprocessorCount, dev);
        if (hipFuncSetAttribute((const void*)hymba_fwd, hipFuncAttributeMaxDynamicSharedMemorySize, LDS_BYTES) != hipSuccess) { fprintf(stderr, "kernel_launch: hipFuncSetAttribute failed\n"); }
        if (hipOccupancyMaxActiveBlocksPerMultiprocessor(&per_cu, (const void*)hymba_fwd, 512, LDS_BYTES) != hipSuccess || per_cu < 1) per_cu = 1;
        (void)hipGetLastError();
        if (per_cu > 1) per_cu = 1;
        grid_blocks = cus * per_cu;
    }
    if (grid_blocks < 0) return;
    P p{};
    const float** f = (const float**)&p;
    for (int i = 0; i < 34; ++i) f[i] = (const float*)d_in[i];
    p.out = (float*)d_out; p.ws = (unsigned char*)d_ws;
    (void)hipMemsetAsync((char*)d_ws + WS_CTL, 0, 16384, stream);
    void* args[] = {&p};
    hipError_t e = hipLaunchCooperativeKernel((const void*)hymba_fwd, dim3(grid_blocks), dim3(512), args, LDS_BYTES, stream);
    if (e != hipSuccess) fprintf(stderr, "cooperative launch failed: %s (grid %d)\n", hipGetErrorString(e), grid_blocks);
}
```

```cpp
#include <hip/hip_runtime.h>
#include <hip/hip_cooperative_groups.h>
#include <cstdio>
#include <cstdint>
namespace cg = cooperative_groups;

namespace pg8 {
#define PG8_LAS __attribute__((address_space(3)))
typedef unsigned short bf16_t;
typedef short bf16x8 __attribute__((ext_vector_type(8)));
typedef float f32x4 __attribute__((ext_vector_type(4)));
typedef unsigned u32x4 __attribute__((ext_vector_type(4)));
constexpr int BM = 256, BK = 64, HALF = 128, HTB = HALF * BK * 2  , STAGE_BYTES = 8 * HTB, NXCD = 8, WGM = 8;

__host__ __device__ __forceinline__ int lds_byte(int r, int c) { const int st = (r >> 4) * 2 + (c >> 5), rr = r & 15, cc = c & 31, ob = rr * 64 + cc * 2; return st * 1024 + (ob ^ (((ob >> 9) & 1) << 5)); }
__host__ __device__ __forceinline__ void stage_rc(int b, int& R, int& C) { const int st = b / 1024, sb = b % 1024, swz = sb ^ (((sb >> 9) & 1) << 5); R = (st >> 1) * 16 + swz / 64; C = (st & 1) * 32 + (swz % 64) / 2; }
__host__ __device__ __forceinline__ int perm32(int rho) { const int n = rho >> 4, i = rho & 15; return 8 * (i >> 2) + 4 * n + (i & 3); }

struct Unit { int pm, pn, kc; };
struct Gemm { const bf16_t* A; const bf16_t* Bt; int M, N, K, Kc, wv; };

struct StaticOrder {
    int nM, nN, nwg, G, c;
    __host__ __device__ void init(int M, int N, int G_, int c_) { nM = M / BM; nN = N / BM; nwg = nM * nN; G = G_; c = c_; }
    __host__ __device__ bool next(int i, Unit& u) const {
        const long L = (long)i * G + c; if (L >= nwg) return false;
        int wgid = (int)L; { const int q = nwg / NXCD, r = nwg % NXCD, xcd = wgid % NXCD, off = wgid / NXCD; wgid = (xcd < r ? xcd * (q + 1) : r * (q + 1) + (xcd - r) * q) + off; }
        const int nig = WGM * nN, gid = wgid / nig, fm = gid * WGM, gsz = (nM - fm) < WGM ? (nM - fm) : WGM;
        u.pm = fm + ((wgid % nig) % gsz); u.pn = (wgid % nig) / gsz; u.kc = 0; return true;
    }
    __device__ __forceinline__ void a_ready(const Unit&) const {}
    __device__ __forceinline__ void done(const Unit&) const {}
};

__device__ __forceinline__ unsigned cvt_pk_bf16(float lo, float hi) { unsigned r; asm volatile("v_cvt_pk_bf16_f32 %0, %1, %2" : "=v"(r) : "v"(lo), "v"(hi)); return r; }
template <class Epi, class Sched, bool ALIGN_EPI = false, bool SP2 = false, bool SPLITK = false>
__device__ __forceinline__ void gemm_phase(PG8_LAS unsigned char* lds, const Gemm g, const Sched& S, const Epi& E) {
    int tid_l; asm volatile("v_mbcnt_lo_u32_b32 %0, -1, 0\n\tv_mbcnt_hi_u32_b32 %0, -1, %0" : "=v"(tid_l)); const int tid = g.wv * 64 + tid_l, wid = __builtin_amdgcn_readfirstlane(tid >> 6), lane = tid & 63, wr = wid >> 2, wc = wid & 3, fr = lane & 15, fq = lane >> 4;
    const int K = g.K, nt = (SPLITK ? g.Kc : g.K) / BK; const size_t kcb = SPLITK ? (size_t)g.Kc * 2 : 0;
    unsigned voffA[2], voffB[2];
#pragma unroll
    for (int i = 0; i < 2; ++i) { int R, C; stage_rc(tid * 16 + i * 8192, R, C); const int Rb = Epi::PERM ? ((R & ~31) + perm32(R & 31)) : R;
        voffA[i] = (unsigned)(R * K + C) * 2u; voffB[i] = (unsigned)(Rb * K + C) * 2u; }
    const size_t kstep = (size_t)(BK * 2);
    const size_t hstep = (size_t)HALF * K * 2;
    const size_t tstep = 2 * hstep;
    const unsigned ldsw = (unsigned)wid * 1024u;
    const int aoff = lds_byte(wr * 64 + fr, fq * 8), boff = lds_byte(wc * 32 + fr, fq * 8);
#define PG8_SA(b, h) (((b) * 2 + (h)) * HTB)
#define PG8_SB(b, h) ((4 + (b) * 2 + (h)) * HTB)
#define PG8_STAGE(bufoff, gbase, voff) do { _Pragma("unroll") for (int _i = 0; _i < 2; ++_i) \
        __builtin_amdgcn_global_load_lds((const unsigned*)((const char*)(gbase) + (voff)[_i]), (PG8_LAS unsigned*)(lds + (bufoff) + ldsw + _i * 8192), 16, 0, 0); } while (0)
#define PG8_LDA(dst, b, h) do { _Pragma("unroll") for (int m = 0; m < 4; ++m) _Pragma("unroll") for (int k = 0; k < 2; ++k) dst[m][k] = *(const PG8_LAS bf16x8*)(lds + PG8_SA(b, h) + aoff + m * 2048 + k * 1024); } while (0)
#define PG8_LDB(dst, b, h) do { _Pragma("unroll") for (int n = 0; n < 2; ++n) _Pragma("unroll") for (int k = 0; k < 2; ++k) dst[n][k] = *(const PG8_LAS bf16x8*)(lds + PG8_SB(b, h) + boff + n * 2048 + k * 1024); } while (0)
#define PG8_MMA(ai, bj, At, Bt) do { __builtin_amdgcn_s_setprio(1); _Pragma("unroll") for (int m = 0; m < 4; ++m) _Pragma("unroll") for (int n = 0; n < 2; ++n) _Pragma("unroll") for (int k = 0; k < 2; ++k) \
        acc[ai][bj][m][n] = __builtin_amdgcn_mfma_f32_16x16x32_bf16(Bt[n][k], At[m][k], acc[ai][bj][m][n], 0, 0, 0); __builtin_amdgcn_s_setprio(0); } while (0)
#define PG8_WAIT_V(n) asm volatile("s_waitcnt vmcnt(" #n ")" ::: "memory")
#define PG8_WAIT_L(n) asm volatile("s_waitcnt lgkmcnt(" #n ")" ::: "memory")
#define PG8_BAR __builtin_amdgcn_s_barrier()
#define PG8_SCHED __builtin_amdgcn_sched_barrier(0)
    Unit cur, nxt; int ui = 0;
    if (!S.next(0, cur)) return;
    f32x4 acc[2][2][4][2];
#pragma unroll
    for (int a = 0; a < 2; ++a)
#pragma unroll
        for (int b = 0; b < 2; ++b)
#pragma unroll
            for (int m = 0; m < 4; ++m)
#pragma unroll
                for (int n = 0; n < 2; ++n) acc[a][b][m][n] = (f32x4){0.f, 0.f, 0.f, 0.f};
    bf16x8 At[4][2], B0[2][2], B1[2][2];
    const char* cA = (const char*)g.A + (size_t)cur.pm * tstep + (SPLITK ? (size_t)cur.kc * kcb : 0); const char* cB = (const char*)g.Bt + (size_t)cur.pn * tstep + (SPLITK ? (size_t)cur.kc * kcb : 0);
    S.a_ready(cur);
    if constexpr (SP2) {
        PG8_STAGE(PG8_SB(0, 0), cB, voffB); PG8_STAGE(PG8_SB(0, 1), cB + hstep, voffB); PG8_STAGE(PG8_SA(0, 0), cA, voffA); PG8_STAGE(PG8_SA(0, 1), cA + hstep, voffA);
        if (wr == 1) PG8_BAR;
        PG8_WAIT_V(2); PG8_BAR;
        PG8_STAGE(PG8_SB(1, 0), cB + kstep, voffB); PG8_STAGE(PG8_SA(1, 0), cA + kstep, voffA); PG8_STAGE(PG8_SB(1, 1), cB + hstep + kstep, voffB);
        PG8_WAIT_V(6); PG8_BAR;
    } else {
        PG8_STAGE(PG8_SB(0, 0), cB, voffB); PG8_STAGE(PG8_SA(0, 0), cA, voffA); PG8_STAGE(PG8_SB(0, 1), cB + hstep, voffB); PG8_STAGE(PG8_SA(0, 1), cA + hstep, voffA);
        if (wr == 1) PG8_BAR;
        PG8_WAIT_V(4); PG8_BAR;
        PG8_STAGE(PG8_SB(1, 0), cB + kstep, voffB); PG8_STAGE(PG8_SA(1, 0), cA + kstep, voffA); PG8_STAGE(PG8_SB(1, 1), cB + hstep + kstep, voffB);
        PG8_WAIT_V(6); PG8_BAR;
    }
    for (;;) {
        const bool has_next = S.next(ui + 1, nxt);
        const char* nA = has_next ? (const char*)g.A + (size_t)nxt.pm * tstep + (SPLITK ? (size_t)nxt.kc * kcb : 0) : cA; const char* nB = has_next ? (const char*)g.Bt + (size_t)nxt.pn * tstep + (SPLITK ? (size_t)nxt.kc * kcb : 0) : cB;
#pragma unroll 1
        for (int t = 0; t < nt; t += 2) {
            const bool last = (t == nt - 2);
            const char* a1 = cA + (size_t)(t + 1) * kstep;
            const char* a2 = last ? nA : cA + (size_t)(t + 2) * kstep; const char* b2 = last ? nB : cB + (size_t)(t + 2) * kstep;
            const char* a3 = a2 + kstep; const char* b3 = b2 + kstep;
            if (last && has_next) S.a_ready(nxt);
            if constexpr (SP2) {
            PG8_LDB(B0, 0, 0); PG8_LDB(B1, 0, 1); PG8_SCHED; PG8_LDA(At, 0, 0); PG8_STAGE(PG8_SA(1, 1), a1 + hstep, voffA);
            PG8_WAIT_V(8); PG8_WAIT_L(0); PG8_BAR; PG8_MMA(0, 0, At, B0); PG8_MMA(0, 1, At, B1); PG8_BAR; PG8_SCHED;
            PG8_LDA(At, 0, 1); PG8_STAGE(PG8_SB(0, 0), b2, voffB); PG8_STAGE(PG8_SB(0, 1), b2 + hstep, voffB); PG8_STAGE(PG8_SA(0, 0), a2, voffA);
            PG8_WAIT_V(8); PG8_WAIT_L(0); PG8_BAR; PG8_MMA(1, 0, At, B0); PG8_MMA(1, 1, At, B1); PG8_BAR; PG8_SCHED;
            PG8_LDB(B0, 1, 0); PG8_LDB(B1, 1, 1); PG8_SCHED; PG8_LDA(At, 1, 0); PG8_STAGE(PG8_SA(0, 1), a2 + hstep, voffA);
            PG8_WAIT_V(8); PG8_WAIT_L(0); PG8_BAR; PG8_MMA(0, 0, At, B0); PG8_MMA(0, 1, At, B1); PG8_BAR; PG8_SCHED;
            PG8_LDA(At, 1, 1); PG8_STAGE(PG8_SB(1, 0), b3, voffB); PG8_STAGE(PG8_SB(1, 1), b3 + hstep, voffB); PG8_STAGE(PG8_SA(1, 0), a3, voffA);
            PG8_WAIT_V(8); PG8_WAIT_L(0); PG8_BAR; PG8_MMA(1, 0, At, B0); PG8_MMA(1, 1, At, B1); PG8_BAR; PG8_SCHED;
            } else {
            PG8_LDB(B0, 0, 0); PG8_SCHED; PG8_LDA(At, 0, 0); PG8_STAGE(PG8_SA(1, 1), a1 + hstep, voffA);
            PG8_WAIT_L(8); PG8_BAR; PG8_WAIT_L(0); PG8_MMA(0, 0, At, B0); PG8_BAR; PG8_SCHED;
            PG8_LDB(B1, 0, 1); PG8_STAGE(PG8_SB(0, 0), b2, voffB);
            PG8_BAR; PG8_WAIT_L(0); PG8_MMA(0, 1, At, B1); PG8_BAR;
            PG8_LDA(At, 0, 1); PG8_STAGE(PG8_SA(0, 0), a2, voffA);
            PG8_BAR; PG8_WAIT_L(0); PG8_MMA(1, 0, At, B0); PG8_BAR; PG8_SCHED;
            PG8_STAGE(PG8_SB(0, 1), b2 + hstep, voffB);
            PG8_WAIT_V(6); PG8_BAR; PG8_MMA(1, 1, At, B1); PG8_BAR;
            PG8_LDB(B0, 1, 0); PG8_SCHED; PG8_LDA(At, 1, 0); PG8_STAGE(PG8_SA(0, 1), a2 + hstep, voffA);
            PG8_WAIT_L(8); PG8_BAR; PG8_WAIT_L(0); PG8_MMA(0, 0, At, B0); PG8_BAR; PG8_SCHED;
            PG8_LDB(B1, 1, 1); PG8_STAGE(PG8_SB(1, 0), b3, voffB);
            PG8_BAR; PG8_WAIT_L(0); PG8_MMA(0, 1, At, B1); PG8_BAR;
            PG8_LDA(At, 1, 1); PG8_STAGE(PG8_SA(1, 0), a3, voffA);
            PG8_BAR; PG8_WAIT_L(0); PG8_MMA(1, 0, At, B0); PG8_BAR; PG8_SCHED;
            PG8_STAGE(PG8_SB(1, 1), b3 + hstep, voffB);
            PG8_WAIT_V(6); PG8_BAR; PG8_MMA(1, 1, At, B1); PG8_BAR;
            }
        }
        if constexpr (ALIGN_EPI) { if (wr == 0) PG8_BAR; }
        if constexpr (!Epi::AFTER_DRAIN) { E(acc, cur, wr, wc, fr, fq); S.done(cur); }
        if (!has_next) break;
#pragma unroll
        for (int a = 0; a < 2; ++a)
#pragma unroll
            for (int b = 0; b < 2; ++b)
#pragma unroll
                for (int m = 0; m < 4; ++m)
#pragma unroll
                    for (int n = 0; n < 2; ++n) acc[a][b][m][n] = (f32x4){0.f, 0.f, 0.f, 0.f};
        cur = nxt; cA = nA; cB = nB; ++ui;
        if constexpr (ALIGN_EPI) { if (wr == 1) PG8_BAR; }
    }
    PG8_WAIT_V(0);
    if constexpr (!ALIGN_EPI) { if (wr == 0) PG8_BAR; }
    PG8_BAR;
    if constexpr (Epi::AFTER_DRAIN) { E.fused(acc, cur, wr, wc, fr, fq, lds, wid, lane); S.done(cur); }
#undef PG8_SA
#undef PG8_SB
#undef PG8_STAGE
#undef PG8_LDA
#undef PG8_LDB
#undef PG8_MMA
#undef PG8_WAIT_V
#undef PG8_WAIT_L
#undef PG8_BAR
#undef PG8_SCHED
}
}

#define LAS __attribute__((address_space(3)))
typedef unsigned short bf16_t;
typedef float f32x4 __attribute__((ext_vector_type(4)));
typedef float f32x2 __attribute__((ext_vector_type(2)));
typedef float f32x16 __attribute__((ext_vector_type(16)));
typedef unsigned u32x4 __attribute__((ext_vector_type(4)));
typedef unsigned u32x2 __attribute__((ext_vector_type(2)));
typedef short bf16x8 __attribute__((ext_vector_type(8)));

constexpr int DM = 1024, NB = 32, SEQ = 2048, NMETA = 16, LP = 2064, DSQ = 32, PAST = 4096, KSAMP = 4128;
constexpr int MP = NB * LP;
constexpr int MS = NB * DSQ;
constexpr int M1 = MP + MS;
constexpr int M2P = NB * SEQ;
constexpr int M2 = M2P + MS;
constexpr int KPB = 2112;
constexpr int MKP = NB * KPB;
constexpr int MK = MKP + NB * KSAMP;
constexpr int NPROJ = 2304, INCOLS = 2208, RW0 = 416, RWC = 1792, DFF = 2816;
constexpr float EPS = 1e-6f, LNX_EPS = 64e-5f;
constexpr float QSCALE = 0.10206207261596577f * 1.4426950408889634f;

constexpr size_t OFF_YP = 0, OFF_YS = 67108864, OFF_KVP = 68157440, OFF_KRP = 76611584, OFF_WKVP = 78725120, OFF_SHP = 79773696,
                 OFF_KVS = 79831040, OFF_KRS = 79962112, OFF_WKVS = 79994880, OFF_SHS = 81043456;

constexpr size_t MiB = 1u << 20;
constexpr size_t WS_WIN = 0, WS_WQ = 5 * MiB, WS_WKV = 6 * MiB, WS_WL = 7 * MiB, WS_WOUT = 8 * MiB, WS_WGU = 10 * MiB, WS_WDN = 22 * MiB;
constexpr size_t WS_CTL = 28 * MiB;
constexpr size_t WS_XN = 32 * MiB, WS_PROJ = 163 * MiB;
constexpr size_t WS_CALL = 32 * MiB, WS_KRALL = 81 * MiB, WS_QL = 94 * MiB, WS_LIN = 127 * MiB;
constexpr size_t WS_RKV = 460 * MiB, WS_Q = 163 * MiB, WS_E = 262 * MiB, WS_A = 328 * MiB, WS_G = 394 * MiB;
constexpr size_t WS_MIX = 657 * MiB, WS_KN = 262 * MiB, WS_V = 457 * MiB, WS_ATT = 787 * MiB;
constexpr size_t WS_H = 32 * MiB, WS_U = 292 * MiB, WS_ACT = 422 * MiB;
constexpr size_t WS_HS = 790 * MiB;
constexpr size_t WS_PB5 = 430 * MiB, WS_PB7 = 300 * MiB;
constexpr size_t WS_NEED = 852 * MiB;
constexpr int LDS_BYTES = 139264;

struct P {
    const float *xp, *xs, *ckv, *ckr, *swkv, *sshift, *meta, *g_mix, *w_in, *g_q, *w_qup, *g_kv, *w_kvup, *g_qn, *g_qr, *g_kn, *g_kr, *g_ao,
                *mu, *w0, *w2, *a0, *a2, *g2, *k_k, *k_a, *r_k, *lnx_g, *lnx_b, *w_out, *g_ffn, *w_gate, *w_up, *w_down;
    float* out; unsigned char* ws;
};
__device__ __forceinline__ int lane_id() { int l; asm volatile("v_mbcnt_lo_u32_b32 %0, -1, 0\n\tv_mbcnt_hi_u32_b32 %0, -1, %0" : "=v"(l)); return l; }

__device__ __forceinline__ float bf2f(unsigned b) { return __uint_as_float(b << 16); }
__device__ __forceinline__ float bflo(unsigned w) { return __uint_as_float(w << 16); }
__device__ __forceinline__ float bfhi(unsigned w) { return __uint_as_float(w & 0xffff0000u); }
__device__ __forceinline__ unsigned pk2(float lo, float hi) { return pg8::cvt_pk_bf16(lo, hi); }
__device__ __forceinline__ float wave_sum(float v) {
#pragma unroll
    for (int o = 1; o < 64; o <<= 1) v += __shfl_xor(v, o);
    return v;
}
__device__ __forceinline__ float red16(float v) { v += __shfl_xor(v, 1); v += __shfl_xor(v, 2); v += __shfl_xor(v, 4); v += __shfl_xor(v, 8); return v; }
__device__ __forceinline__ float sigmoidf_(float x) { return 1.0f / (1.0f + __expf(-x)); }
__device__ __forceinline__ void rope_cs(float pos, int j, float& c, float& s) {
    const float inv = exp2f(-0.8304820237218406f * (float)j);
    const float ang = pos * inv;
    const float k = rintf(ang * 0.15915494309189535f);
    float r = fmaf(-k, 6.2831854820251465f, ang); r = fmaf(-k, -1.7484555e-7f, r);
    s = __sinf(r); c = __cosf(r);
}
__device__ __forceinline__ float row_pos(int row1) { return row1 < MP ? (float)(row1 % LP) : (float)(PAST + ((row1 - MP) & 31)); }

namespace pg8 {
struct EpiStore {
    static constexpr bool PERM = true, AFTER_DRAIN = false;
    bf16_t* O; int ldc;
    __device__ __forceinline__ void operator()(const f32x4 (&acc)[2][2][4][2], const Unit& u, int wr, int wc, int fr, int fq) const {
        const int row0 = u.pm * BM + wr * 64 + fr, col0 = u.pn * BM + wc * 32 + 8 * fq;
#pragma unroll
        for (int ai = 0; ai < 2; ++ai)
#pragma unroll
            for (int m = 0; m < 4; ++m) { bf16_t* rowp = O + (size_t)(row0 + ai * HALF + m * 16) * ldc + col0;
#pragma unroll
                for (int bj = 0; bj < 2; ++bj) { const f32x4 v0 = acc[ai][bj][m][0], v1 = acc[ai][bj][m][1]; u32x4 w;
                    w.x = cvt_pk_bf16(v0[0], v0[1]); w.y = cvt_pk_bf16(v0[2], v0[3]); w.z = cvt_pk_bf16(v1[0], v1[1]); w.w = cvt_pk_bf16(v1[2], v1[3]);
                    *(u32x4*)(rowp + bj * HALF) = w; } }
    }
};
struct EpiKV {
    static constexpr bool PERM = true, AFTER_DRAIN = false;
    bf16_t* KN; bf16_t* V; const float* gk;
    __device__ __forceinline__ void operator()(const f32x4 (&acc)[2][2][4][2], const Unit& u, int wr, int wc, int fr, int fq) const {
        const int slot = u.pn * 4 + wc, h = slot & 7;
        const size_t off0 = (size_t)(u.pm * BM + wr * 64 + fr) * 512 + h * 64 + 8 * fq;
        if (slot >= 8) {
#pragma unroll
            for (int ai = 0; ai < 2; ++ai)
#pragma unroll
                for (int m = 0; m < 4; ++m) { bf16_t* dst = V + off0 + (size_t)(ai * HALF + m * 16) * 512;
#pragma unroll
                    for (int bj = 0; bj < 2; ++bj) { const f32x4 v0 = acc[ai][bj][m][0], v1 = acc[ai][bj][m][1]; u32x4 w;
                        w.x = cvt_pk_bf16(v0[0], v0[1]); w.y = cvt_pk_bf16(v0[2], v0[3]); w.z = cvt_pk_bf16(v1[0], v1[1]); w.w = cvt_pk_bf16(v1[2], v1[3]);
                        *(u32x4*)(dst + 32 * bj) = w; } }
        } else {
#pragma unroll
            for (int ai = 0; ai < 2; ++ai)
#pragma unroll
                for (int m = 0; m < 4; ++m) {
                    float ss = 0.f;
#pragma unroll
                    for (int bj = 0; bj < 2; ++bj)
#pragma unroll
                        for (int n = 0; n < 2; ++n) { const f32x4 x = acc[ai][bj][m][n]; ss += (x[0] * x[0] + x[1] * x[1]) + (x[2] * x[2] + x[3] * x[3]); }
                    ss += __shfl_xor(ss, 16); ss += __shfl_xor(ss, 32);
                    const float rs = rsqrtf(ss * (1.0f / 64.0f) + EPS);
                    bf16_t* dst = KN + off0 + (size_t)(ai * HALF + m * 16) * 512;
#pragma unroll
                    for (int bj = 0; bj < 2; ++bj) { const f32x4 v0 = acc[ai][bj][m][0] * rs, v1 = acc[ai][bj][m][1] * rs; u32x4 w;
                        w.x = cvt_pk_bf16(v0[0], v0[1]); w.y = cvt_pk_bf16(v0[2], v0[3]); w.z = cvt_pk_bf16(v1[0], v1[1]); w.w = cvt_pk_bf16(v1[2], v1[3]);
                        *(u32x4*)(dst + 32 * bj) = w; }
                    asm volatile("" ::: "memory");
                }
        }
    }
};
struct EpiRes {
    static constexpr bool PERM = false, AFTER_DRAIN = false;
    float* O; const float* r0; const float* r1; int split;
    __device__ __forceinline__ void operator()(const f32x4 (&acc)[2][2][4][2], const Unit& u, int wr, int wc, int fr, int fq) const {
        const int col0 = u.pn * BM + wc * 32 + 4 * fq;
#pragma unroll
        for (int ai = 0; ai < 2; ++ai)
#pragma unroll
            for (int m = 0; m < 4; ++m) {
                const int row = u.pm * BM + ai * HALF + wr * 64 + m * 16 + fr;
                const float* rp = (row < split ? r0 + (size_t)row * 1024 : r1 + (size_t)(row - split) * 1024) + col0;
                float* op = O + (size_t)row * 1024 + col0;
#pragma unroll
                for (int bj = 0; bj < 2; ++bj)
#pragma unroll
                    for (int n = 0; n < 2; ++n) { const f32x4 x = *(const f32x4*)(rp + bj * HALF + n * 16); *(f32x4*)(op + bj * HALF + n * 16) = acc[ai][bj][m][n] + x; }
            }
    }
};
struct EpiResToB16 {
    static constexpr bool PERM = false, AFTER_DRAIN = false;
    bf16_t* H; const float* x;
    __device__ __forceinline__ void operator()(const f32x4 (&acc)[2][2][4][2], const Unit& u, int wr, int wc, int fr, int fq) const {
        const int col0 = u.pn * BM + wc * 32 + 4 * fq;
#pragma unroll
        for (int ai = 0; ai < 2; ++ai)
#pragma unroll
            for (int m = 0; m < 4; ++m) {
                const size_t o = (size_t)(u.pm * BM + ai * HALF + wr * 64 + m * 16 + fr) * 1024 + col0;
#pragma unroll
                for (int bj = 0; bj < 2; ++bj)
#pragma unroll
                    for (int n = 0; n < 2; ++n) { const f32x4 h = acc[ai][bj][m][n] + *(const f32x4*)(x + o + bj * HALF + n * 16);
                        u32x2 w; w.x = cvt_pk_bf16(h[0], h[1]); w.y = cvt_pk_bf16(h[2], h[3]); *(u32x2*)(H + o + bj * HALF + n * 16) = w; }
            }
    }
};
struct EpiOutFromB16 {
    static constexpr bool PERM = false, AFTER_DRAIN = false;
    float* O; const bf16_t* H;
    __device__ __forceinline__ void operator()(const f32x4 (&acc)[2][2][4][2], const Unit& u, int wr, int wc, int fr, int fq) const {
        const int col0 = u.pn * BM + wc * 32 + 4 * fq;
#pragma unroll
        for (int ai = 0; ai < 2; ++ai)
#pragma unroll
            for (int m = 0; m < 4; ++m) {
                const size_t o = (size_t)(u.pm * BM + ai * HALF + wr * 64 + m * 16 + fr) * 1024 + col0;
#pragma unroll
                for (int bj = 0; bj < 2; ++bj)
#pragma unroll
                    for (int n = 0; n < 2; ++n) { const u32x2 r = *(const u32x2*)(H + o + bj * HALF + n * 16);
                        const f32x4 h = {bflo(r.x), bfhi(r.x), bflo(r.y), bfhi(r.y)};
                        *(f32x4*)(O + o + bj * HALF + n * 16) = acc[ai][bj][m][n] + h; }
            }
    }
};
struct EpiSwiglu {
    static constexpr bool PERM = true, AFTER_DRAIN = false;
    bf16_t* O;
    __device__ __forceinline__ void operator()(const f32x4 (&acc)[2][2][4][2], const Unit& u, int wr, int wc, int fr, int fq) const {
        const int col0 = u.pn * HALF + wc * 32 + 8 * fq;
#pragma unroll
        for (int ai = 0; ai < 2; ++ai)
#pragma unroll
            for (int m = 0; m < 4; ++m) {
                const int row = u.pm * BM + ai * HALF + wr * 64 + m * 16 + fr;
                float o[8];
#pragma unroll
                for (int n = 0; n < 2; ++n)
#pragma unroll
                    for (int e = 0; e < 4; ++e) { const float g = acc[ai][0][m][n][e], up = acc[ai][1][m][n][e]; o[4 * n + e] = g * sigmoidf_(g) * up; }
                u32x4 w; w.x = cvt_pk_bf16(o[0], o[1]); w.y = cvt_pk_bf16(o[2], o[3]); w.z = cvt_pk_bf16(o[4], o[5]); w.w = cvt_pk_bf16(o[6], o[7]);
                *(u32x4*)(O + (size_t)row * DFF + col0) = w;
            }
    }
};
struct SplitOrder {
    int pm0, npm, nN, nkc, G, c;
    __device__ bool next(int i, Unit& u) const {
        const long L = (long)i * G + (G - 1 - c); if (L >= (long)npm * nN * nkc) return false;
        const int l = (int)L; u.kc = l % nkc; const int t = l / nkc; u.pn = t % nN; u.pm = pm0 + t / nN; return true;
    }
    __device__ __forceinline__ void a_ready(const Unit&) const {}
    __device__ __forceinline__ void done(const Unit&) const {}
};
struct EpiPartial {
    static constexpr bool PERM = false, AFTER_DRAIN = false;
    float* PB; int row0;
    __device__ __forceinline__ void operator()(const f32x4 (&acc)[2][2][4][2], const Unit& u, int wr, int wc, int fr, int fq) const {
        const int col0 = u.pn * BM + wc * 32 + 4 * fq;
        float* base = PB + ((size_t)u.kc * 1024 + (u.pm * BM + wr * 64 + fr - row0)) * 1024 + col0;
#pragma unroll
        for (int ai = 0; ai < 2; ++ai)
#pragma unroll
            for (int m = 0; m < 4; ++m) {
                float* op = base + (size_t)(ai * HALF + m * 16) * 1024;
#pragma unroll
                for (int bj = 0; bj < 2; ++bj)
#pragma unroll
                    for (int n = 0; n < 2; ++n) *(f32x4*)(op + bj * HALF + n * 16) = acc[ai][bj][m][n];
            }
    }
};
}

__device__ __forceinline__ float wsrc(const P& p, int mat, int n, int k) {
    switch (mat) {
    case 0: return n < INCOLS ? p.w_in[(size_t)k * INCOLS + n] : 0.f;
    case 1: return p.w_qup[(size_t)k * 768 + n];
    case 2: { const int pn = n >> 8, bj = (n >> 7) & 1, wc = (n >> 5) & 3, x = n & 31, slot = pn * 4 + wc;
              const int c = (slot & 7) * 128 + (slot < 8 ? 0 : 64) + 32 * bj + x;
              return p.w_kvup[(size_t)k * 1024 + c]; }
    case 3: { if (n < 512) return k < 64 ? p.w2[(size_t)k * 512 + n] : 0.f;
              if (n < 1024) return (k >= 64 && k < 128) ? p.a2[(size_t)(k - 64) * 512 + (n - 512)] : 0.f;
              return k >= 128 ? p.g2[(size_t)(k - 128) * 512 + (n - 1024)] : 0.f; }
    case 4: return p.w_out[(size_t)k * 1024 + n];
    case 5: { const int pn = n >> 8, r = n & 255; return r < 128 ? p.w_gate[(size_t)k * DFF + pn * 128 + r] : p.w_up[(size_t)k * DFF + pn * 128 + r - 128]; }
    default: return p.w_down[(size_t)k * 1024 + n];
    }
}
__device__ __forceinline__ const float* xn_src(const P& p, int row) {
    if (row < MP) { const int b = row / LP, t = row % LP; return t < NMETA ? p.meta + (size_t)t * DM : p.xp + ((size_t)b * SEQ + (t - NMETA)) * DM; }
    return p.xs + (size_t)(row - MP) * DM;
}
__device__ __forceinline__ void phase_e0(const P& p, int wv, LAS unsigned char* lds) {
    LAS float* T = (LAS float*)lds;
    const int tid_l = wv * 64 + lane_id(); const int tid = tid_l, lane = tid & 63, wave = tid >> 6;
    constexpr int NT = 3120;
#define E0_DECODE(T_, mat, K, n0, k0, dst) do { int r_; \
        if ((T_) < 576)       { mat = 0; r_ = (T_);        K = 1024; dst = (bf16_t*)(p.ws + WS_WIN); } \
        else if ((T_) < 624)  { mat = 1; r_ = (T_) - 576;  K = 256;  dst = (bf16_t*)(p.ws + WS_WQ); } \
        else if ((T_) < 656)  { mat = 2; r_ = (T_) - 624;  K = 128;  dst = (bf16_t*)(p.ws + WS_WKV); } \
        else if ((T_) < 752)  { mat = 3; r_ = (T_) - 656;  K = 256;  dst = (bf16_t*)(p.ws + WS_WL); } \
        else if ((T_) < 1008) { mat = 4; r_ = (T_) - 752;  K = 1024; dst = (bf16_t*)(p.ws + WS_WOUT); } \
        else if ((T_) < 2416) { mat = 5; r_ = (T_) - 1008; K = 1024; dst = (bf16_t*)(p.ws + WS_WGU); } \
        else                  { mat = 6; r_ = (T_) - 2416; K = 2816; dst = (bf16_t*)(p.ws + WS_WDN); } \
        const int nkt_ = K / 64; n0 = (r_ / nkt_) * 64; k0 = (r_ % nkt_) * 64; } while (0)
    {
        float v[8];
        int t = blockIdx.x;
        if (t < NT) { int mat, K, n0, k0; bf16_t* dst; E0_DECODE(t, mat, K, n0, k0, dst); (void)dst;
#pragma unroll
            for (int i = 0; i < 8; ++i) v[i] = wsrc(p, mat, n0 + (tid & 63), k0 + (tid >> 6) + 8 * i); }
        for (; t < NT; t += gridDim.x) {
            int mat, K, n0, k0; bf16_t* dst; E0_DECODE(t, mat, K, n0, k0, dst); (void)mat;
#pragma unroll
            for (int i = 0; i < 8; ++i) T[((tid >> 6) + 8 * i) * 65 + (tid & 63)] = v[i];
            __syncthreads();
            const int tn = t + gridDim.x;
            if (tn < NT) { int mat2, K2, n02, k02; bf16_t* dst2; E0_DECODE(tn, mat2, K2, n02, k02, dst2); (void)dst2;
#pragma unroll
                for (int i = 0; i < 8; ++i) v[i] = wsrc(p, mat2, n02 + (tid & 63), k02 + (tid >> 6) + 8 * i); }
#pragma unroll
            for (int i = 0; i < 4; ++i) { const int n = (tid >> 5) + 16 * i, kq = tid & 31;
                *(unsigned*)(dst + (size_t)(n0 + n) * K + k0 + 2 * kq) = pk2(T[(2 * kq) * 65 + n], T[(2 * kq + 1) * 65 + n]); }
            __syncthreads();
        }
    }
#undef E0_DECODE
    bf16_t* XN = (bf16_t*)(p.ws + WS_XN);
    f32x4 g[4];
#pragma unroll
    for (int j = 0; j < 4; ++j) g[j] = *(const f32x4*)(p.g_mix + 4 * lane + 256 * j);
    const int xstride = gridDim.x * 8;
    for (int row = blockIdx.x * 8 + wave; row < M1; row += 2 * xstride) {
        const int rowb = row + xstride; const bool hb = rowb < M1;
        const float* sa = xn_src(p, row); const float* sb = xn_src(p, hb ? rowb : row);
        f32x4 va[4], vb[4]; float ssa = 0.f, ssb = 0.f;
#pragma unroll
        for (int j = 0; j < 4; ++j) { va[j] = *(const f32x4*)(sa + 4 * lane + 256 * j); vb[j] = *(const f32x4*)(sb + 4 * lane + 256 * j); }
#pragma unroll
        for (int j = 0; j < 4; ++j) { ssa += (va[j][0] * va[j][0] + va[j][1] * va[j][1]) + (va[j][2] * va[j][2] + va[j][3] * va[j][3]);
                                      ssb += (vb[j][0] * vb[j][0] + vb[j][1] * vb[j][1]) + (vb[j][2] * vb[j][2] + vb[j][3] * vb[j][3]); }
        const float rsa = rsqrtf(wave_sum(ssa) * (1.0f / DM) + EPS), rsb = rsqrtf(wave_sum(ssb) * (1.0f / DM) + EPS);
#pragma unroll
        for (int j = 0; j < 4; ++j) { const f32x4 o = va[j] * g[j] * rsa; u32x2 w; w.x = pk2(o[0], o[1]); w.y = pk2(o[2], o[3]);
            *(u32x2*)(XN + (size_t)row * DM + 4 * lane + 256 * j) = w; }
        if (hb) {
#pragma unroll
            for (int j = 0; j < 4; ++j) { const f32x4 o = vb[j] * g[j] * rsb; u32x2 w; w.x = pk2(o[0], o[1]); w.y = pk2(o[2], o[3]);
                *(u32x2*)(XN + (size_t)rowb * DM + 4 * lane + 256 * j) = w; } }
    }
}

struct E1Raw { u32x2 q; unsigned c, kr; u32x2 cur[7], prv[7]; };
__device__ __forceinline__ void e1_load(E1Raw& R, const bf16_t* PROJ, int row, int lane) {
    const bf16_t* pr = PROJ + (size_t)row * NPROJ;
    R.q = *(const u32x2*)(pr + 4 * lane); R.c = *(const unsigned*)(pr + 256 + 2 * lane); R.kr = pr[384 + (lane & 31)];
#pragma unroll
    for (int idx = 0; idx < 7; ++idx) R.cur[idx] = *(const u32x2*)(pr + RW0 + 4 * lane + 256 * idx);
    const bool nofirst = row < MP ? (row % LP != 0) : (((row - MP) & 31) != 0);
#pragma unroll
    for (int idx = 0; idx < 7; ++idx) R.prv[idx] = nofirst ? *(const u32x2*)(pr - NPROJ + RW0 + 4 * lane + 256 * idx) : (u32x2){0u, 0u};
}
__device__ __forceinline__ void e1_finish(const P& p, const E1Raw& R, int row, int lane, f32x4 gq, f32x2 gkv, float gkr) {
    bf16_t* QL = (bf16_t*)(p.ws + WS_QL); bf16_t* CALL = (bf16_t*)(p.ws + WS_CALL); bf16_t* KRALL = (bf16_t*)(p.ws + WS_KRALL);
    bf16_t* RKV = (bf16_t*)(p.ws + WS_RKV); bf16_t* LIN = (bf16_t*)(p.ws + WS_LIN);
    const bool isP = row < MP;
        int b, t; if (isP) { b = row / LP; t = row % LP; } else { b = (row - MP) >> 5; t = (row - MP) & 31; }
        const int rowk = isP ? b * KPB + 48 + t : MKP + b * KSAMP + PAST + t;
        const float pos = isP ? (float)t : (float)(PAST + t);
        { const u32x2 raw = R.q; const float x0 = bflo(raw.x), x1 = bfhi(raw.x), x2 = bflo(raw.y), x3 = bfhi(raw.y);
          const float rs = rsqrtf(wave_sum((x0 * x0 + x1 * x1) + (x2 * x2 + x3 * x3)) * (1.0f / 256.0f) + EPS);
          u32x2 w; w.x = pk2(x0 * rs * gq[0], x1 * rs * gq[1]); w.y = pk2(x2 * rs * gq[2], x3 * rs * gq[3]);
          *(u32x2*)(QL + (size_t)row * 256 + 4 * lane) = w; }
        { const unsigned raw = R.c; const float x0 = bflo(raw), x1 = bfhi(raw);
          const float rs = rsqrtf(wave_sum(x0 * x0 + x1 * x1) * (1.0f / 128.0f) + EPS);
          const float c0 = x0 * rs * gkv[0], c1 = x1 * rs * gkv[1];
          float* dst = isP ? p.out + OFF_KVP + ((size_t)b * LP + t) * 128 : p.out + OFF_KVS + ((size_t)b * DSQ + t) * 128;
          *(f32x2*)(dst + 2 * lane) = (f32x2){c0, c1};
          *(unsigned*)(CALL + (size_t)rowk * 128 + 2 * lane) = pk2(c0, c1); }
        { const int j = lane & 31; const float x = bf2f(R.kr);
          float ss = x * x; ss += __shfl_xor(ss, 1); ss += __shfl_xor(ss, 2); ss += __shfl_xor(ss, 4); ss += __shfl_xor(ss, 8); ss += __shfl_xor(ss, 16);
          const float y = x * rsqrtf(ss * (1.0f / 32.0f) + EPS) * gkr;
          const float pa = __shfl_xor(y, 16);
          float c, s; rope_cs(pos, j & 15, c, s);
          const float o = j < 16 ? y * c - pa * s : pa * s + y * c;
          if (lane < 32) {
              float* dst = isP ? p.out + OFF_KRP + ((size_t)b * LP + t) * 32 : p.out + OFF_KRS + ((size_t)b * DSQ + t) * 32;
              dst[j] = o; KRALL[(size_t)rowk * 32 + j] = (bf16_t)(pk2(o, 0.f) & 0xffffu);
          } }
        const bool first = (t == 0), last = isP ? (t == LP - 1) : (t == DSQ - 1);
        float* shdst = isP ? p.out + OFF_SHP + (size_t)b * RWC : p.out + OFF_SHS + (size_t)b * RWC;
#pragma unroll
        for (int idx = 0; idx < 7; ++idx) {
            const int c = 4 * lane + 256 * idx;
            const u32x2 raw = R.cur[idx];
            const f32x4 cur = {bflo(raw.x), bfhi(raw.x), bflo(raw.y), bfhi(raw.y)};
            f32x4 prev;
            if (first) { if (isP) prev = (f32x4){0.f, 0.f, 0.f, 0.f}; else prev = *(const f32x4*)(p.sshift + (size_t)b * RWC + c); }
            else { const u32x2 rp = R.prv[idx]; prev = (f32x4){bflo(rp.x), bfhi(rp.x), bflo(rp.y), bfhi(rp.y)}; }
            const f32x4 mu = *(const f32x4*)(p.mu + c);
            f32x4 xm = cur + (prev - cur) * mu;
            if (last) *(f32x4*)(shdst + c) = cur;
            if (idx < 6) { u32x2 w; w.x = pk2(xm[0], xm[1]); w.y = pk2(xm[2], xm[3]); *(u32x2*)(RKV + (size_t)row * 1536 + c) = w; }
            else {
                const int lc = 4 * lane;
                if (lc < 64) {
#pragma unroll
                    for (int e = 0; e < 4; ++e) xm[e] = tanhf(xm[e]); }
                else if (lc >= 128) {
#pragma unroll
                    for (int e = 0; e < 4; ++e) xm[e] = sigmoidf_(xm[e]); }
                u32x2 w; w.x = pk2(xm[0], xm[1]); w.y = pk2(xm[2], xm[3]); *(u32x2*)(LIN + (size_t)row * 256 + lc) = w;
            }
        }
    }
__device__ __forceinline__ void phase_e1(const P& p, int wv) {
    const int tid_l = wv * 64 + lane_id(); const int tid = tid_l, lane = tid & 63, wave = tid >> 6;
    const bf16_t* PROJ = (const bf16_t*)(p.ws + WS_PROJ);
    bf16_t* QL = (bf16_t*)(p.ws + WS_QL); bf16_t* CALL = (bf16_t*)(p.ws + WS_CALL); bf16_t* KRALL = (bf16_t*)(p.ws + WS_KRALL);
    bf16_t* RKV = (bf16_t*)(p.ws + WS_RKV); bf16_t* LIN = (bf16_t*)(p.ws + WS_LIN);
    {
        const size_t gt = (size_t)blockIdx.x * 512 + tid, gs = (size_t)gridDim.x * 512;
        {
            constexpr size_t NV1 = (size_t)NB * PAST * 128 / 4, NV2 = (size_t)NB * PAST * 32 / 4;
            for (size_t e = gt; e < NV1; e += 4 * gs) {
                f32x4 v[4];
#pragma unroll
                for (int u = 0; u < 4; ++u) { const size_t ee = e + u * gs; v[u] = ee < NV1 ? *(const f32x4*)(p.ckv + ee * 4) : (f32x4){0.f, 0.f, 0.f, 0.f}; }
#pragma unroll
                for (int u = 0; u < 4; ++u) { const size_t ee = e + u * gs; if (ee < NV1) { const size_t idx = ee * 4; const int b = (int)(idx / ((size_t)PAST * 128)); const size_t rem = idx - (size_t)b * PAST * 128;
                    u32x2 w; w.x = pk2(v[u][0], v[u][1]); w.y = pk2(v[u][2], v[u][3]); *(u32x2*)(CALL + ((size_t)MKP + (size_t)b * KSAMP) * 128 + rem) = w; } }
            }
            for (size_t e = gt; e < NV2; e += 4 * gs) {
                f32x4 v[4];
#pragma unroll
                for (int u = 0; u < 4; ++u) { const size_t ee = e + u * gs; v[u] = ee < NV2 ? *(const f32x4*)(p.ckr + ee * 4) : (f32x4){0.f, 0.f, 0.f, 0.f}; }
#pragma unroll
                for (int u = 0; u < 4; ++u) { const size_t ee = e + u * gs; if (ee < NV2) { const size_t idx = ee * 4; const int b = (int)(idx / ((size_t)PAST * 32)); const size_t rem = idx - (size_t)b * PAST * 32;
                    u32x2 w; w.x = pk2(v[u][0], v[u][1]); w.y = pk2(v[u][2], v[u][3]); *(u32x2*)(KRALL + ((size_t)MKP + (size_t)b * KSAMP) * 32 + rem) = w; } }
            }
        }
        for (size_t e = gt; e < (size_t)NB * 48 * 128 / 4; e += gs) {
            const size_t idx = e * 4; const int b = (int)(idx / (48 * 128)); const size_t rem = idx - (size_t)b * 48 * 128;
            *(u32x2*)(CALL + (size_t)b * KPB * 128 + rem) = (u32x2){0u, 0u};
        }
        for (size_t e = gt; e < (size_t)NB * 48 * 32 / 4; e += gs) {
            const size_t idx = e * 4; const int b = (int)(idx / (48 * 32)); const size_t rem = idx - (size_t)b * 48 * 32;
            *(u32x2*)(KRALL + (size_t)b * KPB * 32 + rem) = (u32x2){0u, 0u};
        }
    }
    const f32x4 gq = *(const f32x4*)(p.g_q + 4 * lane);
    const f32x2 gkv = *(const f32x2*)(p.g_kv + 2 * lane);
    const float gkr = p.g_kr[lane & 31];
    const int e1stride = gridDim.x * 8;
    for (int row = blockIdx.x * 8 + wave; row < M1; row += 2 * e1stride) {
        const int rowb = row + e1stride; const bool hb = rowb < M1;
        E1Raw ra, rb;
        e1_load(ra, PROJ, row, lane); e1_load(rb, PROJ, hb ? rowb : row, lane);
        e1_finish(p, ra, row, lane, gq, gkv, gkr);
        if (hb) e1_finish(p, rb, rowb, lane, gq, gkv, gkr);
    }

}

template <int CTRL> __device__ __forceinline__ float dppf(float v) { return __uint_as_float(__builtin_amdgcn_update_dpp(0u, __float_as_uint(v), CTRL, 0xF, 0xF, true)); }
__device__ __forceinline__ float red8(float v) { v += dppf<0xB1>(v); v += dppf<0x4E>(v); v += dppf<0x141>(v); return v; }
__device__ __forceinline__ float red16d(float v) { v += dppf<0xB1>(v); v += dppf<0x4E>(v); v += dppf<0x141>(v); v += dppf<0x140>(v); return v; }

struct ScanPre { u32x2 r, k, v, lw, la, g; };
struct ScanKeep { f32x4 v; float bon; u32x2 g; };
struct ScanConst { f32x4 kk, ka, rk, lg, lb, w0, a0; };
constexpr int SC_BUF = 12416;

__device__ __forceinline__ void scan_load(ScanPre& q, const bf16_t* RKV, const bf16_t* LO, size_t row, int hc) {
    q.r = *(const u32x2*)(RKV + row * 1536 + hc); q.k = *(const u32x2*)(RKV + row * 1536 + 512 + hc); q.v = *(const u32x2*)(RKV + row * 1536 + 1024 + hc);
    q.lw = *(const u32x2*)(LO + row * 1536 + hc); q.la = *(const u32x2*)(LO + row * 1536 + 512 + hc); q.g = *(const u32x2*)(LO + row * 1536 + 1024 + hc);
}
__device__ __forceinline__ void scan_stage_a(const ScanPre& q, const ScanConst& C, LAS float* buf, int tt, int dq, ScanKeep& keep) {
    const f32x4 r = {bflo(q.r.x), bfhi(q.r.x), bflo(q.r.y), bfhi(q.r.y)}, k = {bflo(q.k.x), bfhi(q.k.x), bflo(q.k.y), bfhi(q.k.y)}, v = {bflo(q.v.x), bfhi(q.v.x), bflo(q.v.y), bfhi(q.v.y)};
    const f32x4 lw = (f32x4){bflo(q.lw.x), bfhi(q.lw.x), bflo(q.lw.y), bfhi(q.lw.y)} + C.w0, la = (f32x4){bflo(q.la.x), bfhi(q.la.x), bflo(q.la.y), bfhi(q.la.y)} + C.a0;
    f32x4 w, a;
#pragma unroll
    for (int c = 0; c < 4; ++c) { w[c] = __expf(-0.6065306597126334f * sigmoidf_(lw[c])); a[c] = sigmoidf_(la[c]); }
    const f32x4 kkr = k * C.kk;
    const float ss = red16d((kkr[0] * kkr[0] + kkr[1] * kkr[1]) + (kkr[2] * kkr[2] + kkr[3] * kkr[3]));
    const float inv = 1.0f / fmaxf(sqrtf(ss), 1e-12f);
    const f32x4 kk = kkr * inv;
    const f32x4 keff = k * (1.0f + (a - 1.0f) * C.ka);
    const f32x4 bb = a * kk, wr = w * r;
    const f32x4 t1 = bb * r, t2 = keff * r, t3 = t2 * C.rk;
    const float br = red16d((t1[0] + t1[1]) + (t1[2] + t1[3])), kr = red16d((t2[0] + t2[1]) + (t2[2] + t2[3])), bon = red16d((t3[0] + t3[1]) + (t3[2] + t3[3]));
    const int o = tt * 64 + 4 * dq;
    *(LAS f32x4*)(buf + o) = w; *(LAS f32x4*)(buf + 2048 + o) = bb; *(LAS f32x4*)(buf + 4096 + o) = keff; *(LAS f32x4*)(buf + 6144 + o) = kk; *(LAS f32x4*)(buf + 8192 + o) = wr; *(LAS f32x4*)(buf + 10240 + o) = v;
    if (dq == 0) *(LAS f32x4*)(buf + 12288 + tt * 4) = (f32x4){br, kr, bon, 0.f};
    keep.v = v; keep.bon = bon; keep.g = q.g;
}

struct ScanVec { f32x4 k0, k1, q0, q1, w0, w1, b0, b1, e0, e1, sc; float vi0, vi1; };
#define SV_DSR128(dst, addr, off) asm volatile("ds_read_b128 %0, %1 offset:" #off : "=v"(dst) : "v"(addr))
#define SV_DSR32(dst, addr, off) asm volatile("ds_read_b32 %0, %1 offset:" #off : "=v"(dst) : "v"(addr))
__device__ __forceinline__ void sv_issue(ScanVec& s, unsigned a_vec, unsigned a_sc, unsigned a_v) {
    SV_DSR128(s.k0, a_vec, 24576); SV_DSR128(s.k1, a_vec, 24592); SV_DSR128(s.q0, a_vec, 32768); SV_DSR128(s.q1, a_vec, 32784);
    SV_DSR128(s.sc, a_sc, 49152); SV_DSR32(s.vi0, a_v, 40960); SV_DSR32(s.vi1, a_v, 41088);
    SV_DSR128(s.w0, a_vec, 0); SV_DSR128(s.w1, a_vec, 16); SV_DSR128(s.b0, a_vec, 8192); SV_DSR128(s.b1, a_vec, 8208);
    SV_DSR128(s.e0, a_vec, 16384); SV_DSR128(s.e1, a_vec, 16400);
}
__device__ __forceinline__ void sv_wait(ScanVec& s) {
    asm volatile("s_waitcnt lgkmcnt(0)" : "+v"(s.k0), "+v"(s.k1), "+v"(s.q0), "+v"(s.q1), "+v"(s.w0), "+v"(s.w1), "+v"(s.b0), "+v"(s.b1), "+v"(s.e0), "+v"(s.e1), "+v"(s.sc), "+v"(s.vi0), "+v"(s.vi1));
}
__device__ __forceinline__ f32x2 lo2(f32x4 v) { return __builtin_shufflevector(v, v, 0, 1); }
__device__ __forceinline__ f32x2 hi2(f32x4 v) { return __builtin_shufflevector(v, v, 2, 3); }
__device__ __forceinline__ f32x2 fma2(f32x2 a, f32x2 b, f32x2 c) { return __builtin_elementwise_fma(a, b, c); }
__device__ __forceinline__ float sv_row(f32x2 (&S)[4], const ScanVec& s, float vi) {
    f32x2 a1 = S[0] * lo2(s.k0), a2 = S[0] * lo2(s.q0);
    a1 = fma2(S[1], hi2(s.k0), a1); a2 = fma2(S[1], hi2(s.q0), a2);
    a1 = fma2(S[2], lo2(s.k1), a1); a2 = fma2(S[2], lo2(s.q1), a2);
    a1 = fma2(S[3], hi2(s.k1), a1); a2 = fma2(S[3], hi2(s.q1), a2);
    const float d1 = red8(a1.x + a1.y), d2 = red8(a2.x + a2.y);
    const float sa = -d1;
    const float y = d2 + sa * s.sc[0] + vi * s.sc[1];
    const f32x2 sa2 = {sa, sa}, vi2 = {vi, vi};
    S[0] = fma2(S[0], lo2(s.w0), fma2(sa2, lo2(s.b0), vi2 * lo2(s.e0)));
    S[1] = fma2(S[1], hi2(s.w0), fma2(sa2, hi2(s.b0), vi2 * hi2(s.e0)));
    S[2] = fma2(S[2], lo2(s.w1), fma2(sa2, lo2(s.b1), vi2 * lo2(s.e1)));
    S[3] = fma2(S[3], hi2(s.w1), fma2(sa2, hi2(s.b1), vi2 * hi2(s.e1)));
    return y;
}
__device__ __forceinline__ void sv_step(f32x2 (&S0)[4], f32x2 (&S1)[4], const ScanVec& s, LAS float* Yc, int t, int i2, int j) {
    const float y0 = sv_row(S0, s, s.vi0), y1 = sv_row(S1, s, s.vi1);
    if (j == 0) { Yc[t * 64 + i2] = y0; Yc[t * 64 + 32 + i2] = y1; }
}
__device__ __forceinline__ void scan_stage_c(const ScanConst& C, const LAS float* buf, const LAS float* Yc, int tl, int dq, bool valid, u32x2 graw, bf16_t* dst) {
    const f32x4 y = *(const LAS f32x4*)(Yc + tl * 64 + 4 * dq);
    const float mean = red16d((y[0] + y[1]) + (y[2] + y[3])) * (1.0f / 64.0f);
    const f32x4 d = y - mean;
    const float var = red16d((d[0] * d[0] + d[1] * d[1]) + (d[2] * d[2] + d[3] * d[3])) * (1.0f / 64.0f);
    const f32x4 v = *(const LAS f32x4*)(buf + 10240 + tl * 64 + 4 * dq);
    const float bon = buf[12288 + tl * 4 + 2];
    if (valid) {
        const float rstd = rsqrtf(var + LNX_EPS);
        const f32x4 g = {bflo(graw.x), bfhi(graw.x), bflo(graw.y), bfhi(graw.y)};
        const f32x4 o = (d * rstd * C.lg + C.lb + v * bon) * g;
        u32x2 w; w.x = pk2(o[0], o[1]); w.y = pk2(o[2], o[3]);
        *(u32x2*)dst = w;
    }
}

__device__ __forceinline__ void scan_unit(const P& p, int wv, LAS unsigned char* lds, int row1_base, int nsteps, const float* s0, float* s_out, int first_out, int row2_base, int h) {
    const int tid_l = wv * 64 + lane_id(); const int tid = tid_l;
    const bool is_rec = tid < 256;
    LAS float* BUF = (LAS float*)lds;
    LAS float* Y = BUF + 2 * SC_BUF;
    const bf16_t* RKV = (const bf16_t*)(p.ws + WS_RKV); const bf16_t* LO = (const bf16_t*)(p.ws + WS_E);
    bf16_t* MIX = (bf16_t*)(p.ws + WS_MIX);
    const int nch = (nsteps + 31) >> 5;
    __syncthreads();
    if (is_rec) {
        const int i2 = tid >> 3, j = tid & 7;
        f32x2 S0[4], S1[4];
        if (s0) { const f32x4 a = *(const f32x4*)(s0 + i2 * 64 + 8 * j), b = *(const f32x4*)(s0 + i2 * 64 + 8 * j + 4), c = *(const f32x4*)(s0 + (i2 + 32) * 64 + 8 * j), d = *(const f32x4*)(s0 + (i2 + 32) * 64 + 8 * j + 4);
            S0[0] = lo2(a); S0[1] = hi2(a); S0[2] = lo2(b); S0[3] = hi2(b); S1[0] = lo2(c); S1[1] = hi2(c); S1[2] = lo2(d); S1[3] = hi2(d); }
        else {
#pragma unroll
            for (int cc = 0; cc < 4; ++cc) { S0[cc] = (f32x2){0.f, 0.f}; S1[cc] = (f32x2){0.f, 0.f}; } }
        const unsigned lbase = (unsigned)(unsigned long long)BUF;
        __syncthreads();
        for (int c = 0; c < nch; ++c) {
            const int c0 = c * 32, T = (nsteps - c0) < 32 ? (nsteps - c0) : 32;
            LAS float* Yc = Y + (c & 1) * 2048;
            const unsigned bb = lbase + (unsigned)(c & 1) * (SC_BUF * 4u);
            unsigned a_vec = bb + 32u * j, a_sc = bb, a_v = bb + 4u * i2;
            ScanVec va, vb;
            sv_issue(va, a_vec, a_sc, a_v); sv_wait(va);
            for (int t = 0; t < T; t += 2) {
                sv_issue(vb, a_vec + 256u, a_sc + 16u, a_v + 256u);
                sv_step(S0, S1, va, Yc, t, i2, j);
                sv_wait(vb);
                const unsigned adv = (t + 2 < T) ? 2u : 1u;
                a_vec += 256u * adv; a_sc += 16u * adv; a_v += 256u * adv;
                sv_issue(va, a_vec, a_sc, a_v);
                sv_step(S0, S1, vb, Yc, t + 1, i2, j);
                sv_wait(va);
            }
            __syncthreads();
        }
        float* so = s_out + i2 * 64 + 8 * j;
        *(f32x4*)so = (f32x4){S0[0].x, S0[0].y, S0[1].x, S0[1].y}; *(f32x4*)(so + 4) = (f32x4){S0[2].x, S0[2].y, S0[3].x, S0[3].y};
        *(f32x4*)(so + 2048) = (f32x4){S1[0].x, S1[0].y, S1[1].x, S1[1].y}; *(f32x4*)(so + 2052) = (f32x4){S1[2].x, S1[2].y, S1[3].x, S1[3].y};
    } else {
        const int ptid = tid - 256, tt = ptid >> 4, dq = ptid & 15, hc = h * 64 + 4 * dq;
        ScanConst C;
        C.kk = *(const f32x4*)(p.k_k + hc); C.ka = *(const f32x4*)(p.k_a + hc); C.rk = *(const f32x4*)(p.r_k + hc);
        C.lg = *(const f32x4*)(p.lnx_g + hc); C.lb = *(const f32x4*)(p.lnx_b + hc); C.w0 = *(const f32x4*)(p.w0 + hc); C.a0 = *(const f32x4*)(p.a0 + hc);
        ScanPre pa, pb; ScanKeep kdummy;
        pa.r = pa.k = pa.v = pa.lw = pa.la = pa.g = (u32x2){0u, 0u}; pb = pa;
        if (tt < nsteps) scan_load(pa, RKV, LO, (size_t)(row1_base + tt), hc);
        if (tt + 16 < nsteps) scan_load(pb, RKV, LO, (size_t)(row1_base + tt + 16), hc);
        if (tt < nsteps) scan_stage_a(pa, C, BUF, tt, dq, kdummy);
        if (tt + 16 < nsteps) scan_stage_a(pb, C, BUF, tt + 16, dq, kdummy);
        if (32 + tt < nsteps) scan_load(pa, RKV, LO, (size_t)(row1_base + 32 + tt), hc);
        if (48 + tt < nsteps) scan_load(pb, RKV, LO, (size_t)(row1_base + 48 + tt), hc);
        __syncthreads();
        for (int c = 0; c < nch; ++c) {
            const int c0 = c * 32;
            if (c >= 1) {
                const int pc0 = c0 - 32; const LAS float* bufp = BUF + ((c - 1) & 1) * SC_BUF; const LAS float* Yp = Y + ((c - 1) & 1) * 2048;
                const int tok0 = pc0 + tt, tok1 = pc0 + tt + 16;
                const bool v0 = tok0 >= first_out, v1 = tok1 >= first_out;
                u32x2 g0 = {0u, 0u}, g1 = {0u, 0u};
                if (v0) g0 = *(const u32x2*)(LO + (size_t)(row1_base + tok0) * 1536 + 1024 + hc);
                if (v1) g1 = *(const u32x2*)(LO + (size_t)(row1_base + tok1) * 1536 + 1024 + hc);
                scan_stage_c(C, bufp, Yp, tt, dq, v0, g0, MIX + (size_t)(row2_base + tok0 - first_out) * 1024 + 512 + hc);
                scan_stage_c(C, bufp, Yp, tt + 16, dq, v1, g1, MIX + (size_t)(row2_base + tok1 - first_out) * 1024 + 512 + hc);
            }
            if (c0 + 32 + tt < nsteps) scan_stage_a(pa, C, BUF + ((c + 1) & 1) * SC_BUF, tt, dq, kdummy);
            if (c0 + 48 + tt < nsteps) scan_stage_a(pb, C, BUF + ((c + 1) & 1) * SC_BUF, tt + 16, dq, kdummy);
            if (c0 + 64 + tt < nsteps) scan_load(pa, RKV, LO, (size_t)(row1_base + c0 + 64 + tt), hc);
            if (c0 + 80 + tt < nsteps) scan_load(pb, RKV, LO, (size_t)(row1_base + c0 + 80 + tt), hc);
            __syncthreads();
        }
        {
            const int c = nch - 1, pc0 = c * 32, T = nsteps - pc0; const LAS float* bufp = BUF + (c & 1) * SC_BUF; const LAS float* Yp = Y + (c & 1) * 2048;
            const int tok0 = pc0 + tt, tok1 = pc0 + tt + 16;
            const bool v0 = tt < T && tok0 >= first_out, v1 = tt + 16 < T && tok1 >= first_out;
            u32x2 g0 = {0u, 0u}, g1 = {0u, 0u};
            if (v0) g0 = *(const u32x2*)(LO + (size_t)(row1_base + tok0) * 1536 + 1024 + hc);
            if (v1) g1 = *(const u32x2*)(LO + (size_t)(row1_base + tok1) * 1536 + 1024 + hc);
            scan_stage_c(C, bufp, Yp, tt, dq, v0, g0, MIX + (size_t)(row2_base + tok0 - first_out) * 1024 + 512 + hc);
            scan_stage_c(C, bufp, Yp, tt + 16, dq, v1, g1, MIX + (size_t)(row2_base + tok1 - first_out) * 1024 + 512 + hc);
        }
    }
}
__device__ __forceinline__ void phase_scan(const P& p, int wv, LAS unsigned char* lds) {
    for (int u = blockIdx.x; u < 512; u += gridDim.x) {
        const int uu = u & 255, b = uu >> 3, h = uu & 7;
        if (u < 256) scan_unit(p, wv, lds, b * LP, LP, nullptr, p.out + OFF_WKVP + (size_t)uu * 4096, NMETA, b * SEQ, h);
        else scan_unit(p, wv, lds, MP + b * DSQ, DSQ, p.swkv + (size_t)uu * 4096, p.out + OFF_WKVS + (size_t)uu * 4096, 0, M2P + b * DSQ, h);
    }
}

__device__ __forceinline__ int crow(int r, int hi) { return (r & 3) + 8 * (r >> 2) + 4 * hi; }
constexpr float ATT_THR = 12.0f;
__device__ __forceinline__ float xhalf_max(float v) { const auto rr = __builtin_amdgcn_permlane32_swap(__float_as_uint(v), __float_as_uint(v), false, false); return fmaxf(__uint_as_float(rr[0]), __uint_as_float(rr[1])); }
__device__ __forceinline__ float xhalf_sum(float v) { const auto rr = __builtin_amdgcn_permlane32_swap(__float_as_uint(v), __float_as_uint(v), false, false); return __uint_as_float(rr[0]) + __uint_as_float(rr[1]); }
__device__ __forceinline__ void att_blk(const LAS unsigned char* Kc, const LAS unsigned char* Vimg, const bf16x8 (&qf)[6], float& m, float& l, f32x16 (&O)[2], int lane, int nmask) {
    const int q = lane & 31, hi = lane >> 5;
    f32x16 s; const float nm = -m;
#pragma unroll
    for (int r = 0; r < 16; ++r) s[r] = nm;
#pragma unroll
    for (int i = 0; i < 6; ++i) { const bf16x8 kf = *(const LAS bf16x8*)(Kc + q * 208 + (16 * i + 8 * hi) * 2); s = __builtin_amdgcn_mfma_f32_32x32x16_bf16(kf, qf[i], s, 0, 0, 0); }
    if (nmask > 0) {
#pragma unroll
        for (int r = 0; r < 16; ++r) if (crow(r, hi) < nmask) s[r] = -1e30f; }
    float mx = fmaxf(s[0], s[1]);
#pragma unroll
    for (int r = 2; r < 16; r += 2) mx = fmaxf(fmaxf(mx, s[r]), s[r + 1]);
    if (__builtin_amdgcn_ballot_w64(mx > ATT_THR) != 0ull) {
        const float delta = fmaxf(xhalf_max(mx), 0.f), alpha = __builtin_amdgcn_exp2f(-delta);
        m += delta; l *= alpha;
#pragma unroll
        for (int r = 0; r < 16; ++r) { O[0][r] *= alpha; O[1][r] *= alpha; s[r] -= delta; }
    }
    float rsum = 0.f;
#pragma unroll
    for (int r = 0; r < 16; ++r) { s[r] = __builtin_amdgcn_exp2f(s[r]); rsum += s[r]; }
    l += rsum;
    bf16x8 pb[2];
#pragma unroll
    for (int i = 0; i < 2; ++i) { u32x4 w; w.x = pk2(s[8 * i + 0], s[8 * i + 1]); w.y = pk2(s[8 * i + 2], s[8 * i + 3]); w.z = pk2(s[8 * i + 4], s[8 * i + 5]); w.w = pk2(s[8 * i + 6], s[8 * i + 7]);
        pb[i] = __builtin_bit_cast(bf16x8, w); }
    typedef short v4i16_t __attribute__((ext_vector_type(4)));
    const int li = lane & 15, g16 = lane >> 4;
    const LAS unsigned char* vb = Vimg + (4 * hi + (li >> 2)) * 192 + (16 * (g16 & 1) + 4 * (li & 3)) * 2;
#pragma unroll
    for (int db = 0; db < 2; ++db)
#pragma unroll
        for (int i = 0; i < 2; ++i) {
            const v4i16_t lo = __builtin_amdgcn_ds_read_tr16_b64_v4i16((LAS v4i16_t*)(vb + (16 * i) * 192 + 64 * db));
            const v4i16_t hh = __builtin_amdgcn_ds_read_tr16_b64_v4i16((LAS v4i16_t*)(vb + (16 * i + 8) * 192 + 64 * db));
            const bf16x8 vf = {lo[0], lo[1], lo[2], lo[3], hh[0], hh[1], hh[2], hh[3]};
            O[db] = __builtin_amdgcn_mfma_f32_32x32x16_bf16(vf, pb[i], O[db], 0, 0, 0); }
}
__device__ __forceinline__ void att_tile64(const LAS unsigned char* Kc, const LAS unsigned char* Vimg, const bf16x8 (&qf)[6], float& m, float& l, f32x16 (&O)[2], int lane) {
    const int q = lane & 31, hi = lane >> 5;
    f32x16 s0, s1; const float nm = -m;
#pragma unroll
    for (int r = 0; r < 16; ++r) { s0[r] = nm; s1[r] = nm; }
#pragma unroll
    for (int i = 0; i < 6; ++i) {
        const bf16x8 k0 = *(const LAS bf16x8*)(Kc + q * 208 + (16 * i + 8 * hi) * 2), k1 = *(const LAS bf16x8*)(Kc + (32 + q) * 208 + (16 * i + 8 * hi) * 2);
        s0 = __builtin_amdgcn_mfma_f32_32x32x16_bf16(k0, qf[i], s0, 0, 0, 0); s1 = __builtin_amdgcn_mfma_f32_32x32x16_bf16(k1, qf[i], s1, 0, 0, 0); }
    float mx = fmaxf(s0[0], s1[0]);
#pragma unroll
    for (int r = 1; r < 16; ++r) mx = fmaxf(fmaxf(mx, s0[r]), s1[r]);
    if (__builtin_amdgcn_ballot_w64(mx > ATT_THR) != 0ull) {
        const float delta = fmaxf(xhalf_max(mx), 0.f), alpha = __builtin_amdgcn_exp2f(-delta);
        m += delta; l *= alpha;
#pragma unroll
        for (int r = 0; r < 16; ++r) { O[0][r] *= alpha; O[1][r] *= alpha; s0[r] -= delta; s1[r] -= delta; }
    }
    float rs0 = 0.f, rs1 = 0.f;
#pragma unroll
    for (int r = 0; r < 16; ++r) { s0[r] = __builtin_amdgcn_exp2f(s0[r]); s1[r] = __builtin_amdgcn_exp2f(s1[r]); rs0 += s0[r]; rs1 += s1[r]; }
    l += rs0 + rs1;
    bf16x8 pb[4];
#pragma unroll
    for (int i = 0; i < 2; ++i) { u32x4 w; w.x = pk2(s0[8 * i + 0], s0[8 * i + 1]); w.y = pk2(s0[8 * i + 2], s0[8 * i + 3]); w.z = pk2(s0[8 * i + 4], s0[8 * i + 5]); w.w = pk2(s0[8 * i + 6], s0[8 * i + 7]);
        pb[i] = __builtin_bit_cast(bf16x8, w);
        u32x4 x; x.x = pk2(s1[8 * i + 0], s1[8 * i + 1]); x.y = pk2(s1[8 * i + 2], s1[8 * i + 3]); x.z = pk2(s1[8 * i + 4], s1[8 * i + 5]); x.w = pk2(s1[8 * i + 6], s1[8 * i + 7]);
        pb[2 + i] = __builtin_bit_cast(bf16x8, x); }
    typedef short v4i16_t __attribute__((ext_vector_type(4)));
    const int li = lane & 15, g16 = lane >> 4;
    const LAS unsigned char* vb = Vimg + (4 * hi + (li >> 2)) * 192 + (16 * (g16 & 1) + 4 * (li & 3)) * 2;
#pragma unroll
    for (int i = 0; i < 4; ++i)
#pragma unroll
        for (int db = 0; db < 2; ++db) {
            const v4i16_t lo = __builtin_amdgcn_ds_read_tr16_b64_v4i16((LAS v4i16_t*)(vb + (16 * i) * 192 + 64 * db));
            const v4i16_t hh = __builtin_amdgcn_ds_read_tr16_b64_v4i16((LAS v4i16_t*)(vb + (16 * i + 8) * 192 + 64 * db));
            const bf16x8 vf = {lo[0], lo[1], lo[2], lo[3], hh[0], hh[1], hh[2], hh[3]};
            O[db] = __builtin_amdgcn_mfma_f32_32x32x16_bf16(vf, pb[i], O[db], 0, 0, 0); }
}
__device__ __forceinline__ int kpos(int key) { return (key & ~12) | ((key & 4) << 1) | ((key & 8) >> 1); }

__device__ __forceinline__ void load_q(bf16x8 (&qf)[6], const bf16_t* qrow, float pos, const float* gn, const float* gr, const float* gkn, int hi) {
    float x[6][8];
#pragma unroll
    for (int i = 0; i < 6; ++i) { const u32x4 raw = *(const u32x4*)(qrow + 16 * i + 8 * hi);
        x[i][0] = bflo(raw.x); x[i][1] = bfhi(raw.x); x[i][2] = bflo(raw.y); x[i][3] = bfhi(raw.y); x[i][4] = bflo(raw.z); x[i][5] = bfhi(raw.z); x[i][6] = bflo(raw.w); x[i][7] = bfhi(raw.w); }
    float ssn = 0.f, ssr = 0.f;
#pragma unroll
    for (int i = 0; i < 4; ++i)
#pragma unroll
        for (int e = 0; e < 8; ++e) ssn += x[i][e] * x[i][e];
#pragma unroll
    for (int i = 4; i < 6; ++i)
#pragma unroll
        for (int e = 0; e < 8; ++e) ssr += x[i][e] * x[i][e];
    ssn += __shfl_xor(ssn, 32); ssr += __shfl_xor(ssr, 32);
    const float rsn = rsqrtf(ssn * (1.0f / 64.0f) + EPS) * QSCALE, rsr = rsqrtf(ssr * (1.0f / 32.0f) + EPS) * QSCALE;
#pragma unroll
    for (int i = 0; i < 4; ++i) { float o[8];
#pragma unroll
        for (int e = 0; e < 8; ++e) o[e] = x[i][e] * rsn * (gn[16 * i + 8 * hi + e] * gkn[16 * i + 8 * hi + e]);
        u32x4 w; w.x = pk2(o[0], o[1]); w.y = pk2(o[2], o[3]); w.z = pk2(o[4], o[5]); w.w = pk2(o[6], o[7]); qf[i] = __builtin_bit_cast(bf16x8, w); }
    float o1[8], o2[8];
#pragma unroll
    for (int e = 0; e < 8; ++e) { const int j = 8 * hi + e; float c, s; rope_cs(pos, j, c, s);
        const float x1 = x[4][e] * rsr * gr[j], x2 = x[5][e] * rsr * gr[16 + j];
        o1[e] = x1 * c - x2 * s; o2[e] = x1 * s + x2 * c; }
    { u32x4 w; w.x = pk2(o1[0], o1[1]); w.y = pk2(o1[2], o1[3]); w.z = pk2(o1[4], o1[5]); w.w = pk2(o1[6], o1[7]); qf[4] = __builtin_bit_cast(bf16x8, w); }
    { u32x4 w; w.x = pk2(o2[0], o2[1]); w.y = pk2(o2[2], o2[3]); w.z = pk2(o2[4], o2[5]); w.w = pk2(o2[6], o2[7]); qf[5] = __builtin_bit_cast(bf16x8, w); }
}

constexpr int AT_KB = 64 * 208, AT_VB = 64 * 192, AT_BUF = AT_KB + AT_VB;
__device__ __forceinline__ void attn_prompt_unit(const P& p, int wv, LAS unsigned char* lds, int b, int h) {
    const int tid_l = wv * 64 + lane_id(); const int tid = tid_l, lane = tid & 63, w = tid >> 6, q = lane & 31, hi = lane >> 5;
    const bf16_t* Qb = (const bf16_t*)(p.ws + WS_Q); const bf16_t* KN = (const bf16_t*)(p.ws + WS_KN); const bf16_t* Vb = (const bf16_t*)(p.ws + WS_V);
    const bf16_t* KR = (const bf16_t*)(p.ws + WS_KRALL); bf16_t* ATT = (bf16_t*)(p.ws + WS_ATT);
    const int key = tid >> 3, part = tid & 7, key2 = tid >> 2, part2 = tid & 3;
    const size_t rowk_b = (size_t)b * KPB;
    for (int qt = 0; qt < 8; ++qt) {
        const size_t row1 = (size_t)b * LP + NMETA + 256 * qt + 32 * w + q;
        bf16x8 qf[6];
        load_q(qf, Qb + row1 * 768 + h * 96, (float)(NMETA + 256 * qt + 32 * w + q), p.g_qn, p.g_qr, p.g_kn, hi);
        const int cmax = 4 * qt + (w >> 1) + 1, ntile = 4 * qt + 5;
        float m = 0.f, l = 0.f; f32x16 O[2];
#pragma unroll
        for (int r = 0; r < 16; ++r) { O[0][r] = 0.f; O[1][r] = 0.f; }
        u32x4 rkn0, rkr0, rv0, rkn1, rkr1, rv1;
        rkr0 = rkr1 = (u32x4){0u, 0u, 0u, 0u};
#define AT_LOAD(S, JT) do { const size_t rk_ = rowk_b + 64 * (size_t)(JT); \
            rkn##S = *(const u32x4*)(KN + (rk_ + key) * 512 + h * 64 + 8 * part); rv##S = *(const u32x4*)(Vb + (rk_ + key) * 512 + h * 64 + 8 * part); \
            if (tid < 256) rkr##S = *(const u32x4*)(KR + (rk_ + key2) * 32 + 8 * part2); } while (0)
#define AT_STAGE(S, BUFI) do { LAS unsigned char* Kc_ = lds + (BUFI) * AT_BUF; LAS unsigned char* VT_ = Kc_ + AT_KB; \
            *(LAS u32x4*)(Kc_ + key * 208 + part * 16) = rkn##S; if (tid < 256) *(LAS u32x4*)(Kc_ + key2 * 208 + 128 + part2 * 16) = rkr##S; \
            *(LAS u32x4*)(VT_ + key * 192 + part * 16) = rv##S; } while (0)
#define AT_COMPUTE(JT, BUFI) do { if ((JT) <= cmax) { const LAS unsigned char* Kc_ = lds + (BUFI) * AT_BUF; const LAS unsigned char* VT_ = Kc_ + AT_KB; \
            if ((JT) > 0) att_tile64(Kc_, VT_, qf, m, l, O, lane); else att_blk(Kc_ + 32 * 208, VT_ + 32 * 192, qf, m, l, O, lane, 16); } } while (0)
        AT_LOAD(0, 0); AT_LOAD(1, 1);
        for (int jt = 0; jt < ntile; jt += 2) {
            AT_STAGE(0, 0);
            if (jt + 2 < ntile) AT_LOAD(0, jt + 2);
            __syncthreads();
            AT_COMPUTE(jt, 0);
            if (jt + 1 < ntile) {
                AT_STAGE(1, 1);
                if (jt + 3 < ntile) AT_LOAD(1, jt + 3);
                __syncthreads();
                AT_COMPUTE(jt + 1, 1);
            }
        }
#undef AT_LOAD
#undef AT_STAGE
#undef AT_COMPUTE
        __syncthreads();
        const float il = 1.0f / xhalf_sum(l);
        const size_t row2 = (size_t)b * SEQ + 256 * qt + 32 * w + q;
#pragma unroll
        for (int db = 0; db < 2; ++db)
#pragma unroll
            for (int rg = 0; rg < 4; ++rg) { u32x2 wv; wv.x = pk2(O[db][4 * rg] * il, O[db][4 * rg + 1] * il); wv.y = pk2(O[db][4 * rg + 2] * il, O[db][4 * rg + 3] * il);
                *(u32x2*)(ATT + row2 * 512 + h * 64 + 32 * db + 8 * rg + 4 * hi) = wv; }
    }
}
typedef __bf16 bf16x2_cv __attribute__((ext_vector_type(2)));
__device__ __forceinline__ unsigned pk2c(float lo, float hi) { const f32x2 v = {lo, hi}; const bf16x2_cv b = __builtin_convertvector(v, bf16x2_cv); return __builtin_bit_cast(unsigned, b); }
constexpr int AS_WIMG = 128 * 272;
constexpr int AS_KB = 32 * 208, AS_VB = 32 * 192, AS_WB = AS_KB + AS_VB;
__device__ __forceinline__ void attn_sample_unit(const P& p, int wv, LAS unsigned char* lds, int b, int h) {
    const int tid_l = wv * 64 + lane_id(); const int tid = tid_l, lane = tid & 63, w = tid >> 6, q = lane & 31, hi = lane >> 5;
    const bf16_t* Qb = (const bf16_t*)(p.ws + WS_Q); const bf16_t* CA = (const bf16_t*)(p.ws + WS_CALL); const bf16_t* WKV = (const bf16_t*)(p.ws + WS_WKV);
    const bf16_t* KR = (const bf16_t*)(p.ws + WS_KRALL); bf16_t* ATT = (bf16_t*)(p.ws + WS_ATT);
    for (int e = tid; e < 128 * 16; e += 512) { const int j = e >> 4, ch = e & 15, d = j & 63, slot = (j < 64) ? h : 8 + h;
        const int prow = 256 * (slot >> 2) + 128 * (d >> 5) + 32 * (slot & 3) + (d & 31);
        *(LAS u32x4*)(lds + j * 272 + ch * 16) = *(const u32x4*)(WKV + (size_t)prow * 128 + 8 * ch); }
    const size_t row1 = (size_t)MP + b * DSQ + q;
    bf16x8 qf[6];
    load_q(qf, Qb + row1 * 768 + h * 96, (float)(PAST + q), p.g_qn, p.g_qr, p.g_kn, hi);
    float m = 0.f, l = 0.f; f32x16 O[2];
#pragma unroll
    for (int r = 0; r < 16; ++r) { O[0][r] = 0.f; O[1][r] = 0.f; }
    LAS unsigned char* Kc = lds + AS_WIMG + w * AS_WB; LAS unsigned char* VT = Kc + AS_KB;
    const size_t rowk_b = (size_t)MKP + (size_t)b * KSAMP;
    __syncthreads();
    bf16x8 cf[8]; u32x4 rr2[2];
#define AS_LOAD(JT) do { const size_t rk_ = rowk_b + 32 * (size_t)(JT); \
        _Pragma("unroll") for (int i = 0; i < 8; ++i) cf[i] = *(const bf16x8*)(CA + (rk_ + q) * 128 + 16 * i + 8 * hi); \
        _Pragma("unroll") for (int n = 0; n < 2; ++n) { const int key = (lane >> 2) + 16 * n, part = lane & 3; rr2[n] = *(const u32x4*)(KR + (rk_ + key) * 32 + 8 * part); } } while (0)
    AS_LOAD(w);
    for (int jt = w; jt < 129; jt += 8) {
#pragma unroll
        for (int n = 0; n < 2; ++n) { const int key = (lane >> 2) + 16 * n, part = lane & 3; *(LAS u32x4*)(Kc + key * 208 + 128 + part * 16) = rr2[n]; }
        {
            f32x16 k0, k1;
#pragma unroll
            for (int r = 0; r < 16; ++r) { k0[r] = 0.f; k1[r] = 0.f; }
#pragma unroll
            for (int i = 0; i < 8; ++i) {
                const bf16x8 w0 = *(const LAS bf16x8*)(lds + q * 272 + (16 * i + 8 * hi) * 2), w1 = *(const LAS bf16x8*)(lds + (32 + q) * 272 + (16 * i + 8 * hi) * 2);
                k0 = __builtin_amdgcn_mfma_f32_32x32x16_bf16(w0, cf[i], k0, 0, 0, 0); k1 = __builtin_amdgcn_mfma_f32_32x32x16_bf16(w1, cf[i], k1, 0, 0, 0); }
            float ss = 0.f;
#pragma unroll
            for (int r = 0; r < 16; ++r) ss += k0[r] * k0[r] + k1[r] * k1[r];
            const float rs = rsqrtf(xhalf_sum(ss) * (1.0f / 64.0f) + EPS);
#pragma unroll
            for (int rg = 0; rg < 4; ++rg) {
                u32x2 a; a.x = pk2c(k0[4 * rg] * rs, k0[4 * rg + 1] * rs); a.y = pk2c(k0[4 * rg + 2] * rs, k0[4 * rg + 3] * rs);
                *(LAS u32x2*)(Kc + q * 208 + (8 * rg + 4 * hi) * 2) = a;
                u32x2 c; c.x = pk2c(k1[4 * rg] * rs, k1[4 * rg + 1] * rs); c.y = pk2c(k1[4 * rg + 2] * rs, k1[4 * rg + 3] * rs);
                *(LAS u32x2*)(Kc + q * 208 + (32 + 8 * rg + 4 * hi) * 2) = c; }
        }
        {
            f32x16 v0, v1;
#pragma unroll
            for (int r = 0; r < 16; ++r) { v0[r] = 0.f; v1[r] = 0.f; }
#pragma unroll
            for (int i = 0; i < 8; ++i) {
                const bf16x8 w0 = *(const LAS bf16x8*)(lds + (64 + q) * 272 + (16 * i + 8 * hi) * 2), w1 = *(const LAS bf16x8*)(lds + (96 + q) * 272 + (16 * i + 8 * hi) * 2);
                v0 = __builtin_amdgcn_mfma_f32_32x32x16_bf16(w0, cf[i], v0, 0, 0, 0); v1 = __builtin_amdgcn_mfma_f32_32x32x16_bf16(w1, cf[i], v1, 0, 0, 0); }
#pragma unroll
            for (int rg = 0; rg < 4; ++rg) {
                u32x2 a; a.x = pk2c(v0[4 * rg], v0[4 * rg + 1]); a.y = pk2c(v0[4 * rg + 2], v0[4 * rg + 3]);
                *(LAS u32x2*)(VT + q * 192 + (8 * rg + 4 * hi) * 2) = a;
                u32x2 c; c.x = pk2c(v1[4 * rg], v1[4 * rg + 1]); c.y = pk2c(v1[4 * rg + 2], v1[4 * rg + 3]);
                *(LAS u32x2*)(VT + q * 192 + (32 + 8 * rg + 4 * hi) * 2) = c; }
        }
        if (jt + 8 < 129) AS_LOAD(jt + 8);
        asm volatile("" ::: "memory"); __builtin_amdgcn_wave_barrier();
        att_blk(Kc, VT, qf, m, l, O, lane, 0);
        asm volatile("" ::: "memory"); __builtin_amdgcn_wave_barrier();
    }
#undef AS_LOAD
    __syncthreads();
    LAS float* Ox = (LAS float*)lds;
    LAS float* Mx = (LAS float*)(lds + 65536);
    LAS float* Lx = Mx + 256;
#pragma unroll
    for (int db = 0; db < 2; ++db)
#pragma unroll
        for (int r = 0; r < 16; ++r) Ox[(w * 64 + 32 * db + crow(r, hi)) * 32 + q] = O[db][r];
    { const float lt = xhalf_sum(l); if (hi == 0) { Mx[w * 32 + q] = m; Lx[w * 32 + q] = lt; } }
    __syncthreads();
    {
        const int qq = tid & 31, dg = tid >> 5;
        float M = -3e30f;
#pragma unroll
        for (int ww = 0; ww < 8; ++ww) M = fmaxf(M, Mx[ww * 32 + qq]);
        float L = 0.f, o[4] = {0.f, 0.f, 0.f, 0.f};
#pragma unroll
        for (int ww = 0; ww < 8; ++ww) { const float sc = __builtin_amdgcn_exp2f(Mx[ww * 32 + qq] - M); L += Lx[ww * 32 + qq] * sc;
#pragma unroll
            for (int e = 0; e < 4; ++e) o[e] += Ox[(ww * 64 + 4 * dg + e) * 32 + qq] * sc; }
        const float il = 1.0f / L;
        u32x2 wv; wv.x = pk2(o[0] * il, o[1] * il); wv.y = pk2(o[2] * il, o[3] * il);
        *(u32x2*)(ATT + ((size_t)M2P + b * DSQ + qq) * 512 + h * 64 + 4 * dg) = wv;
    }
    __syncthreads();
}
__device__ __forceinline__ void phase_attn(const P& p, int wv, LAS unsigned char* lds) {
    for (int u = blockIdx.x; u < 256; u += gridDim.x) attn_prompt_unit(p, wv, lds, u >> 3, u & 7);
    for (int u = blockIdx.x; u < 256; u += gridDim.x) attn_sample_unit(p, wv, lds, u >> 3, u & 7);
}

__device__ __forceinline__ void phase_e2(const P& p, int wv) {
    const int tid_l = wv * 64 + lane_id(); const int lane = tid_l & 63, wave = tid_l >> 6;
    const bf16_t* ATT = (const bf16_t*)(p.ws + WS_ATT); bf16_t* MIX = (bf16_t*)(p.ws + WS_MIX);
    const f32x4 g0 = *(const f32x4*)(p.g_ao + 8 * lane), g1 = *(const f32x4*)(p.g_ao + 8 * lane + 4);
    const int stride = gridDim.x * 8;
    for (int row0 = blockIdx.x * 8 + wave; row0 < M2; row0 += 4 * stride) {
        u32x4 raw[4];
#pragma unroll
        for (int u = 0; u < 4; ++u) { const int row = row0 + u * stride; raw[u] = *(const u32x4*)(ATT + (size_t)(row < M2 ? row : row0) * 512 + 8 * lane); }
#pragma unroll
        for (int u = 0; u < 4; ++u) { const int row = row0 + u * stride;
            const f32x4 a = {bflo(raw[u].x), bfhi(raw[u].x), bflo(raw[u].y), bfhi(raw[u].y)}, c = {bflo(raw[u].z), bfhi(raw[u].z), bflo(raw[u].w), bfhi(raw[u].w)};
            const float ss = (a[0] * a[0] + a[1] * a[1]) + (a[2] * a[2] + a[3] * a[3]) + (c[0] * c[0] + c[1] * c[1]) + (c[2] * c[2] + c[3] * c[3]);
            const float rs = rsqrtf(wave_sum(ss) * (1.0f / 512.0f) + EPS);
            const f32x4 o0 = a * g0 * rs, o1 = c * g1 * rs;
            u32x4 w; w.x = pk2(o0[0], o0[1]); w.y = pk2(o0[2], o0[3]); w.z = pk2(o1[0], o1[1]); w.w = pk2(o1[2], o1[3]);
            if (row < M2) *(u32x4*)(MIX + (size_t)row * 1024 + 8 * lane) = w; }
    }
}
__device__ __forceinline__ void phase_e3(const P& p, int wv) {
    const int tid_l = wv * 64 + lane_id(); const int lane = tid_l & 63, wave = tid_l >> 6;
    const bf16_t* H = (const bf16_t*)(p.ws + WS_H); bf16_t* U = (bf16_t*)(p.ws + WS_U);
    f32x4 g[4];
#pragma unroll
    for (int j = 0; j < 4; ++j) g[j] = *(const f32x4*)(p.g_ffn + 4 * lane + 256 * j);
    const int stride = gridDim.x * 8;
    for (int row = blockIdx.x * 8 + wave; row < M2P; row += 2 * stride) {
        const int rowb = row + stride; const bool hb = rowb < M2P; const int rb = hb ? rowb : row;
        f32x4 va[4], vb[4]; float ssa = 0.f, ssb = 0.f;
#pragma unroll
        for (int j = 0; j < 4; ++j) { const u32x2 ra_ = *(const u32x2*)(H + (size_t)row * 1024 + 4 * lane + 256 * j), rb_ = *(const u32x2*)(H + (size_t)rb * 1024 + 4 * lane + 256 * j);
            va[j] = (f32x4){bflo(ra_.x), bfhi(ra_.x), bflo(ra_.y), bfhi(ra_.y)}; vb[j] = (f32x4){bflo(rb_.x), bfhi(rb_.x), bflo(rb_.y), bfhi(rb_.y)}; }
#pragma unroll
        for (int j = 0; j < 4; ++j) { ssa += (va[j][0] * va[j][0] + va[j][1] * va[j][1]) + (va[j][2] * va[j][2] + va[j][3] * va[j][3]);
                                      ssb += (vb[j][0] * vb[j][0] + vb[j][1] * vb[j][1]) + (vb[j][2] * vb[j][2] + vb[j][3] * vb[j][3]); }
        const float rsa = rsqrtf(wave_sum(ssa) * (1.0f / 1024.0f) + EPS), rsb = rsqrtf(wave_sum(ssb) * (1.0f / 1024.0f) + EPS);
#pragma unroll
        for (int j = 0; j < 4; ++j) { const f32x4 o = va[j] * g[j] * rsa; u32x2 w; w.x = pk2(o[0], o[1]); w.y = pk2(o[2], o[3]);
            *(u32x2*)(U + (size_t)row * 1024 + 4 * lane + 256 * j) = w; }
        if (hb) {
#pragma unroll
            for (int j = 0; j < 4; ++j) { const f32x4 o = vb[j] * g[j] * rsb; u32x2 w; w.x = pk2(o[0], o[1]); w.y = pk2(o[2], o[3]);
                *(u32x2*)(U + (size_t)rowb * 1024 + 4 * lane + 256 * j) = w; } }
    }
    { const float* PB = (const float*)(p.ws + WS_PB5); float* Hw = (float*)(p.ws + WS_HS);
      for (int r = blockIdx.x * 8 + wave; r < MS; r += stride) {
          f32x4 v[4]; float ss = 0.f;
#pragma unroll
          for (int j = 0; j < 4; ++j) { const size_t o = (size_t)r * 1024 + 4 * lane + 256 * j;
              v[j] = (*(const f32x4*)(PB + o) + *(const f32x4*)(PB + 1048576 + o)) + (*(const f32x4*)(PB + 2 * 1048576 + o) + *(const f32x4*)(PB + 3 * 1048576 + o)) + *(const f32x4*)(p.xs + o);
              *(f32x4*)(Hw + (size_t)r * 1024 + 4 * lane + 256 * j) = v[j];
              ss += (v[j][0] * v[j][0] + v[j][1] * v[j][1]) + (v[j][2] * v[j][2] + v[j][3] * v[j][3]); }
          const float rs = rsqrtf(wave_sum(ss) * (1.0f / 1024.0f) + EPS);
#pragma unroll
          for (int j = 0; j < 4; ++j) { const f32x4 o = v[j] * g[j] * rs; u32x2 w; w.x = pk2(o[0], o[1]); w.y = pk2(o[2], o[3]);
              *(u32x2*)(U + (size_t)(M2P + r) * 1024 + 4 * lane + 256 * j) = w; }
      } }
}

#define XB_TMO      128
#define XB_XCNT(j)  (256  + 64 * (j))
#define XB_XSUB(j)  (1280 + 64 * (j))
#define XB_XGEN(j)  (2304 + 64 * (j))
#define XB_TOP      3328
#define XB_TOPGEN   3392
#define XCD_BAR_WORDS 3456
#define XB_SPIN_CAP (1u << 18)

__device__ __forceinline__ unsigned xb_ld(unsigned* p)              { return __hip_atomic_load(p, __ATOMIC_RELAXED, __HIP_MEMORY_SCOPE_AGENT); }
__device__ __forceinline__ unsigned xb_add(unsigned* p, unsigned v) { return __hip_atomic_fetch_add(p, v, __ATOMIC_RELAXED, __HIP_MEMORY_SCOPE_AGENT); }
__device__ __forceinline__ unsigned xb_xcc_id() { return (unsigned)__builtin_amdgcn_s_getreg((3 << 11) | 20) & 0xFu; }
#define XB_SPIN(cond, bar) do { unsigned _sp = 0; while (cond) { __builtin_amdgcn_s_sleep(1); \
    if ((++_sp & 255u) == 0u) { if (xb_ld(&(bar)[XB_TMO])) break; if (_sp > XB_SPIN_CAP) { atomicAdd(&(bar)[XB_TMO], 1u); break; } } } } while (0)

struct XcdBarrier {
    int wv;
    unsigned* bar; unsigned x;
    volatile LAS unsigned* st;
};

__device__ __forceinline__ XcdBarrier xcd_barrier_post(unsigned* bar, volatile LAS unsigned* st) {
    XcdBarrier b; b.wv = 0; b.bar = bar; b.x = xb_xcc_id(); b.st = st;
    if (threadIdx.x == 0) (void)xb_add(&bar[XB_XCNT(b.x)], 1u);
    return b;
}
__device__ __forceinline__ void xcd_barrier_complete(unsigned* bar, unsigned x, unsigned& nloc, unsigned& nx) {
    const unsigned G = gridDim.x * gridDim.y * gridDim.z;
    unsigned sum, cnt, mine, sp = 0u;
    for (;;) {
        sum = 0u; cnt = 0u; mine = 0u;
#pragma unroll
        for (unsigned j = 0; j < 16; ++j) { const unsigned c = xb_ld(&bar[XB_XCNT(j)]); sum += c; cnt += (c > 0u) ? 1u : 0u; mine = (j == x) ? c : mine; }
        if (sum == G) break;
        __builtin_amdgcn_s_sleep(1);
        if ((++sp & 255u) == 0u) { if (xb_ld(&bar[XB_TMO])) break; if (sp > XB_SPIN_CAP) { atomicAdd(&bar[XB_TMO], 1u); break; } }
    }
    nloc = mine > 0u ? mine : 1u; nx = cnt > 0u ? cnt : 1u;
}

__device__ __forceinline__ void xcd_barrier(const XcdBarrier& b) {
    asm volatile("s_waitcnt vmcnt(0)" ::: "memory");
    __syncthreads();
    if (b.wv == 0 && lane_id() == 0) {
        unsigned* bar = b.bar;
        __builtin_amdgcn_s_waitcnt(0);
        unsigned nloc = b.st[0], nx = b.st[1];
        if (nloc == 0u) { xcd_barrier_complete(bar, b.x, nloc, nx); b.st[0] = nloc; b.st[1] = nx; }
        const unsigned old = xb_add(&bar[XB_XSUB(b.x)], 1u);
        const unsigned gen = old / nloc;
        if (old + 1u == (gen + 1u) * nloc) {
            __builtin_amdgcn_fence(__ATOMIC_RELEASE, "agent");
            asm volatile("s_waitcnt vmcnt(0)" ::: "memory");
            const unsigned og = xb_add(&bar[XB_TOP], 1u);
            const unsigned tg = og / nx;
            if (og + 1u == (tg + 1u) * nx) xb_add(&bar[XB_TOPGEN], 1u);
            else XB_SPIN(xb_ld(&bar[XB_TOPGEN]) == tg, bar);
            __builtin_amdgcn_fence(__ATOMIC_ACQUIRE, "agent");
            xb_add(&bar[XB_XGEN(b.x)], 1u);
            asm volatile("s_waitcnt vmcnt(0)" ::: "memory");
        } else {
            XB_SPIN(xb_ld(&bar[XB_XGEN(b.x)]) == gen, bar);
            __builtin_amdgcn_fence(__ATOMIC_ACQUIRE, "agent");
            asm volatile("s_waitcnt vmcnt(0)" ::: "memory");
        }
    }
    __syncthreads();
}

template <class Epi> __device__ __forceinline__ void run_gemm(int wv, LAS unsigned char* lds, const bf16_t* A, const bf16_t* Bt, int M, int N, int K, const Epi& E) {
    pg8::Gemm g{A, Bt, M, N, K, K, wv}; pg8::StaticOrder S; S.init(M, N, (int)gridDim.x, (int)blockIdx.x);
    pg8::gemm_phase<Epi, pg8::StaticOrder, true, true>(lds, g, S, E);
}

#ifndef PH_MASK
#define PH_MASK 0xFFFF
#endif
#ifndef PH_TWICE
#define PH_TWICE 0
#ifndef EXTRA_SYNCS
#define EXTRA_SYNCS 0
#endif
#endif
__device__ __forceinline__ void run_gemm_split(int wv, LAS unsigned char* lds, const bf16_t* A, const bf16_t* Bt, int N, int K, int Kc, int pm0, int npm, const pg8::EpiPartial& E) {
    pg8::Gemm g{A, Bt, 0, N, K, Kc, wv}; pg8::SplitOrder S{pm0, npm, N / 256, K / Kc, (int)gridDim.x, (int)blockIdx.x};
    pg8::gemm_phase<pg8::EpiPartial, pg8::SplitOrder, true, true, true>(lds, g, S, E);
}
__global__ void __launch_bounds__(512, 2) hymba_fwd(P p) {
    extern __shared__ __attribute__((aligned(16))) unsigned char lds_raw[];
    LAS unsigned char* lds = (LAS unsigned char*)lds_raw;
    cg::grid_group grid = cg::this_grid();
    unsigned char* ws = p.ws;
    volatile LAS unsigned* bst = (volatile LAS unsigned*)(lds + LDS_BYTES - 64);
    if (threadIdx.x < 16) bst[threadIdx.x] = 0u;
    __syncthreads();
    XcdBarrier xbar = xcd_barrier_post((unsigned*)(ws + WS_CTL), bst);
    const int wv = __builtin_amdgcn_readfirstlane((int)(threadIdx.x >> 6)); xbar.wv = wv;
#define GBAR() xcd_barrier(xbar)
    if (PH_MASK & 1) phase_e0(p, wv, lds);
    if (PH_TWICE & 1) { __syncthreads(); phase_e0(p, wv, lds); }
    if (p.ws == nullptr) grid.sync();
    GBAR();
    if (PH_MASK & 2) { pg8::EpiStore E{(bf16_t*)(ws + WS_PROJ), NPROJ}; run_gemm(wv, lds, (const bf16_t*)(ws + WS_XN), (const bf16_t*)(ws + WS_WIN), M1, NPROJ, 1024, E); }
    if (PH_TWICE & 2) { pg8::EpiStore E{(bf16_t*)(ws + WS_PROJ), NPROJ}; run_gemm(wv, lds, (const bf16_t*)(ws + WS_XN), (const bf16_t*)(ws + WS_WIN), M1, NPROJ, 1024, E); }
    GBAR();
    for (int es = 0; es < EXTRA_SYNCS; ++es) GBAR();
    if (PH_MASK & 4) phase_e1(p, wv);
    if (PH_TWICE & 4) phase_e1(p, wv);
    GBAR();
    if (PH_MASK & 16) { pg8::EpiStore E{(bf16_t*)(ws + WS_E), 1536}; run_gemm(wv, lds, (const bf16_t*)(ws + WS_LIN), (const bf16_t*)(ws + WS_WL), M1, 1536, 256, E); }
    if (PH_TWICE & 16) { pg8::EpiStore E{(bf16_t*)(ws + WS_E), 1536}; run_gemm(wv, lds, (const bf16_t*)(ws + WS_LIN), (const bf16_t*)(ws + WS_WL), M1, 1536, 256, E); }
    GBAR();
    if (PH_MASK & 32) phase_scan(p, wv, lds);
    if (PH_TWICE & 32) phase_scan(p, wv, lds);
    GBAR();
    if (PH_MASK & 8) { pg8::EpiStore E{(bf16_t*)(ws + WS_Q), 768}; run_gemm(wv, lds, (const bf16_t*)(ws + WS_QL), (const bf16_t*)(ws + WS_WQ), M1, 768, 256, E); }
    if (PH_TWICE & 8) { pg8::EpiStore E{(bf16_t*)(ws + WS_Q), 768}; run_gemm(wv, lds, (const bf16_t*)(ws + WS_QL), (const bf16_t*)(ws + WS_WQ), M1, 768, 256, E); }
    if (PH_MASK & 64) { pg8::EpiKV E{(bf16_t*)(ws + WS_KN), (bf16_t*)(ws + WS_V), p.g_kn}; run_gemm(wv, lds, (const bf16_t*)(ws + WS_CALL), (const bf16_t*)(ws + WS_WKV), MKP, 1024, 128, E); }
    if (PH_TWICE & 64) { pg8::EpiKV E{(bf16_t*)(ws + WS_KN), (bf16_t*)(ws + WS_V), p.g_kn}; run_gemm(wv, lds, (const bf16_t*)(ws + WS_CALL), (const bf16_t*)(ws + WS_WKV), MKP, 1024, 128, E); }
    GBAR();
    if (PH_MASK & 128) phase_attn(p, wv, lds);
    if (PH_TWICE & 128) phase_attn(p, wv, lds);
    GBAR();
    if (PH_MASK & 256) phase_e2(p, wv);
    if (PH_TWICE & 256) phase_e2(p, wv);
    GBAR();
    if (PH_MASK & 512) { pg8::EpiResToB16 E{(bf16_t*)(ws + WS_H), p.xp}; run_gemm(wv, lds, (const bf16_t*)(ws + WS_MIX), (const bf16_t*)(ws + WS_WOUT), M2P, 1024, 1024, E);
        pg8::EpiPartial E2{(float*)(ws + WS_PB5), M2P}; run_gemm_split(wv, lds, (const bf16_t*)(ws + WS_MIX), (const bf16_t*)(ws + WS_WOUT), 1024, 1024, 256, M2P / 256, MS / 256, E2); }
    GBAR();
    if (PH_MASK & 1024) phase_e3(p, wv);
    if (PH_TWICE & 1024) phase_e3(p, wv);
    GBAR();
    if (PH_MASK & 2048) { pg8::EpiSwiglu E{(bf16_t*)(ws + WS_ACT)}; run_gemm(wv, lds, (const bf16_t*)(ws + WS_U), (const bf16_t*)(ws + WS_WGU), M2, 2 * DFF, 1024, E); }
    if (PH_TWICE & 2048) { pg8::EpiSwiglu E{(bf16_t*)(ws + WS_ACT)}; run_gemm(wv, lds, (const bf16_t*)(ws + WS_U), (const bf16_t*)(ws + WS_WGU), M2, 2 * DFF, 1024, E); }
    GBAR();
    if (PH_MASK & 4096) { pg8::EpiOutFromB16 E{p.out, (const bf16_t*)(ws + WS_H)}; run_gemm(wv, lds, (const bf16_t*)(ws + WS_ACT), (const bf16_t*)(ws + WS_WDN), M2P, 1024, DFF, E);
        pg8::EpiPartial E2{(float*)(ws + WS_PB7), M2P}; run_gemm_split(wv, lds, (const bf16_t*)(ws + WS_ACT), (const bf16_t*)(ws + WS_WDN), 1024, DFF, 256, M2P / 256, MS / 256, E2); }
    GBAR();
    {
        const float* PB = (const float*)(ws + WS_PB7); float* ys = p.out + OFF_YS;
        const int tid_l = wv * 64 + lane_id();
        for (size_t e = (size_t)blockIdx.x * 512 + tid_l; e < (size_t)MS * 1024 / 4; e += (size_t)gridDim.x * 512) {
            f32x4 a = *(const f32x4*)(PB + 4 * e) + *(const f32x4*)((const float*)(ws + WS_HS) + 4 * e);
#pragma unroll
            for (int kc = 1; kc < 11; ++kc) a += *(const f32x4*)(PB + (size_t)kc * 1048576 + 4 * e);
            *(f32x4*)(ys + 4 * e) = a; }
    }
}

extern "C" void kernel_launch(void* const* d_in, const int* in_sizes, int n_in, void* d_out, int out_size, void* d_ws, size_t ws_size, hipStream_t stream) {
    static int grid_blocks = 0;
    if (grid_blocks == 0) {
        if (n_in != 34 || ws_size < WS_NEED) { fprintf(stderr, "kernel_launch: unexpected n_in %d / ws_size %zu\n", n_in, ws_size); grid_blocks = -1; return; }
        int dev = 0, cus = 0, per_cu = 0;
        hipGetDevice(&dev);
        hipDeviceGetAttribute(&cus, hipDeviceAttributeMultiprocessorCount, dev);
        if (hipFuncSetAttribute((const void*)hymba_fwd, hipFuncAttributeMaxDynamicSharedMemorySize, LDS_BYTES) != hipSuccess) { fprintf(stderr, "kernel_launch: hipFuncSetAttribute failed\n"); }
        if (hipOccupancyMaxActiveBlocksPerMultiprocessor(&per_cu, (const void*)hymba_fwd, 512, LDS_BYTES) != hipSuccess || per_cu < 1) per_cu = 1;
        (void)hipGetLastError();
        if (per_cu > 1) per_cu = 1;
        grid_blocks = cus * per_cu;
    }
    if (grid_blocks < 0) return;
    P p{};
    const float** f = (const float**)&p;
    for (int i = 0; i < 34; ++i) f[i] = (const float*)d_in[i];
    p.out = (float*)d_out; p.ws = (unsigned char*)d_ws;
    (void)hipMemsetAsync((char*)d_ws + WS_CTL, 0, 16384, stream);
    void* args[] = {&p};
    hipError_t e = hipLaunchCooperativeKernel((const void*)hymba_fwd, dim3(grid_blocks), dim3(512), args, LDS_BYTES, stream);
    if (e != hipSuccess) fprintf(stderr, "cooperative launch failed: %s (grid %d)\n", hipGetErrorString(e), grid_blocks);
}
```

```cpp
#include <hip/hip_runtime.h>
#include <hip/hip_cooperative_groups.h>
#include <cstdio>
#include <cstdint>
namespace cg = cooperative_groups;

namespace pg8 {
#define PG8_LAS __attribute__((address_space(3)))
typedef unsigned short bf16_t;
typedef short bf16x8 __attribute__((ext_vector_type(8)));
typedef float f32x4 __attribute__((ext_vector_type(4)));
typedef unsigned u32x4 __attribute__((ext_vector_type(4)));
constexpr int BM = 256, BK = 64, HALF = 128, HTB = HALF * BK * 2  , STAGE_BYTES = 8 * HTB, NXCD = 8, WGM = 8;

__host__ __device__ __forceinline__ int lds_byte(int r, int c) { const int st = (r >> 4) * 2 + (c >> 5), rr = r & 15, cc = c & 31, ob = rr * 64 + cc * 2; return st * 1024 + (ob ^ (((ob >> 9) & 1) << 5)); }
__host__ __device__ __forceinline__ void stage_rc(int b, int& R, int& C) { const int st = b / 1024, sb = b % 1024, swz = sb ^ (((sb >> 9) & 1) << 5); R = (st >> 1) * 16 + swz / 64; C = (st & 1) * 32 + (swz % 64) / 2; }
__host__ __device__ __forceinline__ int perm32(int rho) { const int n = rho >> 4, i = rho & 15; return 8 * (i >> 2) + 4 * n + (i & 3); }

struct Unit { int pm, pn, kc; };
struct Gemm { const bf16_t* A; const bf16_t* Bt; int M, N, K, Kc, wv; };

struct StaticOrder {
    int nM, nN, nwg, G, c;
    __host__ __device__ void init(int M, int N, int G_, int c_) { nM = M / BM; nN = N / BM; nwg = nM * nN; G = G_; c = c_; }
    __host__ __device__ bool next(int i, Unit& u) const {
        const long L = (long)i * G + c; if (L >= nwg) return false;
        int wgid = (int)L; { const int q = nwg / NXCD, r = nwg % NXCD, xcd = wgid % NXCD, off = wgid / NXCD; wgid = (xcd < r ? xcd * (q + 1) : r * (q + 1) + (xcd - r) * q) + off; }
        const int nig = WGM * nN, gid = wgid / nig, fm = gid * WGM, gsz = (nM - fm) < WGM ? (nM - fm) : WGM;
        u.pm = fm + ((wgid % nig) % gsz); u.pn = (wgid % nig) / gsz; u.kc = 0; return true;
    }
    __device__ __forceinline__ void a_ready(const Unit&) const {}
    __device__ __forceinline__ void done(const Unit&) const {}
};

__device__ __forceinline__ unsigned cvt_pk_bf16(float lo, float hi) { unsigned r; asm volatile("v_cvt_pk_bf16_f32 %0, %1, %2" : "=v"(r) : "v"(lo), "v"(hi)); return r; }
template <class Epi, class Sched, bool ALIGN_EPI = false, bool SP2 = false, bool SPLITK = false>
__device__ __forceinline__ void gemm_phase(PG8_LAS unsigned char* lds, const Gemm g, const Sched& S, const Epi& E) {
    int tid_l; asm volatile("v_mbcnt_lo_u32_b32 %0, -1, 0\n\tv_mbcnt_hi_u32_b32 %0, -1, %0" : "=v"(tid_l)); const int tid = g.wv * 64 + tid_l, wid = __builtin_amdgcn_readfirstlane(tid >> 6), lane = tid & 63, wr = wid >> 2, wc = wid & 3, fr = lane & 15, fq = lane >> 4;
    const int K = g.K, nt = (SPLITK ? g.Kc : g.K) / BK; const size_t kcb = SPLITK ? (size_t)g.Kc * 2 : 0;
    unsigned voffA[2], voffB[2];
#pragma unroll
    for (int i = 0; i < 2; ++i) { int R, C; stage_rc(tid * 16 + i * 8192, R, C); const int Rb = Epi::PERM ? ((R & ~31) + perm32(R & 31)) : R;
        voffA[i] = (unsigned)(R * K + C) * 2u; voffB[i] = (unsigned)(Rb * K + C) * 2u; }
    const size_t kstep = (size_t)(BK * 2);
    const size_t hstep = (size_t)HALF * K * 2;
    const size_t tstep = 2 * hstep;
    const unsigned ldsw = (unsigned)wid * 1024u;
    const int aoff = lds_byte(wr * 64 + fr, fq * 8), boff = lds_byte(wc * 32 + fr, fq * 8);
#define PG8_SA(b, h) (((b) * 2 + (h)) * HTB)
#define PG8_SB(b, h) ((4 + (b) * 2 + (h)) * HTB)
#define PG8_STAGE(bufoff, gbase, voff) do { _Pragma("unroll") for (int _i = 0; _i < 2; ++_i) \
        __builtin_amdgcn_global_load_lds((const unsigned*)((const char*)(gbase) + (voff)[_i]), (PG8_LAS unsigned*)(lds + (bufoff) + ldsw + _i * 8192), 16, 0, 0); } while (0)
#define PG8_LDA(dst, b, h) do { _Pragma("unroll") for (int m = 0; m < 4; ++m) _Pragma("unroll") for (int k = 0; k < 2; ++k) dst[m][k] = *(const PG8_LAS bf16x8*)(lds + PG8_SA(b, h) + aoff + m * 2048 + k * 1024); } while (0)
#define PG8_LDB(dst, b, h) do { _Pragma("unroll") for (int n = 0; n < 2; ++n) _Pragma("unroll") for (int k = 0; k < 2; ++k) dst[n][k] = *(const PG8_LAS bf16x8*)(lds + PG8_SB(b, h) + boff + n * 2048 + k * 1024); } while (0)
#define PG8_MMA(ai, bj, At, Bt) do { __builtin_amdgcn_s_setprio(1); _Pragma("unroll") for (int m = 0; m < 4; ++m) _Pragma("unroll") for (int n = 0; n < 2; ++n) _Pragma("unroll") for (int k = 0; k < 2; ++k) \
        acc[ai][bj][m][n] = __builtin_amdgcn_mfma_f32_16x16x32_bf16(Bt[n][k], At[m][k], acc[ai][bj][m][n], 0, 0, 0); __builtin_amdgcn_s_setprio(0); } while (0)
#define PG8_WAIT_V(n) asm volatile("s_waitcnt vmcnt(" #n ")" ::: "memory")
#define PG8_WAIT_L(n) asm volatile("s_waitcnt lgkmcnt(" #n ")" ::: "memory")
#define PG8_BAR __builtin_amdgcn_s_barrier()
#define PG8_SCHED __builtin_amdgcn_sched_barrier(0)
    Unit cur, nxt; int ui = 0;
    if (!S.next(0, cur)) return;
    f32x4 acc[2][2][4][2];
#pragma unroll
    for (int a = 0; a < 2; ++a)
#pragma unroll
        for (int b = 0; b < 2; ++b)
#pragma unroll
            for (int m = 0; m < 4; ++m)
#pragma unroll
                for (int n = 0; n < 2; ++n) acc[a][b][m][n] = (f32x4){0.f, 0.f, 0.f, 0.f};
    bf16x8 At[4][2], B0[2][2], B1[2][2];
    const char* cA = (const char*)g.A + (size_t)cur.pm * tstep + (SPLITK ? (size_t)cur.kc * kcb : 0); const char* cB = (const char*)g.Bt + (size_t)cur.pn * tstep + (SPLITK ? (size_t)cur.kc * kcb : 0);
    S.a_ready(cur);
    if constexpr (SP2) {
        PG8_STAGE(PG8_SB(0, 0), cB, voffB); PG8_STAGE(PG8_SB(0, 1), cB + hstep, voffB); PG8_STAGE(PG8_SA(0, 0), cA, voffA); PG8_STAGE(PG8_SA(0, 1), cA + hstep, voffA);
        if (wr == 1) PG8_BAR;
        PG8_WAIT_V(2); PG8_BAR;
        PG8_STAGE(PG8_SB(1, 0), cB + kstep, voffB); PG8_STAGE(PG8_SA(1, 0), cA + kstep, voffA); PG8_STAGE(PG8_SB(1, 1), cB + hstep + kstep, voffB);
        PG8_WAIT_V(6); PG8_BAR;
    } else {
        PG8_STAGE(PG8_SB(0, 0), cB, voffB); PG8_STAGE(PG8_SA(0, 0), cA, voffA); PG8_STAGE(PG8_SB(0, 1), cB + hstep, voffB); PG8_STAGE(PG8_SA(0, 1), cA + hstep, voffA);
        if (wr == 1) PG8_BAR;
        PG8_WAIT_V(4); PG8_BAR;
        PG8_STAGE(PG8_SB(1, 0), cB + kstep, voffB); PG8_STAGE(PG8_SA(1, 0), cA + kstep, voffA); PG8_STAGE(PG8_SB(1, 1), cB + hstep + kstep, voffB);
        PG8_WAIT_V(6); PG8_BAR;
    }
    for (;;) {
        const bool has_next = S.next(ui + 1, nxt);
        const char* nA = has_next ? (const char*)g.A + (size_t)nxt.pm * tstep + (SPLITK ? (size_t)nxt.kc * kcb : 0) : cA; const char* nB = has_next ? (const char*)g.Bt + (size_t)nxt.pn * tstep + (SPLITK ? (size_t)nxt.kc * kcb : 0) : cB;
#pragma unroll 1
        for (int t = 0; t < nt; t += 2) {
            const bool last = (t == nt - 2);
            const char* a1 = cA + (size_t)(t + 1) * kstep;
            const char* a2 = last ? nA : cA + (size_t)(t + 2) * kstep; const char* b2 = last ? nB : cB + (size_t)(t + 2) * kstep;
            const char* a3 = a2 + kstep; const char* b3 = b2 + kstep;
            if (last && has_next) S.a_ready(nxt);
            if constexpr (SP2) {
            PG8_LDB(B0, 0, 0); PG8_LDB(B1, 0, 1); PG8_SCHED; PG8_LDA(At, 0, 0); PG8_STAGE(PG8_SA(1, 1), a1 + hstep, voffA);
            PG8_WAIT_V(8); PG8_WAIT_L(0); PG8_BAR; PG8_MMA(0, 0, At, B0); PG8_MMA(0, 1, At, B1); PG8_BAR; PG8_SCHED;
            PG8_LDA(At, 0, 1); PG8_STAGE(PG8_SB(0, 0), b2, voffB); PG8_STAGE(PG8_SB(0, 1), b2 + hstep, voffB); PG8_STAGE(PG8_SA(0, 0), a2, voffA);
            PG8_WAIT_V(8); PG8_WAIT_L(0); PG8_BAR; PG8_MMA(1, 0, At, B0); PG8_MMA(1, 1, At, B1); PG8_BAR; PG8_SCHED;
            PG8_LDB(B0, 1, 0); PG8_LDB(B1, 1, 1); PG8_SCHED; PG8_LDA(At, 1, 0); PG8_STAGE(PG8_SA(0, 1), a2 + hstep, voffA);
            PG8_WAIT_V(8); PG8_WAIT_L(0); PG8_BAR; PG8_MMA(0, 0, At, B0); PG8_MMA(0, 1, At, B1); PG8_BAR; PG8_SCHED;
            PG8_LDA(At, 1, 1); PG8_STAGE(PG8_SB(1, 0), b3, voffB); PG8_STAGE(PG8_SB(1, 1), b3 + hstep, voffB); PG8_STAGE(PG8_SA(1, 0), a3, voffA);
            PG8_WAIT_V(8); PG8_WAIT_L(0); PG8_BAR; PG8_MMA(1, 0, At, B0); PG8_MMA(1, 1, At, B1); PG8_BAR; PG8_SCHED;
            } else {
            PG8_LDB(B0, 0, 0); PG8_SCHED; PG8_LDA(At, 0, 0); PG8_STAGE(PG8_SA(1, 1), a1 + hstep, voffA);
            PG8_WAIT_L(8); PG8_BAR; PG8_WAIT_L(0); PG8_MMA(0, 0, At, B0); PG8_BAR; PG8_SCHED;
            PG8_LDB(B1, 0, 1); PG8_STAGE(PG8_SB(0, 0), b2, voffB);
            PG8_BAR; PG8_WAIT_L(0); PG8_MMA(0, 1, At, B1); PG8_BAR;
            PG8_LDA(At, 0, 1); PG8_STAGE(PG8_SA(0, 0), a2, voffA);
            PG8_BAR; PG8_WAIT_L(0); PG8_MMA(1, 0, At, B0); PG8_BAR; PG8_SCHED;
            PG8_STAGE(PG8_SB(0, 1), b2 + hstep, voffB);
            PG8_WAIT_V(6); PG8_BAR; PG8_MMA(1, 1, At, B1); PG8_BAR;
            PG8_LDB(B0, 1, 0); PG8_SCHED; PG8_LDA(At, 1, 0); PG8_STAGE(PG8_SA(0, 1), a2 + hstep, voffA);
            PG8_WAIT_L(8); PG8_BAR; PG8_WAIT_L(0); PG8_MMA(0, 0, At, B0); PG8_BAR; PG8_SCHED;
            PG8_LDB(B1, 1, 1); PG8_STAGE(PG8_SB(1, 0), b3, voffB);
            PG8_BAR; PG8_WAIT_L(0); PG8_MMA(0, 1, At, B1); PG8_BAR;
            PG8_LDA(At, 1, 1); PG8_STAGE(PG8_SA(1, 0), a3, voffA);
            PG8_BAR; PG8_WAIT_L(0); PG8_MMA(1, 0, At, B0); PG8_BAR; PG8_SCHED;
            PG8_STAGE(PG8_SB(1, 1), b3 + hstep, voffB);
            PG8_WAIT_V(6); PG8_BAR; PG8_MMA(1, 1, At, B1); PG8_BAR;
            }
        }
        if constexpr (ALIGN_EPI) { if (wr == 0) PG8_BAR; }
        if constexpr (!Epi::AFTER_DRAIN) { E(acc, cur, wr, wc, fr, fq); S.done(cur); }
        if (!has_next) break;
#pragma unroll
        for (int a = 0; a < 2; ++a)
#pragma unroll
            for (int b = 0; b < 2; ++b)
#pragma unroll
                for (int m = 0; m < 4; ++m)
#pragma unroll
                    for (int n = 0; n < 2; ++n) acc[a][b][m][n] = (f32x4){0.f, 0.f, 0.f, 0.f};
        cur = nxt; cA = nA; cB = nB; ++ui;
        if constexpr (ALIGN_EPI) { if (wr == 1) PG8_BAR; }
    }
    PG8_WAIT_V(0);
    if constexpr (!ALIGN_EPI) { if (wr == 0) PG8_BAR; }
    PG8_BAR;
    if constexpr (Epi::AFTER_DRAIN) { E.fused(acc, cur, wr, wc, fr, fq, lds, wid, lane); S.done(cur); }
#undef PG8_SA
#undef PG8_SB
#undef PG8_STAGE
#undef PG8_LDA
#undef PG8_LDB
#undef PG8_MMA
#undef PG8_WAIT_V
#undef PG8_WAIT_L
#undef PG8_BAR
#undef PG8_SCHED
}
}

#define LAS __attribute__((address_space(3)))
typedef unsigned short bf16_t;
typedef float f32x4 __attribute__((ext_vector_type(4)));
typedef float f32x2 __attribute__((ext_vector_type(2)));
typedef float f32x16 __attribute__((ext_vector_type(16)));
typedef unsigned u32x4 __attribute__((ext_vector_type(4)));
typedef unsigned u32x2 __attribute__((ext_vector_type(2)));
typedef short bf16x8 __attribute__((ext_vector_type(8)));

constexpr int DM = 1024, NB = 32, SEQ = 2048, NMETA = 16, LP = 2064, DSQ = 32, PAST = 4096, KSAMP = 4128;
constexpr int MP = NB * LP;
constexpr int MS = NB * DSQ;
constexpr int M1 = MP + MS;
constexpr int M2P = NB * SEQ;
constexpr int M2 = M2P + MS;
constexpr int KPB = 2112;
constexpr int MKP = NB * KPB;
constexpr int MK = MKP + NB * KSAMP;
constexpr int NPROJ = 2304, INCOLS = 2208, RW0 = 416, RWC = 1792, DFF = 2816;
constexpr float EPS = 1e-6f, LNX_EPS = 64e-5f;
constexpr float QSCALE = 0.10206207261596577f * 1.4426950408889634f;

constexpr size_t OFF_YP = 0, OFF_YS = 67108864, OFF_KVP = 68157440, OFF_KRP = 76611584, OFF_WKVP = 78725120, OFF_SHP = 79773696,
                 OFF_KVS = 79831040, OFF_KRS = 79962112, OFF_WKVS = 79994880, OFF_SHS = 81043456;

constexpr size_t MiB = 1u << 20;
constexpr size_t WS_WIN = 0, WS_WQ = 5 * MiB, WS_WKV = 6 * MiB, WS_WL = 7 * MiB, WS_WOUT = 8 * MiB, WS_WGU = 10 * MiB, WS_WDN = 22 * MiB;
constexpr size_t WS_CTL = 28 * MiB;
constexpr size_t WS_XN = 32 * MiB, WS_PROJ = 163 * MiB;
constexpr size_t WS_CALL = 32 * MiB, WS_KRALL = 81 * MiB, WS_QL = 94 * MiB, WS_LIN = 127 * MiB;
constexpr size_t WS_RKV = 460 * MiB, WS_Q = 163 * MiB, WS_E = 262 * MiB, WS_A = 328 * MiB, WS_G = 394 * MiB;
constexpr size_t WS_MIX = 657 * MiB, WS_KN = 262 * MiB, WS_V = 457 * MiB, WS_ATT = 787 * MiB;
constexpr size_t WS_H = 32 * MiB, WS_U = 292 * MiB, WS_ACT = 422 * MiB;
constexpr size_t WS_HS = 790 * MiB;
constexpr size_t WS_PB5 = 430 * MiB, WS_PB7 = 300 * MiB;
constexpr size_t WS_NEED = 852 * MiB;
constexpr int LDS_BYTES = 139264;

struct P {
    const float *xp, *xs, *ckv, *ckr, *swkv, *sshift, *meta, *g_mix, *w_in, *g_q, *w_qup, *g_kv, *w_kvup, *g_qn, *g_qr, *g_kn, *g_kr, *g_ao,
                *mu, *w0, *w2, *a0, *a2, *g2, *k_k, *k_a, *r_k, *lnx_g, *lnx_b, *w_out, *g_ffn, *w_gate, *w_up, *w_down;
    float* out; unsigned char* ws;
};
__device__ __forceinline__ int lane_id() { int l; asm volatile("v_mbcnt_lo_u32_b32 %0, -1, 0\n\tv_mbcnt_hi_u32_b32 %0, -1, %0" : "=v"(l)); return l; }

__device__ __forceinline__ float bf2f(unsigned b) { return __uint_as_float(b << 16); }
__device__ __forceinline__ float bflo(unsigned w) { return __uint_as_float(w << 16); }
__device__ __forceinline__ float bfhi(unsigned w) { return __uint_as_float(w & 0xffff0000u); }
__device__ __forceinline__ unsigned pk2(float lo, float hi) { return pg8::cvt_pk_bf16(lo, hi); }
__device__ __forceinline__ float wave_sum(float v) {
#pragma unroll
    for (int o = 1; o < 64; o <<= 1) v += __shfl_xor(v, o);
    return v;
}
__device__ __forceinline__ float red16(float v) { v += __shfl_xor(v, 1); v += __shfl_xor(v, 2); v += __shfl_xor(v, 4); v += __shfl_xor(v, 8); return v; }
__device__ __forceinline__ float sigmoidf_(float x) { return 1.0f / (1.0f + __expf(-x)); }
__device__ __forceinline__ void rope_cs(float pos, int j, float& c, float& s) {
    const float inv = exp2f(-0.8304820237218406f * (float)j);
    const float ang = pos * inv;
    const float k = rintf(ang * 0.15915494309189535f);
    float r = fmaf(-k, 6.2831854820251465f, ang); r = fmaf(-k, -1.7484555e-7f, r);
    s = __sinf(r); c = __cosf(r);
}
__device__ __forceinline__ float row_pos(int row1) { return row1 < MP ? (float)(row1 % LP) : (float)(PAST + ((row1 - MP) & 31)); }

namespace pg8 {
struct EpiStore {
    static constexpr bool PERM = true, AFTER_DRAIN = false;
    bf16_t* O; int ldc;
    __device__ __forceinline__ void operator()(const f32x4 (&acc)[2][2][4][2], const Unit& u, int wr, int wc, int fr, int fq) const {
        const int row0 = u.pm * BM + wr * 64 + fr, col0 = u.pn * BM + wc * 32 + 8 * fq;
#pragma unroll
        for (int ai = 0; ai < 2; ++ai)
#pragma unroll
            for (int m = 0; m < 4; ++m) { bf16_t* rowp = O + (size_t)(row0 + ai * HALF + m * 16) * ldc + col0;
#pragma unroll
                for (int bj = 0; bj < 2; ++bj) { const f32x4 v0 = acc[ai][bj][m][0], v1 = acc[ai][bj][m][1]; u32x4 w;
                    w.x = cvt_pk_bf16(v0[0], v0[1]); w.y = cvt_pk_bf16(v0[2], v0[3]); w.z = cvt_pk_bf16(v1[0], v1[1]); w.w = cvt_pk_bf16(v1[2], v1[3]);
                    *(u32x4*)(rowp + bj * HALF) = w; } }
    }
};
struct EpiKV {
    static constexpr bool PERM = true, AFTER_DRAIN = false;
    bf16_t* KN; bf16_t* V; const float* gk;
    __device__ __forceinline__ void operator()(const f32x4 (&acc)[2][2][4][2], const Unit& u, int wr, int wc, int fr, int fq) const {
        const int slot = u.pn * 4 + wc, h = slot & 7;
        const size_t off0 = (size_t)(u.pm * BM + wr * 64 + fr) * 512 + h * 64 + 8 * fq;
        if (slot >= 8) {
#pragma unroll
            for (int ai = 0; ai < 2; ++ai)
#pragma unroll
                for (int m = 0; m < 4; ++m) { bf16_t* dst = V + off0 + (size_t)(ai * HALF + m * 16) * 512;
#pragma unroll
                    for (int bj = 0; bj < 2; ++bj) { const f32x4 v0 = acc[ai][bj][m][0], v1 = acc[ai][bj][m][1]; u32x4 w;
                        w.x = cvt_pk_bf16(v0[0], v0[1]); w.y = cvt_pk_bf16(v0[2], v0[3]); w.z = cvt_pk_bf16(v1[0], v1[1]); w.w = cvt_pk_bf16(v1[2], v1[3]);
                        *(u32x4*)(dst + 32 * bj) = w; } }
        } else {
#pragma unroll
            for (int ai = 0; ai < 2; ++ai)
#pragma unroll
                for (int m = 0; m < 4; ++m) {
                    float ss = 0.f;
#pragma unroll
                    for (int bj = 0; bj < 2; ++bj)
#pragma unroll
                        for (int n = 0; n < 2; ++n) { const f32x4 x = acc[ai][bj][m][n]; ss += (x[0] * x[0] + x[1] * x[1]) + (x[2] * x[2] + x[3] * x[3]); }
                    ss += __shfl_xor(ss, 16); ss += __shfl_xor(ss, 32);
                    const float rs = rsqrtf(ss * (1.0f / 64.0f) + EPS);
                    bf16_t* dst = KN + off0 + (size_t)(ai * HALF + m * 16) * 512;
#pragma unroll
                    for (int bj = 0; bj < 2; ++bj) { const f32x4 v0 = acc[ai][bj][m][0] * rs, v1 = acc[ai][bj][m][1] * rs; u32x4 w;
                        w.x = cvt_pk_bf16(v0[0], v0[1]); w.y = cvt_pk_bf16(v0[2], v0[3]); w.z = cvt_pk_bf16(v1[0], v1[1]); w.w = cvt_pk_bf16(v1[2], v1[3]);
                        *(u32x4*)(dst + 32 * bj) = w; }
                    asm volatile("" ::: "memory");
                }
        }
    }
};
struct EpiRes {
    static constexpr bool PERM = false, AFTER_DRAIN = false;
    float* O; const float* r0; const float* r1; int split;
    __device__ __forceinline__ void operator()(const f32x4 (&acc)[2][2][4][2], const Unit& u, int wr, int wc, int fr, int fq) const {
        const int col0 = u.pn * BM + wc * 32 + 4 * fq;
#pragma unroll
        for (int ai = 0; ai < 2; ++ai)
#pragma unroll
            for (int m = 0; m < 4; ++m) {
                const int row = u.pm * BM + ai * HALF + wr * 64 + m * 16 + fr;
                const float* rp = (row < split ? r0 + (size_t)row * 1024 : r1 + (size_t)(row - split) * 1024) + col0;
                float* op = O + (size_t)row * 1024 + col0;
#pragma unroll
                for (int bj = 0; bj < 2; ++bj)
#pragma unroll
                    for (int n = 0; n < 2; ++n) { const f32x4 x = *(const f32x4*)(rp + bj * HALF + n * 16); *(f32x4*)(op + bj * HALF + n * 16) = acc[ai][bj][m][n] + x; }
            }
    }
};
struct EpiResToB16 {
    static constexpr bool PERM = false, AFTER_DRAIN = false;
    bf16_t* H; const float* x;
    __device__ __forceinline__ void operator()(const f32x4 (&acc)[2][2][4][2], const Unit& u, int wr, int wc, int fr, int fq) const {
        const int col0 = u.pn * BM + wc * 32 + 4 * fq;
#pragma unroll
        for (int ai = 0; ai < 2; ++ai)
#pragma unroll
            for (int m = 0; m < 4; ++m) {
                const size_t o = (size_t)(u.pm * BM + ai * HALF + wr * 64 + m * 16 + fr) * 1024 + col0;
#pragma unroll
                for (int bj = 0; bj < 2; ++bj)
#pragma unroll
                    for (int n = 0; n < 2; ++n) { const f32x4 h = acc[ai][bj][m][n] + *(const f32x4*)(x + o + bj * HALF + n * 16);
                        u32x2 w; w.x = cvt_pk_bf16(h[0], h[1]); w.y = cvt_pk_bf16(h[2], h[3]); *(u32x2*)(H + o + bj * HALF + n * 16) = w; }
            }
    }
};
struct EpiOutFromB16 {
    static constexpr bool PERM = false, AFTER_DRAIN = false;
    float* O; const bf16_t* H;
    __device__ __forceinline__ void operator()(const f32x4 (&acc)[2][2][4][2], const Unit& u, int wr, int wc, int fr, int fq) const {
        const int col0 = u.pn * BM + wc * 32 + 4 * fq;
#pragma unroll
        for (int ai = 0; ai < 2; ++ai)
#pragma unroll
            for (int m = 0; m < 4; ++m) {
                const size_t o = (size_t)(u.pm * BM + ai * HALF + wr * 64 + m * 16 + fr) * 1024 + col0;
#pragma unroll
                for (int bj = 0; bj < 2; ++bj)
#pragma unroll
                    for (int n = 0; n < 2; ++n) { const u32x2 r = *(const u32x2*)(H + o + bj * HALF + n * 16);
                        const f32x4 h = {bflo(r.x), bfhi(r.x), bflo(r.y), bfhi(r.y)};
                        *(f32x4*)(O + o + bj * HALF + n * 16) = acc[ai][bj][m][n] + h; }
            }
    }
};
struct EpiSwiglu {
    static constexpr bool PERM = true, AFTER_DRAIN = false;
    bf16_t* O;
    __device__ __forceinline__ void operator()(const f32x4 (&acc)[2][2][4][2], const Unit& u, int wr, int wc, int fr, int fq) const {
        const int col0 = u.pn * HALF + wc * 32 + 8 * fq;
#pragma unroll
        for (int ai = 0; ai < 2; ++ai)
#pragma unroll
            for (int m = 0; m < 4; ++m) {
                const int row = u.pm * BM + ai * HALF + wr * 64 + m * 16 + fr;
                float o[8];
#pragma unroll
                for (int n = 0; n < 2; ++n)
#pragma unroll
                    for (int e = 0; e < 4; ++e) { const float g = acc[ai][0][m][n][e], up = acc[ai][1][m][n][e]; o[4 * n + e] = g * sigmoidf_(g) * up; }
                u32x4 w; w.x = cvt_pk_bf16(o[0], o[1]); w.y = cvt_pk_bf16(o[2], o[3]); w.z = cvt_pk_bf16(o[4], o[5]); w.w = cvt_pk_bf16(o[6], o[7]);
                *(u32x4*)(O + (size_t)row * DFF + col0) = w;
            }
    }
};
struct SplitOrder {
    int pm0, npm, nN, nkc, G, c;
    __device__ bool next(int i, Unit& u) const {
        const long L = (long)i * G + (G - 1 - c); if (L >= (long)npm * nN * nkc) return false;
        const int l = (int)L; u.kc = l % nkc; const int t = l / nkc; u.pn = t % nN; u.pm = pm0 + t / nN; return true;
    }
    __device__ __forceinline__ void a_ready(const Unit&) const {}
    __device__ __forceinline__ void done(const Unit&) const {}
};
struct EpiPartial {
    static constexpr bool PERM = false, AFTER_DRAIN = false;
    float* PB; int row0;
    __device__ __forceinline__ void operator()(const f32x4 (&acc)[2][2][4][2], const Unit& u, int wr, int wc, int fr, int fq) const {
        const int col0 = u.pn * BM + wc * 32 + 4 * fq;
        float* base = PB + ((size_t)u.kc * 1024 + (u.pm * BM + wr * 64 + fr - row0)) * 1024 + col0;
#pragma unroll
        for (int ai = 0; ai < 2; ++ai)
#pragma unroll
            for (int m = 0; m < 4; ++m) {
                float* op = base + (size_t)(ai * HALF + m * 16) * 1024;
#pragma unroll
                for (int bj = 0; bj < 2; ++bj)
#pragma unroll
                    for (int n = 0; n < 2; ++n) *(f32x4*)(op + bj * HALF + n * 16) = acc[ai][bj][m][n];
            }
    }
};
}

__device__ __forceinline__ float wsrc(const P& p, int mat, int n, int k) {
    switch (mat) {
    case 0: return n < INCOLS ? p.w_in[(size_t)k * INCOLS + n] : 0.f;
    case 1: return p.w_qup[(size_t)k * 768 + n];
    case 2: { const int pn = n >> 8, bj = (n >> 7) & 1, wc = (n >> 5) & 3, x = n & 31, slot = pn * 4 + wc;
              const int c = (slot & 7) * 128 + (slot < 8 ? 0 : 64) + 32 * bj + x;
              return p.w_kvup[(size_t)k * 1024 + c]; }
    case 3: { if (n < 512) return k < 64 ? p.w2[(size_t)k * 512 + n] : 0.f;
              if (n < 1024) return (k >= 64 && k < 128) ? p.a2[(size_t)(k - 64) * 512 + (n - 512)] : 0.f;
              return k >= 128 ? p.g2[(size_t)(k - 128) * 512 + (n - 1024)] : 0.f; }
    case 4: return p.w_out[(size_t)k * 1024 + n];
    case 5: { const int pn = n >> 8, r = n & 255; return r < 128 ? p.w_gate[(size_t)k * DFF + pn * 128 + r] : p.w_up[(size_t)k * DFF + pn * 128 + r - 128]; }
    default: return p.w_down[(size_t)k * 1024 + n];
    }
}
__device__ __forceinline__ const float* xn_src(const P& p, int row) {
    if (row < MP) { const int b = row / LP, t = row % LP; return t < NMETA ? p.meta + (size_t)t * DM : p.xp + ((size_t)b * SEQ + (t - NMETA)) * DM; }
    return p.xs + (size_t)(row - MP) * DM;
}
__device__ __forceinline__ void phase_e0(const P& p, int wv, LAS unsigned char* lds) {
    LAS float* T = (LAS float*)lds;
    const int tid_l = wv * 64 + lane_id(); const int tid = tid_l, lane = tid & 63, wave = tid >> 6;
    constexpr int NT = 3120;
#define E0_DECODE(T_, mat, K, n0, k0, dst) do { int r_; \
        if ((T_) < 576)       { mat = 0; r_ = (T_);        K = 1024; dst = (bf16_t*)(p.ws + WS_WIN); } \
        else if ((T_) < 624)  { mat = 1; r_ = (T_) - 576;  K = 256;  dst = (bf16_t*)(p.ws + WS_WQ); } \
        else if ((T_) < 656)  { mat = 2; r_ = (T_) - 624;  K = 128;  dst = (bf16_t*)(p.ws + WS_WKV); } \
        else if ((T_) < 752)  { mat = 3; r_ = (T_) - 656;  K = 256;  dst = (bf16_t*)(p.ws + WS_WL); } \
        else if ((T_) < 1008) { mat = 4; r_ = (T_) - 752;  K = 1024; dst = (bf16_t*)(p.ws + WS_WOUT); } \
        else if ((T_) < 2416) { mat = 5; r_ = (T_) - 1008; K = 1024; dst = (bf16_t*)(p.ws + WS_WGU); } \
        else                  { mat = 6; r_ = (T_) - 2416; K = 2816; dst = (bf16_t*)(p.ws + WS_WDN); } \
        const int nkt_ = K / 64; n0 = (r_ / nkt_) * 64; k0 = (r_ % nkt_) * 64; } while (0)
    {
        float v[8];
        int t = blockIdx.x;
        if (t < NT) { int mat, K, n0, k0; bf16_t* dst; E0_DECODE(t, mat, K, n0, k0, dst); (void)dst;
#pragma unroll
            for (int i = 0; i < 8; ++i) v[i] = wsrc(p, mat, n0 + (tid & 63), k0 + (tid >> 6) + 8 * i); }
        for (; t < NT; t += gridDim.x) {
            int mat, K, n0, k0; bf16_t* dst; E0_DECODE(t, mat, K, n0, k0, dst); (void)mat;
#pragma unroll
            for (int i = 0; i < 8; ++i) T[((tid >> 6) + 8 * i) * 65 + (tid & 63)] = v[i];
            __syncthreads();
            const int tn = t + gridDim.x;
            if (tn < NT) { int mat2, K2, n02, k02; bf16_t* dst2; E0_DECODE(tn, mat2, K2, n02, k02, dst2); (void)dst2;
#pragma unroll
                for (int i = 0; i < 8; ++i) v[i] = wsrc(p, mat2, n02 + (tid & 63), k02 + (tid >> 6) + 8 * i); }
#pragma unroll
            for (int i = 0; i < 4; ++i) { const int n = (tid >> 5) + 16 * i, kq = tid & 31;
                *(unsigned*)(dst + (size_t)(n0 + n) * K + k0 + 2 * kq) = pk2(T[(2 * kq) * 65 + n], T[(2 * kq + 1) * 65 + n]); }
            __syncthreads();
        }
    }
#undef E0_DECODE
    bf16_t* XN = (bf16_t*)(p.ws + WS_XN);
    f32x4 g[4];
#pragma unroll
    for (int j = 0; j < 4; ++j) g[j] = *(const f32x4*)(p.g_mix + 4 * lane + 256 * j);
    const int xstride = gridDim.x * 8;
    for (int row = blockIdx.x * 8 + wave; row < M1; row += 2 * xstride) {
        const int rowb = row + xstride; const bool hb = rowb < M1;
        const float* sa = xn_src(p, row); const float* sb = xn_src(p, hb ? rowb : row);
        f32x4 va[4], vb[4]; float ssa = 0.f, ssb = 0.f;
#pragma unroll
        for (int j = 0; j < 4; ++j) { va[j] = *(const f32x4*)(sa + 4 * lane + 256 * j); vb[j] = *(const f32x4*)(sb + 4 * lane + 256 * j); }
#pragma unroll
        for (int j = 0; j < 4; ++j) { ssa += (va[j][0] * va[j][0] + va[j][1] * va[j][1]) + (va[j][2] * va[j][2] + va[j][3] * va[j][3]);
                                      ssb += (vb[j][0] * vb[j][0] + vb[j][1] * vb[j][1]) + (vb[j][2] * vb[j][2] + vb[j][3] * vb[j][3]); }
        const float rsa = rsqrtf(wave_sum(ssa) * (1.0f / DM) + EPS), rsb = rsqrtf(wave_sum(ssb) * (1.0f / DM) + EPS);
#pragma unroll
        for (int j = 0; j < 4; ++j) { const f32x4 o = va[j] * g[j] * rsa; u32x2 w; w.x = pk2(o[0], o[1]); w.y = pk2(o[2], o[3]);
            *(u32x2*)(XN + (size_t)row * DM + 4 * lane + 256 * j) = w; }
        if (hb) {
#pragma unroll
            for (int j = 0; j < 4; ++j) { const f32x4 o = vb[j] * g[j] * rsb; u32x2 w; w.x = pk2(o[0], o[1]); w.y = pk2(o[2], o[3]);
                *(u32x2*)(XN + (size_t)rowb * DM + 4 * lane + 256 * j) = w; } }
    }
}

struct E1Raw { u32x2 q; unsigned c, kr; u32x2 cur[7], prv[7]; };
__device__ __forceinline__ void e1_load(E1Raw& R, const bf16_t* PROJ, int row, int lane) {
    const bf16_t* pr = PROJ + (size_t)row * NPROJ;
    R.q = *(const u32x2*)(pr + 4 * lane); R.c = *(const unsigned*)(pr + 256 + 2 * lane); R.kr = pr[384 + (lane & 31)];
#pragma unroll
    for (int idx = 0; idx < 7; ++idx) R.cur[idx] = *(const u32x2*)(pr + RW0 + 4 * lane + 256 * idx);
    const bool nofirst = row < MP ? (row % LP != 0) : (((row - MP) & 31) != 0);
#pragma unroll
    for (int idx = 0; idx < 7; ++idx) R.prv[idx] = nofirst ? *(const u32x2*)(pr - NPROJ + RW0 + 4 * lane + 256 * idx) : (u32x2){0u, 0u};
}
__device__ __forceinline__ void e1_finish(const P& p, const E1Raw& R, int row, int lane, f32x4 gq, f32x2 gkv, float gkr) {
    bf16_t* QL = (bf16_t*)(p.ws + WS_QL); bf16_t* CALL = (bf16_t*)(p.ws + WS_CALL); bf16_t* KRALL = (bf16_t*)(p.ws + WS_KRALL);
    bf16_t* RKV = (bf16_t*)(p.ws + WS_RKV); bf16_t* LIN = (bf16_t*)(p.ws + WS_LIN);
    const bool isP = row < MP;
        int b, t; if (isP) { b = row / LP; t = row % LP; } else { b = (row - MP) >> 5; t = (row - MP) & 31; }
        const int rowk = isP ? b * KPB + 48 + t : MKP + b * KSAMP + PAST + t;
        const float pos = isP ? (float)t : (float)(PAST + t);
        { const u32x2 raw = R.q; const float x0 = bflo(raw.x), x1 = bfhi(raw.x), x2 = bflo(raw.y), x3 = bfhi(raw.y);
          const float rs = rsqrtf(wave_sum((x0 * x0 + x1 * x1) + (x2 * x2 + x3 * x3)) * (1.0f / 256.0f) + EPS);
          u32x2 w; w.x = pk2(x0 * rs * gq[0], x1 * rs * gq[1]); w.y = pk2(x2 * rs * gq[2], x3 * rs * gq[3]);
          *(u32x2*)(QL + (size_t)row * 256 + 4 * lane) = w; }
        { const unsigned raw = R.c; const float x0 = bflo(raw), x1 = bfhi(raw);
          const float rs = rsqrtf(wave_sum(x0 * x0 + x1 * x1) * (1.0f / 128.0f) + EPS);
          const float c0 = x0 * rs * gkv[0], c1 = x1 * rs * gkv[1];
          float* dst = isP ? p.out + OFF_KVP + ((size_t)b * LP + t) * 128 : p.out + OFF_KVS + ((size_t)b * DSQ + t) * 128;
          *(f32x2*)(dst + 2 * lane) = (f32x2){c0, c1};
          *(unsigned*)(CALL + (size_t)rowk * 128 + 2 * lane) = pk2(c0, c1); }
        { const int j = lane & 31; const float x = bf2f(R.kr);
          float ss = x * x; ss += __shfl_xor(ss, 1); ss += __shfl_xor(ss, 2); ss += __shfl_xor(ss, 4); ss += __shfl_xor(ss, 8); ss += __shfl_xor(ss, 16);
          const float y = x * rsqrtf(ss * (1.0f / 32.0f) + EPS) * gkr;
          const float pa = __shfl_xor(y, 16);
          float c, s; rope_cs(pos, j & 15, c, s);
          const float o = j < 16 ? y * c - pa * s : pa * s + y * c;
          if (lane < 32) {
              float* dst = isP ? p.out + OFF_KRP + ((size_t)b * LP + t) * 32 : p.out + OFF_KRS + ((size_t)b * DSQ + t) * 32;
              dst[j] = o; KRALL[(size_t)rowk * 32 + j] = (bf16_t)(pk2(o, 0.f) & 0xffffu);
          } }
        const bool first = (t == 0), last = isP ? (t == LP - 1) : (t == DSQ - 1);
        float* shdst = isP ? p.out + OFF_SHP + (size_t)b * RWC : p.out + OFF_SHS + (size_t)b * RWC;
#pragma unroll
        for (int idx = 0; idx < 7; ++idx) {
            const int c = 4 * lane + 256 * idx;
            const u32x2 raw = R.cur[idx];
            const f32x4 cur = {bflo(raw.x), bfhi(raw.x), bflo(raw.y), bfhi(raw.y)};
            f32x4 prev;
            if (first) { if (isP) prev = (f32x4){0.f, 0.f, 0.f, 0.f}; else prev = *(const f32x4*)(p.sshift + (size_t)b * RWC + c); }
            else { const u32x2 rp = R.prv[idx]; prev = (f32x4){bflo(rp.x), bfhi(rp.x), bflo(rp.y), bfhi(rp.y)}; }
            const f32x4 mu = *(const f32x4*)(p.mu + c);
            f32x4 xm = cur + (prev - cur) * mu;
            if (last) *(f32x4*)(shdst + c) = cur;
            if (idx < 6) { u32x2 w; w.x = pk2(xm[0], xm[1]); w.y = pk2(xm[2], xm[3]); *(u32x2*)(RKV + (size_t)row * 1536 + c) = w; }
            else {
                const int lc = 4 * lane;
                if (lc < 64) {
#pragma unroll
                    for (int e = 0; e < 4; ++e) xm[e] = tanhf(xm[e]); }
                else if (lc >= 128) {
#pragma unroll
                    for (int e = 0; e < 4; ++e) xm[e] = sigmoidf_(xm[e]); }
                u32x2 w; w.x = pk2(xm[0], xm[1]); w.y = pk2(xm[2], xm[3]); *(u32x2*)(LIN + (size_t)row * 256 + lc) = w;
            }
        }
    }
__device__ __forceinline__ void phase_e1(const P& p, int wv) {
    const int tid_l = wv * 64 + lane_id(); const int tid = tid_l, lane = tid & 63, wave = tid >> 6;
    const bf16_t* PROJ = (const bf16_t*)(p.ws + WS_PROJ);
    bf16_t* QL = (bf16_t*)(p.ws + WS_QL); bf16_t* CALL = (bf16_t*)(p.ws + WS_CALL); bf16_t* KRALL = (bf16_t*)(p.ws + WS_KRALL);
    bf16_t* RKV = (bf16_t*)(p.ws + WS_RKV); bf16_t* LIN = (bf16_t*)(p.ws + WS_LIN);
    {
        const size_t gt = (size_t)blockIdx.x * 512 + tid, gs = (size_t)gridDim.x * 512;
        for (size_t e = gt; e < (size_t)NB * 48 * 128 / 4; e += gs) {
            const size_t idx = e * 4; const int b = (int)(idx / (48 * 128)); const size_t rem = idx - (size_t)b * 48 * 128;
            *(u32x2*)(CALL + (size_t)b * KPB * 128 + rem) = (u32x2){0u, 0u};
        }
        for (size_t e = gt; e < (size_t)NB * 48 * 32 / 4; e += gs) {
            const size_t idx = e * 4; const int b = (int)(idx / (48 * 32)); const size_t rem = idx - (size_t)b * 48 * 32;
            *(u32x2*)(KRALL + (size_t)b * KPB * 32 + rem) = (u32x2){0u, 0u};
        }
    }
    const f32x4 gq = *(const f32x4*)(p.g_q + 4 * lane);
    const f32x2 gkv = *(const f32x2*)(p.g_kv + 2 * lane);
    const float gkr = p.g_kr[lane & 31];
    const int e1stride = gridDim.x * 8;
    for (int row = blockIdx.x * 8 + wave; row < M1; row += 2 * e1stride) {
        const int rowb = row + e1stride; const bool hb = rowb < M1;
        E1Raw ra, rb;
        e1_load(ra, PROJ, row, lane); e1_load(rb, PROJ, hb ? rowb : row, lane);
        e1_finish(p, ra, row, lane, gq, gkv, gkr);
        if (hb) e1_finish(p, rb, rowb, lane, gq, gkv, gkr);
    }

}

template <int CTRL> __device__ __forceinline__ float dppf(float v) { return __uint_as_float(__builtin_amdgcn_update_dpp(0u, __float_as_uint(v), CTRL, 0xF, 0xF, true)); }
__device__ __forceinline__ float red8(float v) { v += dppf<0xB1>(v); v += dppf<0x4E>(v); v += dppf<0x141>(v); return v; }
__device__ __forceinline__ float red16d(float v) { v += dppf<0xB1>(v); v += dppf<0x4E>(v); v += dppf<0x141>(v); v += dppf<0x140>(v); return v; }

struct ScanPre { u32x2 r, k, v, lw, la, g; };
struct ScanKeep { f32x4 v; float bon; u32x2 g; };
struct ScanConst { f32x4 kk, ka, rk, lg, lb, w0, a0; };
constexpr int SC_BUF = 12416;

__device__ __forceinline__ void scan_load(ScanPre& q, const bf16_t* RKV, const bf16_t* LO, size_t row, int hc) {
    q.r = *(const u32x2*)(RKV + row * 1536 + hc); q.k = *(const u32x2*)(RKV + row * 1536 + 512 + hc); q.v = *(const u32x2*)(RKV + row * 1536 + 1024 + hc);
    q.lw = *(const u32x2*)(LO + row * 1536 + hc); q.la = *(const u32x2*)(LO + row * 1536 + 512 + hc); q.g = *(const u32x2*)(LO + row * 1536 + 1024 + hc);
}
__device__ __forceinline__ void scan_stage_a(const ScanPre& q, const ScanConst& C, LAS float* buf, int tt, int dq, ScanKeep& keep) {
    const f32x4 r = {bflo(q.r.x), bfhi(q.r.x), bflo(q.r.y), bfhi(q.r.y)}, k = {bflo(q.k.x), bfhi(q.k.x), bflo(q.k.y), bfhi(q.k.y)}, v = {bflo(q.v.x), bfhi(q.v.x), bflo(q.v.y), bfhi(q.v.y)};
    const f32x4 lw = (f32x4){bflo(q.lw.x), bfhi(q.lw.x), bflo(q.lw.y), bfhi(q.lw.y)} + C.w0, la = (f32x4){bflo(q.la.x), bfhi(q.la.x), bflo(q.la.y), bfhi(q.la.y)} + C.a0;
    f32x4 w, a;
#pragma unroll
    for (int c = 0; c < 4; ++c) { w[c] = __expf(-0.6065306597126334f * sigmoidf_(lw[c])); a[c] = sigmoidf_(la[c]); }
    const f32x4 kkr = k * C.kk;
    const float ss = red16d((kkr[0] * kkr[0] + kkr[1] * kkr[1]) + (kkr[2] * kkr[2] + kkr[3] * kkr[3]));
    const float inv = 1.0f / fmaxf(sqrtf(ss), 1e-12f);
    const f32x4 kk = kkr * inv;
    const f32x4 keff = k * (1.0f + (a - 1.0f) * C.ka);
    const f32x4 bb = a * kk, wr = w * r;
    const f32x4 t1 = bb * r, t2 = keff * r, t3 = t2 * C.rk;
    const float br = red16d((t1[0] + t1[1]) + (t1[2] + t1[3])), kr = red16d((t2[0] + t2[1]) + (t2[2] + t2[3])), bon = red16d((t3[0] + t3[1]) + (t3[2] + t3[3]));
    const int o = tt * 64 + 4 * dq;
    *(LAS f32x4*)(buf + o) = w; *(LAS f32x4*)(buf + 2048 + o) = bb; *(LAS f32x4*)(buf + 4096 + o) = keff; *(LAS f32x4*)(buf + 6144 + o) = kk; *(LAS f32x4*)(buf + 8192 + o) = wr; *(LAS f32x4*)(buf + 10240 + o) = v;
    if (dq == 0) *(LAS f32x4*)(buf + 12288 + tt * 4) = (f32x4){br, kr, bon, 0.f};
    keep.v = v; keep.bon = bon; keep.g = q.g;
}

struct ScanVec { f32x4 k0, k1, q0, q1, w0, w1, b0, b1, e0, e1, sc; float vi0, vi1; };
#define SV_DSR128(dst, addr, off) asm volatile("ds_read_b128 %0, %1 offset:" #off : "=v"(dst) : "v"(addr))
#define SV_DSR32(dst, addr, off) asm volatile("ds_read_b32 %0, %1 offset:" #off : "=v"(dst) : "v"(addr))
__device__ __forceinline__ void sv_issue(ScanVec& s, unsigned a_vec, unsigned a_sc, unsigned a_v) {
    SV_DSR128(s.k0, a_vec, 24576); SV_DSR128(s.k1, a_vec, 24592); SV_DSR128(s.q0, a_vec, 32768); SV_DSR128(s.q1, a_vec, 32784);
    SV_DSR128(s.sc, a_sc, 49152); SV_DSR32(s.vi0, a_v, 40960); SV_DSR32(s.vi1, a_v, 41088);
    SV_DSR128(s.w0, a_vec, 0); SV_DSR128(s.w1, a_vec, 16); SV_DSR128(s.b0, a_vec, 8192); SV_DSR128(s.b1, a_vec, 8208);
    SV_DSR128(s.e0, a_vec, 16384); SV_DSR128(s.e1, a_vec, 16400);
}
__device__ __forceinline__ void sv_wait(ScanVec& s) {
    asm volatile("s_waitcnt lgkmcnt(0)" : "+v"(s.k0), "+v"(s.k1), "+v"(s.q0), "+v"(s.q1), "+v"(s.w0), "+v"(s.w1), "+v"(s.b0), "+v"(s.b1), "+v"(s.e0), "+v"(s.e1), "+v"(s.sc), "+v"(s.vi0), "+v"(s.vi1));
}
__device__ __forceinline__ f32x2 lo2(f32x4 v) { return __builtin_shufflevector(v, v, 0, 1); }
__device__ __forceinline__ f32x2 hi2(f32x4 v) { return __builtin_shufflevector(v, v, 2, 3); }
__device__ __forceinline__ f32x2 fma2(f32x2 a, f32x2 b, f32x2 c) { return __builtin_elementwise_fma(a, b, c); }
__device__ __forceinline__ float sv_row(f32x2 (&S)[4], const ScanVec& s, float vi) {
    f32x2 a1 = S[0] * lo2(s.k0), a2 = S[0] * lo2(s.q0);
    a1 = fma2(S[1], hi2(s.k0), a1); a2 = fma2(S[1], hi2(s.q0), a2);
    a1 = fma2(S[2], lo2(s.k1), a1); a2 = fma2(S[2], lo2(s.q1), a2);
    a1 = fma2(S[3], hi2(s.k1), a1); a2 = fma2(S[3], hi2(s.q1), a2);
    const float d1 = red8(a1.x + a1.y), d2 = red8(a2.x + a2.y);
    const float sa = -d1;
    const float y = d2 + sa * s.sc[0] + vi * s.sc[1];
    const f32x2 sa2 = {sa, sa}, vi2 = {vi, vi};
    S[0] = fma2(S[0], lo2(s.w0), fma2(sa2, lo2(s.b0), vi2 * lo2(s.e0)));
    S[1] = fma2(S[1], hi2(s.w0), fma2(sa2, hi2(s.b0), vi2 * hi2(s.e0)));
    S[2] = fma2(S[2], lo2(s.w1), fma2(sa2, lo2(s.b1), vi2 * lo2(s.e1)));
    S[3] = fma2(S[3], hi2(s.w1), fma2(sa2, hi2(s.b1), vi2 * hi2(s.e1)));
    return y;
}
__device__ __forceinline__ void sv_step(f32x2 (&S0)[4], f32x2 (&S1)[4], const ScanVec& s, LAS float* Yc, int t, int i2, int j) {
    const float y0 = sv_row(S0, s, s.vi0), y1 = sv_row(S1, s, s.vi1);
    if (j == 0) { Yc[t * 64 + i2] = y0; Yc[t * 64 + 32 + i2] = y1; }
}
__device__ __forceinline__ void scan_stage_c(const ScanConst& C, const LAS float* buf, const LAS float* Yc, int tl, int dq, bool valid, u32x2 graw, bf16_t* dst) {
    const f32x4 y = *(const LAS f32x4*)(Yc + tl * 64 + 4 * dq);
    const float mean = red16d((y[0] + y[1]) + (y[2] + y[3])) * (1.0f / 64.0f);
    const f32x4 d = y - mean;
    const float var = red16d((d[0] * d[0] + d[1] * d[1]) + (d[2] * d[2] + d[3] * d[3])) * (1.0f / 64.0f);
    const f32x4 v = *(const LAS f32x4*)(buf + 10240 + tl * 64 + 4 * dq);
    const float bon = buf[12288 + tl * 4 + 2];
    if (valid) {
        const float rstd = rsqrtf(var + LNX_EPS);
        const f32x4 g = {bflo(graw.x), bfhi(graw.x), bflo(graw.y), bfhi(graw.y)};
        const f32x4 o = (d * rstd * C.lg + C.lb + v * bon) * g;
        u32x2 w; w.x = pk2(o[0], o[1]); w.y = pk2(o[2], o[3]);
        *(u32x2*)dst = w;
    }
}

constexpr int BG_PER_UNIT = 20480;
constexpr size_t BG_NV1 = (size_t)NB * PAST * 128 / 4;
__device__ __forceinline__ bool bg_load(const P& p, int uu, int li, f32x4& v) {
    if (uu < 0 || li >= BG_PER_UNIT) return false;
    const size_t g = (size_t)uu * BG_PER_UNIT + li;
    v = g < BG_NV1 ? *(const f32x4*)(p.ckv + g * 4) : *(const f32x4*)(p.ckr + (g - BG_NV1) * 4);
    return true;
}
__device__ __forceinline__ void bg_store(const P& p, int uu, int li, const f32x4& v) {
    const size_t g = (size_t)uu * BG_PER_UNIT + li;
    u32x2 w; w.x = pk2(v[0], v[1]); w.y = pk2(v[2], v[3]);
    if (g < BG_NV1) { const size_t idx = g * 4; const int b = (int)(idx / ((size_t)PAST * 128)); const size_t rem = idx - (size_t)b * PAST * 128;
        *(u32x2*)((bf16_t*)(p.ws + WS_CALL) + ((size_t)MKP + (size_t)b * KSAMP) * 128 + rem) = w; }
    else { const size_t idx = (g - BG_NV1) * 4; const int b = (int)(idx / ((size_t)PAST * 32)); const size_t rem = idx - (size_t)b * PAST * 32;
        *(u32x2*)((bf16_t*)(p.ws + WS_KRALL) + ((size_t)MKP + (size_t)b * KSAMP) * 32 + rem) = w; }
}

__device__ __forceinline__ void scan_unit(const P& p, int wv, LAS unsigned char* lds, int row1_base, int nsteps, const float* s0, float* s_out, int first_out, int row2_base, int h, int bg_unit) {
    const int tid_l = wv * 64 + lane_id(); const int tid = tid_l;
    const bool is_rec = tid < 256;
    LAS float* BUF = (LAS float*)lds;
    LAS float* Y = BUF + 2 * SC_BUF;
    const bf16_t* RKV = (const bf16_t*)(p.ws + WS_RKV); const bf16_t* LO = (const bf16_t*)(p.ws + WS_E);
    bf16_t* MIX = (bf16_t*)(p.ws + WS_MIX);
    const int nch = (nsteps + 31) >> 5;
    __syncthreads();
    if (is_rec) {
        const int i2 = tid >> 3, j = tid & 7;
        f32x2 S0[4], S1[4];
        if (s0) { const f32x4 a = *(const f32x4*)(s0 + i2 * 64 + 8 * j), b = *(const f32x4*)(s0 + i2 * 64 + 8 * j + 4), c = *(const f32x4*)(s0 + (i2 + 32) * 64 + 8 * j), d = *(const f32x4*)(s0 + (i2 + 32) * 64 + 8 * j + 4);
            S0[0] = lo2(a); S0[1] = hi2(a); S0[2] = lo2(b); S0[3] = hi2(b); S1[0] = lo2(c); S1[1] = hi2(c); S1[2] = lo2(d); S1[3] = hi2(d); }
        else {
#pragma unroll
            for (int cc = 0; cc < 4; ++cc) { S0[cc] = (f32x2){0.f, 0.f}; S1[cc] = (f32x2){0.f, 0.f}; } }
        const unsigned lbase = (unsigned)(unsigned long long)BUF;
        __syncthreads();
        for (int c = 0; c < nch; ++c) {
            const int c0 = c * 32, T = (nsteps - c0) < 32 ? (nsteps - c0) : 32;
            LAS float* Yc = Y + (c & 1) * 2048;
            const unsigned bb = lbase + (unsigned)(c & 1) * (SC_BUF * 4u);
            unsigned a_vec = bb + 32u * j, a_sc = bb, a_v = bb + 4u * i2;
            ScanVec va, vb;
            sv_issue(va, a_vec, a_sc, a_v); sv_wait(va);
            for (int t = 0; t < T; t += 2) {
                sv_issue(vb, a_vec + 256u, a_sc + 16u, a_v + 256u);
                sv_step(S0, S1, va, Yc, t, i2, j);
                sv_wait(vb);
                const unsigned adv = (t + 2 < T) ? 2u : 1u;
                a_vec += 256u * adv; a_sc += 16u * adv; a_v += 256u * adv;
                sv_issue(va, a_vec, a_sc, a_v);
                sv_step(S0, S1, vb, Yc, t + 1, i2, j);
                sv_wait(va);
            }
            __syncthreads();
        }
        float* so = s_out + i2 * 64 + 8 * j;
        *(f32x4*)so = (f32x4){S0[0].x, S0[0].y, S0[1].x, S0[1].y}; *(f32x4*)(so + 4) = (f32x4){S0[2].x, S0[2].y, S0[3].x, S0[3].y};
        *(f32x4*)(so + 2048) = (f32x4){S1[0].x, S1[0].y, S1[1].x, S1[1].y}; *(f32x4*)(so + 2052) = (f32x4){S1[2].x, S1[2].y, S1[3].x, S1[3].y};
    } else {
        const int ptid = tid - 256, tt = ptid >> 4, dq = ptid & 15, hc = h * 64 + 4 * dq;
        ScanConst C;
        C.kk = *(const f32x4*)(p.k_k + hc); C.ka = *(const f32x4*)(p.k_a + hc); C.rk = *(const f32x4*)(p.r_k + hc);
        C.lg = *(const f32x4*)(p.lnx_g + hc); C.lb = *(const f32x4*)(p.lnx_b + hc); C.w0 = *(const f32x4*)(p.w0 + hc); C.a0 = *(const f32x4*)(p.a0 + hc);
        ScanPre pa, pb; ScanKeep kdummy;
        pa.r = pa.k = pa.v = pa.lw = pa.la = pa.g = (u32x2){0u, 0u}; pb = pa;
        if (tt < nsteps) scan_load(pa, RKV, LO, (size_t)(row1_base + tt), hc);
        if (tt + 16 < nsteps) scan_load(pb, RKV, LO, (size_t)(row1_base + tt + 16), hc);
        if (tt < nsteps) scan_stage_a(pa, C, BUF, tt, dq, kdummy);
        if (tt + 16 < nsteps) scan_stage_a(pb, C, BUF, tt + 16, dq, kdummy);
        if (32 + tt < nsteps) scan_load(pa, RKV, LO, (size_t)(row1_base + 32 + tt), hc);
        if (48 + tt < nsteps) scan_load(pb, RKV, LO, (size_t)(row1_base + 48 + tt), hc);
        __syncthreads();
        for (int c = 0; c < nch; ++c) {
            const int c0 = c * 32;
            f32x4 bg0, bg1; const int bgl0 = (2 * c) * 256 + ptid, bgl1 = (2 * c + 1) * 256 + ptid;
            const bool hb0 = bg_load(p, bg_unit, bgl0, bg0), hb1 = bg_load(p, bg_unit, bgl1, bg1);
            if (c >= 1) {
                const int pc0 = c0 - 32; const LAS float* bufp = BUF + ((c - 1) & 1) * SC_BUF; const LAS float* Yp = Y + ((c - 1) & 1) * 2048;
                const int tok0 = pc0 + tt, tok1 = pc0 + tt + 16;
                const bool v0 = tok0 >= first_out, v1 = tok1 >= first_out;
                u32x2 g0 = {0u, 0u}, g1 = {0u, 0u};
                if (v0) g0 = *(const u32x2*)(LO + (size_t)(row1_base + tok0) * 1536 + 1024 + hc);
                if (v1) g1 = *(const u32x2*)(LO + (size_t)(row1_base + tok1) * 1536 + 1024 + hc);
                scan_stage_c(C, bufp, Yp, tt, dq, v0, g0, MIX + (size_t)(row2_base + tok0 - first_out) * 1024 + 512 + hc);
                scan_stage_c(C, bufp, Yp, tt + 16, dq, v1, g1, MIX + (size_t)(row2_base + tok1 - first_out) * 1024 + 512 + hc);
            }
            if (c0 + 32 + tt < nsteps) scan_stage_a(pa, C, BUF + ((c + 1) & 1) * SC_BUF, tt, dq, kdummy);
            if (c0 + 48 + tt < nsteps) scan_stage_a(pb, C, BUF + ((c + 1) & 1) * SC_BUF, tt + 16, dq, kdummy);
            if (c0 + 64 + tt < nsteps) scan_load(pa, RKV, LO, (size_t)(row1_base + c0 + 64 + tt), hc);
            if (c0 + 80 + tt < nsteps) scan_load(pb, RKV, LO, (size_t)(row1_base + c0 + 80 + tt), hc);
            if (hb0) bg_store(p, bg_unit, bgl0, bg0);
            if (hb1) bg_store(p, bg_unit, bgl1, bg1);
            __syncthreads();
        }
        {
            const int c = nch - 1, pc0 = c * 32, T = nsteps - pc0; const LAS float* bufp = BUF + (c & 1) * SC_BUF; const LAS float* Yp = Y + (c & 1) * 2048;
            const int tok0 = pc0 + tt, tok1 = pc0 + tt + 16;
            const bool v0 = tt < T && tok0 >= first_out, v1 = tt + 16 < T && tok1 >= first_out;
            u32x2 g0 = {0u, 0u}, g1 = {0u, 0u};
            if (v0) g0 = *(const u32x2*)(LO + (size_t)(row1_base + tok0) * 1536 + 1024 + hc);
            if (v1) g1 = *(const u32x2*)(LO + (size_t)(row1_base + tok1) * 1536 + 1024 + hc);
            scan_stage_c(C, bufp, Yp, tt, dq, v0, g0, MIX + (size_t)(row2_base + tok0 - first_out) * 1024 + 512 + hc);
            scan_stage_c(C, bufp, Yp, tt + 16, dq, v1, g1, MIX + (size_t)(row2_base + tok1 - first_out) * 1024 + 512 + hc);
        }
    }
}
__device__ __forceinline__ void phase_scan(const P& p, int wv, LAS unsigned char* lds) {
    for (int u = blockIdx.x; u < 512; u += gridDim.x) {
        const int uu = u & 255, b = uu >> 3, h = uu & 7;
        if (u < 256) scan_unit(p, wv, lds, b * LP, LP, nullptr, p.out + OFF_WKVP + (size_t)uu * 4096, NMETA, b * SEQ, h, uu);
        else scan_unit(p, wv, lds, MP + b * DSQ, DSQ, p.swkv + (size_t)uu * 4096, p.out + OFF_WKVS + (size_t)uu * 4096, 0, M2P + b * DSQ, h, -1);
    }
}

__device__ __forceinline__ int crow(int r, int hi) { return (r & 3) + 8 * (r >> 2) + 4 * hi; }
constexpr float ATT_THR = 12.0f;
__device__ __forceinline__ float xhalf_max(float v) { const auto rr = __builtin_amdgcn_permlane32_swap(__float_as_uint(v), __float_as_uint(v), false, false); return fmaxf(__uint_as_float(rr[0]), __uint_as_float(rr[1])); }
__device__ __forceinline__ float xhalf_sum(float v) { const auto rr = __builtin_amdgcn_permlane32_swap(__float_as_uint(v), __float_as_uint(v), false, false); return __uint_as_float(rr[0]) + __uint_as_float(rr[1]); }
__device__ __forceinline__ void att_blk(const LAS unsigned char* Kc, const LAS unsigned char* Vimg, const bf16x8 (&qf)[6], float& m, float& l, f32x16 (&O)[2], int lane, int nmask) {
    const int q = lane & 31, hi = lane >> 5;
    f32x16 s; const float nm = -m;
#pragma unroll
    for (int r = 0; r < 16; ++r) s[r] = nm;
#pragma unroll
    for (int i = 0; i < 6; ++i) { const bf16x8 kf = *(const LAS bf16x8*)(Kc + q * 208 + (16 * i + 8 * hi) * 2); s = __builtin_amdgcn_mfma_f32_32x32x16_bf16(kf, qf[i], s, 0, 0, 0); }
    if (nmask > 0) {
#pragma unroll
        for (int r = 0; r < 16; ++r) if (crow(r, hi) < nmask) s[r] = -1e30f; }
    float mx = fmaxf(s[0], s[1]);
#pragma unroll
    for (int r = 2; r < 16; r += 2) mx = fmaxf(fmaxf(mx, s[r]), s[r + 1]);
    if (__builtin_amdgcn_ballot_w64(mx > ATT_THR) != 0ull) {
        const float delta = fmaxf(xhalf_max(mx), 0.f), alpha = __builtin_amdgcn_exp2f(-delta);
        m += delta; l *= alpha;
#pragma unroll
        for (int r = 0; r < 16; ++r) { O[0][r] *= alpha; O[1][r] *= alpha; s[r] -= delta; }
    }
    float rsum = 0.f;
#pragma unroll
    for (int r = 0; r < 16; ++r) { s[r] = __builtin_amdgcn_exp2f(s[r]); rsum += s[r]; }
    l += rsum;
    bf16x8 pb[2];
#pragma unroll
    for (int i = 0; i < 2; ++i) { u32x4 w; w.x = pk2(s[8 * i + 0], s[8 * i + 1]); w.y = pk2(s[8 * i + 2], s[8 * i + 3]); w.z = pk2(s[8 * i + 4], s[8 * i + 5]); w.w = pk2(s[8 * i + 6], s[8 * i + 7]);
        pb[i] = __builtin_bit_cast(bf16x8, w); }
    typedef short v4i16_t __attribute__((ext_vector_type(4)));
    const int li = lane & 15, g16 = lane >> 4;
    const LAS unsigned char* vb = Vimg + (4 * hi + (li >> 2)) * 192 + (16 * (g16 & 1) + 4 * (li & 3)) * 2;
#pragma unroll
    for (int db = 0; db < 2; ++db)
#pragma unroll
        for (int i = 0; i < 2; ++i) {
            const v4i16_t lo = __builtin_amdgcn_ds_read_tr16_b64_v4i16((LAS v4i16_t*)(vb + (16 * i) * 192 + 64 * db));
            const v4i16_t hh = __builtin_amdgcn_ds_read_tr16_b64_v4i16((LAS v4i16_t*)(vb + (16 * i + 8) * 192 + 64 * db));
            const bf16x8 vf = {lo[0], lo[1], lo[2], lo[3], hh[0], hh[1], hh[2], hh[3]};
            O[db] = __builtin_amdgcn_mfma_f32_32x32x16_bf16(vf, pb[i], O[db], 0, 0, 0); }
}
__device__ __forceinline__ void att_tile64(const LAS unsigned char* Kc, const LAS unsigned char* Vimg, const bf16x8 (&qf)[6], float& m, float& l, f32x16 (&O)[2], int lane) {
    const int q = lane & 31, hi = lane >> 5;
    f32x16 s0, s1; const float nm = -m;
#pragma unroll
    for (int r = 0; r < 16; ++r) { s0[r] = nm; s1[r] = nm; }
#pragma unroll
    for (int i = 0; i < 6; ++i) {
        const bf16x8 k0 = *(const LAS bf16x8*)(Kc + q * 208 + (16 * i + 8 * hi) * 2), k1 = *(const LAS bf16x8*)(Kc + (32 + q) * 208 + (16 * i + 8 * hi) * 2);
        s0 = __builtin_amdgcn_mfma_f32_32x32x16_bf16(k0, qf[i], s0, 0, 0, 0); s1 = __builtin_amdgcn_mfma_f32_32x32x16_bf16(k1, qf[i], s1, 0, 0, 0); }
    float mx = fmaxf(s0[0], s1[0]);
#pragma unroll
    for (int r = 1; r < 16; ++r) mx = fmaxf(fmaxf(mx, s0[r]), s1[r]);
    if (__builtin_amdgcn_ballot_w64(mx > ATT_THR) != 0ull) {
        const float delta = fmaxf(xhalf_max(mx), 0.f), alpha = __builtin_amdgcn_exp2f(-delta);
        m += delta; l *= alpha;
#pragma unroll
        for (int r = 0; r < 16; ++r) { O[0][r] *= alpha; O[1][r] *= alpha; s0[r] -= delta; s1[r] -= delta; }
    }
    float rs0 = 0.f, rs1 = 0.f;
#pragma unroll
    for (int r = 0; r < 16; ++r) { s0[r] = __builtin_amdgcn_exp2f(s0[r]); s1[r] = __builtin_amdgcn_exp2f(s1[r]); rs0 += s0[r]; rs1 += s1[r]; }
    l += rs0 + rs1;
    bf16x8 pb[4];
#pragma unroll
    for (int i = 0; i < 2; ++i) { u32x4 w; w.x = pk2(s0[8 * i + 0], s0[8 * i + 1]); w.y = pk2(s0[8 * i + 2], s0[8 * i + 3]); w.z = pk2(s0[8 * i + 4], s0[8 * i + 5]); w.w = pk2(s0[8 * i + 6], s0[8 * i + 7]);
        pb[i] = __builtin_bit_cast(bf16x8, w);
        u32x4 x; x.x = pk2(s1[8 * i + 0], s1[8 * i + 1]); x.y = pk2(s1[8 * i + 2], s1[8 * i + 3]); x.z = pk2(s1[8 * i + 4], s1[8 * i + 5]); x.w = pk2(s1[8 * i + 6], s1[8 * i + 7]);
        pb[2 + i] = __builtin_bit_cast(bf16x8, x); }
    typedef short v4i16_t __attribute__((ext_vector_type(4)));
    const int li = lane & 15, g16 = lane >> 4;
    const LAS unsigned char* vb = Vimg + (4 * hi + (li >> 2)) * 192 + (16 * (g16 & 1) + 4 * (li & 3)) * 2;
#pragma unroll
    for (int i = 0; i < 4; ++i)
#pragma unroll
        for (int db = 0; db < 2; ++db) {
            const v4i16_t lo = __builtin_amdgcn_ds_read_tr16_b64_v4i16((LAS v4i16_t*)(vb + (16 * i) * 192 + 64 * db));
            const v4i16_t hh = __builtin_amdgcn_ds_read_tr16_b64_v4i16((LAS v4i16_t*)(vb + (16 * i + 8) * 192 + 64 * db));
            const bf16x8 vf = {lo[0], lo[1], lo[2], lo[3], hh[0], hh[1], hh[2], hh[3]};
            O[db] = __builtin_amdgcn_mfma_f32_32x32x16_bf16(vf, pb[i], O[db], 0, 0, 0); }
}
__device__ __forceinline__ int kpos(int key) { return (key & ~12) | ((key & 4) << 1) | ((key & 8) >> 1); }

__device__ __forceinline__ void load_q(bf16x8 (&qf)[6], const bf16_t* qrow, float pos, const float* gn, const float* gr, const float* gkn, int hi) {
    float x[6][8];
#pragma unroll
    for (int i = 0; i < 6; ++i) { const u32x4 raw = *(const u32x4*)(qrow + 16 * i + 8 * hi);
        x[i][0] = bflo(raw.x); x[i][1] = bfhi(raw.x); x[i][2] = bflo(raw.y); x[i][3] = bfhi(raw.y); x[i][4] = bflo(raw.z); x[i][5] = bfhi(raw.z); x[i][6] = bflo(raw.w); x[i][7] = bfhi(raw.w); }
    float ssn = 0.f, ssr = 0.f;
#pragma unroll
    for (int i = 0; i < 4; ++i)
#pragma unroll
        for (int e = 0; e < 8; ++e) ssn += x[i][e] * x[i][e];
#pragma unroll
    for (int i = 4; i < 6; ++i)
#pragma unroll
        for (int e = 0; e < 8; ++e) ssr += x[i][e] * x[i][e];
    ssn += __shfl_xor(ssn, 32); ssr += __shfl_xor(ssr, 32);
    const float rsn = rsqrtf(ssn * (1.0f / 64.0f) + EPS) * QSCALE, rsr = rsqrtf(ssr * (1.0f / 32.0f) + EPS) * QSCALE;
#pragma unroll
    for (int i = 0; i < 4; ++i) { float o[8];
#pragma unroll
        for (int e = 0; e < 8; ++e) o[e] = x[i][e] * rsn * (gn[16 * i + 8 * hi + e] * gkn[16 * i + 8 * hi + e]);
        u32x4 w; w.x = pk2(o[0], o[1]); w.y = pk2(o[2], o[3]); w.z = pk2(o[4], o[5]); w.w = pk2(o[6], o[7]); qf[i] = __builtin_bit_cast(bf16x8, w); }
    float o1[8], o2[8];
#pragma unroll
    for (int e = 0; e < 8; ++e) { const int j = 8 * hi + e; float c, s; rope_cs(pos, j, c, s);
        const float x1 = x[4][e] * rsr * gr[j], x2 = x[5][e] * rsr * gr[16 + j];
        o1[e] = x1 * c - x2 * s; o2[e] = x1 * s + x2 * c; }
    { u32x4 w; w.x = pk2(o1[0], o1[1]); w.y = pk2(o1[2], o1[3]); w.z = pk2(o1[4], o1[5]); w.w = pk2(o1[6], o1[7]); qf[4] = __builtin_bit_cast(bf16x8, w); }
    { u32x4 w; w.x = pk2(o2[0], o2[1]); w.y = pk2(o2[2], o2[3]); w.z = pk2(o2[4], o2[5]); w.w = pk2(o2[6], o2[7]); qf[5] = __builtin_bit_cast(bf16x8, w); }
}

constexpr int AT_KB = 64 * 208, AT_VB = 64 * 192, AT_BUF = AT_KB + AT_VB;
__device__ __forceinline__ void attn_prompt_unit(const P& p, int wv, LAS unsigned char* lds, int b, int h) {
    const int tid_l = wv * 64 + lane_id(); const int tid = tid_l, lane = tid & 63, w = tid >> 6, q = lane & 31, hi = lane >> 5;
    const bf16_t* Qb = (const bf16_t*)(p.ws + WS_Q); const bf16_t* KN = (const bf16_t*)(p.ws + WS_KN); const bf16_t* Vb = (const bf16_t*)(p.ws + WS_V);
    const bf16_t* KR = (const bf16_t*)(p.ws + WS_KRALL); bf16_t* ATT = (bf16_t*)(p.ws + WS_ATT);
    const int key = tid >> 3, part = tid & 7, key2 = tid >> 2, part2 = tid & 3;
    const size_t rowk_b = (size_t)b * KPB;
    for (int qt = 0; qt < 8; ++qt) {
        const size_t row1 = (size_t)b * LP + NMETA + 256 * qt + 32 * w + q;
        bf16x8 qf[6];
        load_q(qf, Qb + row1 * 768 + h * 96, (float)(NMETA + 256 * qt + 32 * w + q), p.g_qn, p.g_qr, p.g_kn, hi);
        const int cmax = 4 * qt + (w >> 1) + 1, ntile = 4 * qt + 5;
        float m = 0.f, l = 0.f; f32x16 O[2];
#pragma unroll
        for (int r = 0; r < 16; ++r) { O[0][r] = 0.f; O[1][r] = 0.f; }
        u32x4 rkn0, rkr0, rv0, rkn1, rkr1, rv1;
        rkr0 = rkr1 = (u32x4){0u, 0u, 0u, 0u};
#define AT_LOAD(S, JT) do { const size_t rk_ = rowk_b + 64 * (size_t)(JT); \
            rkn##S = *(const u32x4*)(KN + (rk_ + key) * 512 + h * 64 + 8 * part); rv##S = *(const u32x4*)(Vb + (rk_ + key) * 512 + h * 64 + 8 * part); \
            if (tid < 256) rkr##S = *(const u32x4*)(KR + (rk_ + key2) * 32 + 8 * part2); } while (0)
#define AT_STAGE(S, BUFI) do { LAS unsigned char* Kc_ = lds + (BUFI) * AT_BUF; LAS unsigned char* VT_ = Kc_ + AT_KB; \
            *(LAS u32x4*)(Kc_ + key * 208 + part * 16) = rkn##S; if (tid < 256) *(LAS u32x4*)(Kc_ + key2 * 208 + 128 + part2 * 16) = rkr##S; \
            *(LAS u32x4*)(VT_ + key * 192 + part * 16) = rv##S; } while (0)
#define AT_COMPUTE(JT, BUFI) do { if ((JT) <= cmax) { const LAS unsigned char* Kc_ = lds + (BUFI) * AT_BUF; const LAS unsigned char* VT_ = Kc_ + AT_KB; \
            if ((JT) > 0) att_tile64(Kc_, VT_, qf, m, l, O, lane); else att_blk(Kc_ + 32 * 208, VT_ + 32 * 192, qf, m, l, O, lane, 16); } } while (0)
        AT_LOAD(0, 0); AT_LOAD(1, 1);
        for (int jt = 0; jt < ntile; jt += 2) {
            AT_STAGE(0, 0);
            if (jt + 2 < ntile) AT_LOAD(0, jt + 2);
            __syncthreads();
            AT_COMPUTE(jt, 0);
            if (jt + 1 < ntile) {
                AT_STAGE(1, 1);
                if (jt + 3 < ntile) AT_LOAD(1, jt + 3);
                __syncthreads();
                AT_COMPUTE(jt + 1, 1);
            }
        }
#undef AT_LOAD
#undef AT_STAGE
#undef AT_COMPUTE
        __syncthreads();
        const float il = 1.0f / xhalf_sum(l);
        const size_t row2 = (size_t)b * SEQ + 256 * qt + 32 * w + q;
#pragma unroll
        for (int db = 0; db < 2; ++db)
#pragma unroll
            for (int rg = 0; rg < 4; ++rg) { u32x2 wv; wv.x = pk2(O[db][4 * rg] * il, O[db][4 * rg + 1] * il); wv.y = pk2(O[db][4 * rg + 2] * il, O[db][4 * rg + 3] * il);
                *(u32x2*)(ATT + row2 * 512 + h * 64 + 32 * db + 8 * rg + 4 * hi) = wv; }
    }
}
typedef __bf16 bf16x2_cv __attribute__((ext_vector_type(2)));
__device__ __forceinline__ unsigned pk2c(float lo, float hi) { const f32x2 v = {lo, hi}; const bf16x2_cv b = __builtin_convertvector(v, bf16x2_cv); return __builtin_bit_cast(unsigned, b); }
constexpr int AS_WIMG = 128 * 272;
constexpr int AS_KB = 32 * 208, AS_VB = 32 * 192, AS_WB = AS_KB + AS_VB;
__device__ __forceinline__ void attn_sample_unit(const P& p, int wv, LAS unsigned char* lds, int b, int h) {
    const int tid_l = wv * 64 + lane_id(); const int tid = tid_l, lane = tid & 63, w = tid >> 6, q = lane & 31, hi = lane >> 5;
    const bf16_t* Qb = (const bf16_t*)(p.ws + WS_Q); const bf16_t* CA = (const bf16_t*)(p.ws + WS_CALL); const bf16_t* WKV = (const bf16_t*)(p.ws + WS_WKV);
    const bf16_t* KR = (const bf16_t*)(p.ws + WS_KRALL); bf16_t* ATT = (bf16_t*)(p.ws + WS_ATT);
    for (int e = tid; e < 128 * 16; e += 512) { const int j = e >> 4, ch = e & 15, d = j & 63, slot = (j < 64) ? h : 8 + h;
        const int prow = 256 * (slot >> 2) + 128 * (d >> 5) + 32 * (slot & 3) + (d & 31);
        *(LAS u32x4*)(lds + j * 272 + ch * 16) = *(const u32x4*)(WKV + (size_t)prow * 128 + 8 * ch); }
    const size_t row1 = (size_t)MP + b * DSQ + q;
    bf16x8 qf[6];
    load_q(qf, Qb + row1 * 768 + h * 96, (float)(PAST + q), p.g_qn, p.g_qr, p.g_kn, hi);
    float m = 0.f, l = 0.f; f32x16 O[2];
#pragma unroll
    for (int r = 0; r < 16; ++r) { O[0][r] = 0.f; O[1][r] = 0.f; }
    LAS unsigned char* Kc = lds + AS_WIMG + w * AS_WB; LAS unsigned char* VT = Kc + AS_KB;
    const size_t rowk_b = (size_t)MKP + (size_t)b * KSAMP;
    __syncthreads();
    bf16x8 cf[8]; u32x4 rr2[2];
#define AS_LOAD(JT) do { const size_t rk_ = rowk_b + 32 * (size_t)(JT); \
        _Pragma("unroll") for (int i = 0; i < 8; ++i) cf[i] = *(const bf16x8*)(CA + (rk_ + q) * 128 + 16 * i + 8 * hi); \
        _Pragma("unroll") for (int n = 0; n < 2; ++n) { const int key = (lane >> 2) + 16 * n, part = lane & 3; rr2[n] = *(const u32x4*)(KR + (rk_ + key) * 32 + 8 * part); } } while (0)
    AS_LOAD(w);
    for (int jt = w; jt < 129; jt += 8) {
#pragma unroll
        for (int n = 0; n < 2; ++n) { const int key = (lane >> 2) + 16 * n, part = lane & 3; *(LAS u32x4*)(Kc + key * 208 + 128 + part * 16) = rr2[n]; }
        {
            f32x16 k0, k1;
#pragma unroll
            for (int r = 0; r < 16; ++r) { k0[r] = 0.f; k1[r] = 0.f; }
#pragma unroll
            for (int i = 0; i < 8; ++i) {
                const bf16x8 w0 = *(const LAS bf16x8*)(lds + q * 272 + (16 * i + 8 * hi) * 2), w1 = *(const LAS bf16x8*)(lds + (32 + q) * 272 + (16 * i + 8 * hi) * 2);
                k0 = __builtin_amdgcn_mfma_f32_32x32x16_bf16(w0, cf[i], k0, 0, 0, 0); k1 = __builtin_amdgcn_mfma_f32_32x32x16_bf16(w1, cf[i], k1, 0, 0, 0); }
            float ss = 0.f;
#pragma unroll
            for (int r = 0; r < 16; ++r) ss += k0[r] * k0[r] + k1[r] * k1[r];
            const float rs = rsqrtf(xhalf_sum(ss) * (1.0f / 64.0f) + EPS);
#pragma unroll
            for (int rg = 0; rg < 4; ++rg) {
                u32x2 a; a.x = pk2c(k0[4 * rg] * rs, k0[4 * rg + 1] * rs); a.y = pk2c(k0[4 * rg + 2] * rs, k0[4 * rg + 3] * rs);
                *(LAS u32x2*)(Kc + q * 208 + (8 * rg + 4 * hi) * 2) = a;
                u32x2 c; c.x = pk2c(k1[4 * rg] * rs, k1[4 * rg + 1] * rs); c.y = pk2c(k1[4 * rg + 2] * rs, k1[4 * rg + 3] * rs);
                *(LAS u32x2*)(Kc + q * 208 + (32 + 8 * rg + 4 * hi) * 2) = c; }
        }
        {
            f32x16 v0, v1;
#pragma unroll
            for (int r = 0; r < 16; ++r) { v0[r] = 0.f; v1[r] = 0.f; }
#pragma unroll
            for (int i = 0; i < 8; ++i) {
                const bf16x8 w0 = *(const LAS bf16x8*)(lds + (64 + q) * 272 + (16 * i + 8 * hi) * 2), w1 = *(const LAS bf16x8*)(lds + (96 + q) * 272 + (16 * i + 8 * hi) * 2);
                v0 = __builtin_amdgcn_mfma_f32_32x32x16_bf16(w0, cf[i], v0, 0, 0, 0); v1 = __builtin_amdgcn_mfma_f32_32x32x16_bf16(w1, cf[i], v1, 0, 0, 0); }
#pragma unroll
            for (int rg = 0; rg < 4; ++rg) {
                u32x2 a; a.x = pk2c(v0[4 * rg], v0[4 * rg + 1]); a.y = pk2c(v0[4 * rg + 2], v0[4 * rg + 3]);
                *(LAS u32x2*)(VT + q * 192 + (8 * rg + 4 * hi) * 2) = a;
                u32x2 c; c.x = pk2c(v1[4 * rg], v1[4 * rg + 1]); c.y = pk2c(v1[4 * rg + 2], v1[4 * rg + 3]);
                *(LAS u32x2*)(VT + q * 192 + (32 + 8 * rg + 4 * hi) * 2) = c; }
        }
        if (jt + 8 < 129) AS_LOAD(jt + 8);
        asm volatile("" ::: "memory"); __builtin_amdgcn_wave_barrier();
        att_blk(Kc, VT, qf, m, l, O, lane, 0);
        asm volatile("" ::: "memory"); __builtin_amdgcn_wave_barrier();
    }
#undef AS_LOAD
    __syncthreads();
    LAS float* Ox = (LAS float*)lds;
    LAS float* Mx = (LAS float*)(lds + 65536);
    LAS float* Lx = Mx + 256;
#pragma unroll
    for (int db = 0; db < 2; ++db)
#pragma unroll
        for (int r = 0; r < 16; ++r) Ox[(w * 64 + 32 * db + crow(r, hi)) * 32 + q] = O[db][r];
    { const float lt = xhalf_sum(l); if (hi == 0) { Mx[w * 32 + q] = m; Lx[w * 32 + q] = lt; } }
    __syncthreads();
    {
        const int qq = tid & 31, dg = tid >> 5;
        float M = -3e30f;
#pragma unroll
        for (int ww = 0; ww < 8; ++ww) M = fmaxf(M, Mx[ww * 32 + qq]);
        float L = 0.f, o[4] = {0.f, 0.f, 0.f, 0.f};
#pragma unroll
        for (int ww = 0; ww < 8; ++ww) { const float sc = __builtin_amdgcn_exp2f(Mx[ww * 32 + qq] - M); L += Lx[ww * 32 + qq] * sc;
#pragma unroll
            for (int e = 0; e < 4; ++e) o[e] += Ox[(ww * 64 + 4 * dg + e) * 32 + qq] * sc; }
        const float il = 1.0f / L;
        u32x2 wv; wv.x = pk2(o[0] * il, o[1] * il); wv.y = pk2(o[2] * il, o[3] * il);
        *(u32x2*)(ATT + ((size_t)M2P + b * DSQ + qq) * 512 + h * 64 + 4 * dg) = wv;
    }
    __syncthreads();
}
__device__ __forceinline__ void phase_attn(const P& p, int wv, LAS unsigned char* lds) {
    for (int u = blockIdx.x; u < 256; u += gridDim.x) attn_prompt_unit(p, wv, lds, u >> 3, u & 7);
    for (int u = blockIdx.x; u < 256; u += gridDim.x) attn_sample_unit(p, wv, lds, u >> 3, u & 7);
}

__device__ __forceinline__ void phase_e2(const P& p, int wv) {
    const int tid_l = wv * 64 + lane_id(); const int lane = tid_l & 63, wave = tid_l >> 6;
    const bf16_t* ATT = (const bf16_t*)(p.ws + WS_ATT); bf16_t* MIX = (bf16_t*)(p.ws + WS_MIX);
    const f32x4 g0 = *(const f32x4*)(p.g_ao + 8 * lane), g1 = *(const f32x4*)(p.g_ao + 8 * lane + 4);
    const int stride = gridDim.x * 8;
    for (int row0 = blockIdx.x * 8 + wave; row0 < M2; row0 += 4 * stride) {
        u32x4 raw[4];
#pragma unroll
        for (int u = 0; u < 4; ++u) { const int row = row0 + u * stride; raw[u] = *(const u32x4*)(ATT + (size_t)(row < M2 ? row : row0) * 512 + 8 * lane); }
#pragma unroll
        for (int u = 0; u < 4; ++u) { const int row = row0 + u * stride;
            const f32x4 a = {bflo(raw[u].x), bfhi(raw[u].x), bflo(raw[u].y), bfhi(raw[u].y)}, c = {bflo(raw[u].z), bfhi(raw[u].z), bflo(raw[u].w), bfhi(raw[u].w)};
            const float ss = (a[0] * a[0] + a[1] * a[1]) + (a[2] * a[2] + a[3] * a[3]) + (c[0] * c[0] + c[1] * c[1]) + (c[2] * c[2] + c[3] * c[3]);
            const float rs = rsqrtf(wave_sum(ss) * (1.0f / 512.0f) + EPS);
            const f32x4 o0 = a * g0 * rs, o1 = c * g1 * rs;
            u32x4 w; w.x = pk2(o0[0], o0[1]); w.y = pk2(o0[2], o0[3]); w.z = pk2(o1[0], o1[1]); w.w = pk2(o1[2], o1[3]);
            if (row < M2) *(u32x4*)(MIX + (size_t)row * 1024 + 8 * lane) = w; }
    }
}
__device__ __forceinline__ void phase_e3(const P& p, int wv) {
    const int tid_l = wv * 64 + lane_id(); const int lane = tid_l & 63, wave = tid_l >> 6;
    const bf16_t* H = (const bf16_t*)(p.ws + WS_H); bf16_t* U = (bf16_t*)(p.ws + WS_U);
    f32x4 g[4];
#pragma unroll
    for (int j = 0; j < 4; ++j) g[j] = *(const f32x4*)(p.g_ffn + 4 * lane + 256 * j);
    const int stride = gridDim.x * 8;
    for (int row = blockIdx.x * 8 + wave; row < M2P; row += 2 * stride) {
        const int rowb = row + stride; const bool hb = rowb < M2P; const int rb = hb ? rowb : row;
        f32x4 va[4], vb[4]; float ssa = 0.f, ssb = 0.f;
#pragma unroll
        for (int j = 0; j < 4; ++j) { const u32x2 ra_ = *(const u32x2*)(H + (size_t)row * 1024 + 4 * lane + 256 * j), rb_ = *(const u32x2*)(H + (size_t)rb * 1024 + 4 * lane + 256 * j);
            va[j] = (f32x4){bflo(ra_.x), bfhi(ra_.x), bflo(ra_.y), bfhi(ra_.y)}; vb[j] = (f32x4){bflo(rb_.x), bfhi(rb_.x), bflo(rb_.y), bfhi(rb_.y)}; }
#pragma unroll
        for (int j = 0; j < 4; ++j) { ssa += (va[j][0] * va[j][0] + va[j][1] * va[j][1]) + (va[j][2] * va[j][2] + va[j][3] * va[j][3]);
                                      ssb += (vb[j][0] * vb[j][0] + vb[j][1] * vb[j][1]) + (vb[j][2] * vb[j][2] + vb[j][3] * vb[j][3]); }
        const float rsa = rsqrtf(wave_sum(ssa) * (1.0f / 1024.0f) + EPS), rsb = rsqrtf(wave_sum(ssb) * (1.0f / 1024.0f) + EPS);
#pragma unroll
        for (int j = 0; j < 4; ++j) { const f32x4 o = va[j] * g[j] * rsa; u32x2 w; w.x = pk2(o[0], o[1]); w.y = pk2(o[2], o[3]);
            *(u32x2*)(U + (size_t)row * 1024 + 4 * lane + 256 * j) = w; }
        if (hb) {
#pragma unroll
            for (int j = 0; j < 4; ++j) { const f32x4 o = vb[j] * g[j] * rsb; u32x2 w; w.x = pk2(o[0], o[1]); w.y = pk2(o[2], o[3]);
                *(u32x2*)(U + (size_t)rowb * 1024 + 4 * lane + 256 * j) = w; } }
    }
    { const float* PB = (const float*)(p.ws + WS_PB5); float* Hw = (float*)(p.ws + WS_HS);
      for (int r = blockIdx.x * 8 + wave; r < MS; r += stride) {
          f32x4 v[4]; float ss = 0.f;
#pragma unroll
          for (int j = 0; j < 4; ++j) { const size_t o = (size_t)r * 1024 + 4 * lane + 256 * j;
              v[j] = (*(const f32x4*)(PB + o) + *(const f32x4*)(PB + 1048576 + o)) + (*(const f32x4*)(PB + 2 * 1048576 + o) + *(const f32x4*)(PB + 3 * 1048576 + o)) + *(const f32x4*)(p.xs + o);
              *(f32x4*)(Hw + (size_t)r * 1024 + 4 * lane + 256 * j) = v[j];
              ss += (v[j][0] * v[j][0] + v[j][1] * v[j][1]) + (v[j][2] * v[j][2] + v[j][3] * v[j][3]); }
          const float rs = rsqrtf(wave_sum(ss) * (1.0f / 1024.0f) + EPS);
#pragma unroll
          for (int j = 0; j < 4; ++j) { const f32x4 o = v[j] * g[j] * rs; u32x2 w; w.x = pk2(o[0], o[1]); w.y = pk2(o[2], o[3]);
              *(u32x2*)(U + (size_t)(M2P + r) * 1024 + 4 * lane + 256 * j) = w; }
      } }
}

#define XB_TMO      128
#define XB_XCNT(j)  (256  + 64 * (j))
#define XB_XSUB(j)  (1280 + 64 * (j))
#define XB_XGEN(j)  (2304 + 64 * (j))
#define XB_TOP      3328
#define XB_TOPGEN   3392
#define XCD_BAR_WORDS 3456
#define XB_SPIN_CAP (1u << 18)

__device__ __forceinline__ unsigned xb_ld(unsigned* p)              { return __hip_atomic_load(p, __ATOMIC_RELAXED, __HIP_MEMORY_SCOPE_AGENT); }
__device__ __forceinline__ unsigned xb_add(unsigned* p, unsigned v) { return __hip_atomic_fetch_add(p, v, __ATOMIC_RELAXED, __HIP_MEMORY_SCOPE_AGENT); }
__device__ __forceinline__ unsigned xb_xcc_id() { return (unsigned)__builtin_amdgcn_s_getreg((3 << 11) | 20) & 0xFu; }
#define XB_SPIN(cond, bar) do { unsigned _sp = 0; while (cond) { __builtin_amdgcn_s_sleep(1); \
    if ((++_sp & 255u) == 0u) { if (xb_ld(&(bar)[XB_TMO])) break; if (_sp > XB_SPIN_CAP) { atomicAdd(&(bar)[XB_TMO], 1u); break; } } } } while (0)

struct XcdBarrier {
    int wv;
    unsigned* bar; unsigned x;
    volatile LAS unsigned* st;
};

__device__ __forceinline__ XcdBarrier xcd_barrier_post(unsigned* bar, volatile LAS unsigned* st) {
    XcdBarrier b; b.wv = 0; b.bar = bar; b.x = xb_xcc_id(); b.st = st;
    if (threadIdx.x == 0) (void)xb_add(&bar[XB_XCNT(b.x)], 1u);
    return b;
}
__device__ __forceinline__ void xcd_barrier_complete(unsigned* bar, unsigned x, unsigned& nloc, unsigned& nx) {
    const unsigned G = gridDim.x * gridDim.y * gridDim.z;
    unsigned sum, cnt, mine, sp = 0u;
    for (;;) {
        sum = 0u; cnt = 0u; mine = 0u;
#pragma unroll
        for (unsigned j = 0; j < 16; ++j) { const unsigned c = xb_ld(&bar[XB_XCNT(j)]); sum += c; cnt += (c > 0u) ? 1u : 0u; mine = (j == x) ? c : mine; }
        if (sum == G) break;
        __builtin_amdgcn_s_sleep(1);
        if ((++sp & 255u) == 0u) { if (xb_ld(&bar[XB_TMO])) break; if (sp > XB_SPIN_CAP) { atomicAdd(&bar[XB_TMO], 1u); break; } }
    }
    nloc = mine > 0u ? mine : 1u; nx = cnt > 0u ? cnt : 1u;
}

__device__ __forceinline__ void xcd_barrier(const XcdBarrier& b) {
    asm volatile("s_waitcnt vmcnt(0)" ::: "memory");
    __syncthreads();
    if (b.wv == 0 && lane_id() == 0) {
        unsigned* bar = b.bar;
        __builtin_amdgcn_s_waitcnt(0);
        unsigned nloc = b.st[0], nx = b.st[1];
        if (nloc == 0u) { xcd_barrier_complete(bar, b.x, nloc, nx); b.st[0] = nloc; b.st[1] = nx; }
        const unsigned old = xb_add(&bar[XB_XSUB(b.x)], 1u);
        const unsigned gen = old / nloc;
        if (old + 1u == (gen + 1u) * nloc) {
            __builtin_amdgcn_fence(__ATOMIC_RELEASE, "agent");
            asm volatile("s_waitcnt vmcnt(0)" ::: "memory");
            const unsigned og = xb_add(&bar[XB_TOP], 1u);
            const unsigned tg = og / nx;
            if (og + 1u == (tg + 1u) * nx) xb_add(&bar[XB_TOPGEN], 1u);
            else XB_SPIN(xb_ld(&bar[XB_TOPGEN]) == tg, bar);
            __builtin_amdgcn_fence(__ATOMIC_ACQUIRE, "agent");
            xb_add(&bar[XB_XGEN(b.x)], 1u);
            asm volatile("s_waitcnt vmcnt(0)" ::: "memory");
        } else {
            XB_SPIN(xb_ld(&bar[XB_XGEN(b.x)]) == gen, bar);
            __builtin_amdgcn_fence(__ATOMIC_ACQUIRE, "agent");
            asm volatile("s_waitcnt vmcnt(0)" ::: "memory");
        }
    }
    __syncthreads();
}

template <class Epi> __device__ __forceinline__ void run_gemm(int wv, LAS unsigned char* lds, const bf16_t* A, const bf16_t* Bt, int M, int N, int K, const Epi& E) {
    pg8::Gemm g{A, Bt, M, N, K, K, wv}; pg8::StaticOrder S; S.init(M, N, (int)gridDim.x, (int)blockIdx.x);
    pg8::gemm_phase<Epi, pg8::StaticOrder, true, true>(lds, g, S, E);
}

#ifndef PH_MASK
#define PH_MASK 0xFFFF
#endif
#ifndef PH_TWICE
#define PH_TWICE 0
#ifndef EXTRA_SYNCS
#define EXTRA_SYNCS 0
#endif
#endif
__device__ __forceinline__ void run_gemm_split(int wv, LAS unsigned char* lds, const bf16_t* A, const bf16_t* Bt, int N, int K, int Kc, int pm0, int npm, const pg8::EpiPartial& E) {
    pg8::Gemm g{A, Bt, 0, N, K, Kc, wv}; pg8::SplitOrder S{pm0, npm, N / 256, K / Kc, (int)gridDim.x, (int)blockIdx.x};
    pg8::gemm_phase<pg8::EpiPartial, pg8::SplitOrder, true, true, true>(lds, g, S, E);
}
__global__ void __launch_bounds__(512, 2) hymba_fwd(P p) {
    extern __shared__ __attribute__((aligned(16))) unsigned char lds_raw[];
    LAS unsigned char* lds = (LAS unsigned char*)lds_raw;
    cg::grid_group grid = cg::this_grid();
    unsigned char* ws = p.ws;
    volatile LAS unsigned* bst = (volatile LAS unsigned*)(lds + LDS_BYTES - 64);
    if (threadIdx.x < 16) bst[threadIdx.x] = 0u;
    __syncthreads();
    XcdBarrier xbar = xcd_barrier_post((unsigned*)(ws + WS_CTL), bst);
    const int wv = __builtin_amdgcn_readfirstlane((int)(threadIdx.x >> 6)); xbar.wv = wv;
#define GBAR() xcd_barrier(xbar)
    if (PH_MASK & 1) phase_e0(p, wv, lds);
    if (PH_TWICE & 1) { __syncthreads(); phase_e0(p, wv, lds); }
    if (p.ws == nullptr) grid.sync();
    GBAR();
    if (PH_MASK & 2) { pg8::EpiStore E{(bf16_t*)(ws + WS_PROJ), NPROJ}; run_gemm(wv, lds, (const bf16_t*)(ws + WS_XN), (const bf16_t*)(ws + WS_WIN), M1, NPROJ, 1024, E); }
    if (PH_TWICE & 2) { pg8::EpiStore E{(bf16_t*)(ws + WS_PROJ), NPROJ}; run_gemm(wv, lds, (const bf16_t*)(ws + WS_XN), (const bf16_t*)(ws + WS_WIN), M1, NPROJ, 1024, E); }
    GBAR();
    for (int es = 0; es < EXTRA_SYNCS; ++es) GBAR();
    if (PH_MASK & 4) phase_e1(p, wv);
    if (PH_TWICE & 4) phase_e1(p, wv);
    GBAR();
    if (PH_MASK & 16) { pg8::EpiStore E{(bf16_t*)(ws + WS_E), 1536}; run_gemm(wv, lds, (const bf16_t*)(ws + WS_LIN), (const bf16_t*)(ws + WS_WL), M1, 1536, 256, E); }
    if (PH_TWICE & 16) { pg8::EpiStore E{(bf16_t*)(ws + WS_E), 1536}; run_gemm(wv, lds, (const bf16_t*)(ws + WS_LIN), (const bf16_t*)(ws + WS_WL), M1, 1536, 256, E); }
    GBAR();
    if (PH_MASK & 32) phase_scan(p, wv, lds);
    if (PH_TWICE & 32) phase_scan(p, wv, lds);
    GBAR();
    if (PH_MASK & 8) { pg8::EpiStore E{(bf16_t*)(ws + WS_Q), 768}; run_gemm(wv, lds, (const bf16_t*)(ws + WS_QL), (const bf16_t*)(ws + WS_WQ), M1, 768, 256, E); }
    if (PH_TWICE & 8) { pg8::EpiStore E{(bf16_t*)(ws + WS_Q), 768}; run_gemm(wv, lds, (const bf16_t*)(ws + WS_QL), (const bf16_t*)(ws + WS_WQ), M1, 768, 256, E); }
    if (PH_MASK & 64) { pg8::EpiKV E{(bf16_t*)(ws + WS_KN), (bf16_t*)(ws + WS_V), p.g_kn}; run_gemm(wv, lds, (const bf16_t*)(ws + WS_CALL), (const bf16_t*)(ws + WS_WKV), MKP, 1024, 128, E); }
    if (PH_TWICE & 64) { pg8::EpiKV E{(bf16_t*)(ws + WS_KN), (bf16_t*)(ws + WS_V), p.g_kn}; run_gemm(wv, lds, (const bf16_t*)(ws + WS_CALL), (const bf16_t*)(ws + WS_WKV), MKP, 1024, 128, E); }
    GBAR();
    if (PH_MASK & 128) phase_attn(p, wv, lds);
    if (PH_TWICE & 128) phase_attn(p, wv, lds);
    GBAR();
    if (PH_MASK & 256) phase_e2(p, wv);
    if (PH_TWICE & 256) phase_e2(p, wv);
    GBAR();
    if (PH_MASK & 512) { pg8::EpiResToB16 E{(bf16_t*)(ws + WS_H), p.xp}; run_gemm(wv, lds, (const bf16_t*)(ws + WS_MIX), (const bf16_t*)(ws + WS_WOUT), M2P, 1024, 1024, E);
        pg8::EpiPartial E2{(float*)(ws + WS_PB5), M2P}; run_gemm_split(wv, lds, (const bf16_t*)(ws + WS_MIX), (const bf16_t*)(ws + WS_WOUT), 1024, 1024, 256, M2P / 256, MS / 256, E2); }
    GBAR();
    if (PH_MASK & 1024) phase_e3(p, wv);
    if (PH_TWICE & 1024) phase_e3(p, wv);
    GBAR();
    if (PH_MASK & 2048) { pg8::EpiSwiglu E{(bf16_t*)(ws + WS_ACT)}; run_gemm(wv, lds, (const bf16_t*)(ws + WS_U), (const bf16_t*)(ws + WS_WGU), M2, 2 * DFF, 1024, E); }
    if (PH_TWICE & 2048) { pg8::EpiSwiglu E{(bf16_t*)(ws + WS_ACT)}; run_gemm(wv, lds, (const bf16_t*)(ws + WS_U), (const bf16_t*)(ws + WS_WGU), M2, 2 * DFF, 1024, E); }
    GBAR();
    if (PH_MASK & 4096) { pg8::EpiOutFromB16 E{p.out, (const bf16_t*)(ws + WS_H)}; run_gemm(wv, lds, (const bf16_t*)(ws + WS_ACT), (const bf16_t*)(ws + WS_WDN), M2P, 1024, DFF, E);
        pg8::EpiPartial E2{(float*)(ws + WS_PB7), M2P}; run_gemm_split(wv, lds, (const bf16_t*)(ws + WS_ACT), (const bf16_t*)(ws + WS_WDN), 1024, DFF, 256, M2P / 256, MS / 256, E2); }
    GBAR();
    {
        const float* PB = (const float*)(ws + WS_PB7); float* ys = p.out + OFF_YS;
        const int tid_l = wv * 64 + lane_id();
        for (size_t e = (size_t)blockIdx.x * 512 + tid_l; e < (size_t)MS * 1024 / 4; e += (size_t)gridDim.x * 512) {
            f32x4 a = *(const f32x4*)(PB + 4 * e) + *(const f32x4*)((const float*)(ws + WS_HS) + 4 * e);
#pragma unroll
            for (int kc = 1; kc < 11; ++kc) a += *(const f32x4*)(PB + (size_t)kc * 1048576 + 4 * e);
            *(f32x4*)(ys + 4 * e) = a; }
    }
}

extern "C" void kernel_launch(void* const* d_in, const int* in_sizes, int n_in, void* d_out, int out_size, void* d_ws, size_t ws_size, hipStream_t stream) {
    static int grid_blocks = 0;
    if (grid_blocks == 0) {
        if (n_in != 34 || ws_size < WS_NEED) { fprintf(stderr, "kernel_launch: unexpected n_in %d / ws_size %zu\n", n_in, ws_size); grid_blocks = -1; return; }
        int dev = 0, cus = 0, per_cu = 0;
        hipGetDevice(&dev);
        hipDeviceGetAttribute(&cus, hipDeviceAttributeMultiprocessorCount, dev);
        if (hipFuncSetAttribute((const void*)hymba_fwd, hipFuncAttributeMaxDynamicSharedMemorySize, LDS_BYTES) != hipSuccess) { fprintf(stderr, "kernel_launch: hipFuncSetAttribute failed\n"); }
        if (hipOccupancyMaxActiveBlocksPerMultiprocessor(&per_cu, (const void*)hymba_fwd, 512, LDS_BYTES) != hipSuccess || per_cu < 1) per_cu = 1;
        (void)hipGetLastError();
        if (per_cu > 1) per_cu = 1;
        grid_blocks = cus * per_cu;
    }
    if (grid_blocks < 0) return;
    P p{};
    const float** f = (const float**)&p;
    for (int i = 0; i < 34; ++i) f[i] = (const float*)d_in[i];
    p.out = (float*)d_out; p.ws = (unsigned char*)d_ws;
    (void)hipMemsetAsync((char*)d_ws + WS_CTL, 0, 16384, stream);
    void* args[] = {&p};
    hipError_t e = hipLaunchCooperativeKernel((const void*)hymba_fwd, dim3(grid_blocks), dim3(512), args, LDS_BYTES, stream);
    if (e != hipSuccess) fprintf(stderr, "cooperative launch failed: %s (grid %d)\n", hipGetErrorString(e), grid_blocks);
}
```

```cpp
#include <hip/hip_runtime.h>
#include <hip/hip_cooperative_groups.h>
#include <cstdio>
#include <cstdint>
namespace cg = cooperative_groups;

namespace pg8 {
#define PG8_LAS __attribute__((address_space(3)))
typedef unsigned short bf16_t;
typedef short bf16x8 __attribute__((ext_vector_type(8)));
typedef float f32x4 __attribute__((ext_vector_type(4)));
typedef unsigned u32x4 __attribute__((ext_vector_type(4)));
constexpr int BM = 256, BK = 64, HALF = 128, HTB = HALF * BK * 2  , STAGE_BYTES = 8 * HTB, NXCD = 8, WGM = 8;

__host__ __device__ __forceinline__ int lds_byte(int r, int c) { const int st = (r >> 4) * 2 + (c >> 5), rr = r & 15, cc = c & 31, ob = rr * 64 + cc * 2; return st * 1024 + (ob ^ (((ob >> 9) & 1) << 5)); }
__host__ __device__ __forceinline__ void stage_rc(int b, int& R, int& C) { const int st = b / 1024, sb = b % 1024, swz = sb ^ (((sb >> 9) & 1) << 5); R = (st >> 1) * 16 + swz / 64; C = (st & 1) * 32 + (swz % 64) / 2; }
__host__ __device__ __forceinline__ int perm32(int rho) { const int n = rho >> 4, i = rho & 15; return 8 * (i >> 2) + 4 * n + (i & 3); }

struct Unit { int pm, pn, kc; };
struct Gemm { const bf16_t* A; const bf16_t* Bt; int M, N, K, Kc, wv; };

struct StaticOrder {
    int nM, nN, nwg, G, c;
    __host__ __device__ void init(int M, int N, int G_, int c_) { nM = M / BM; nN = N / BM; nwg = nM * nN; G = G_; c = c_; }
    __host__ __device__ bool next(int i, Unit& u) const {
        const long L = (long)i * G + c; if (L >= nwg) return false;
        int wgid = (int)L; { const int q = nwg / NXCD, r = nwg % NXCD, xcd = wgid % NXCD, off = wgid / NXCD; wgid = (xcd < r ? xcd * (q + 1) : r * (q + 1) + (xcd - r) * q) + off; }
        const int nig = WGM * nN, gid = wgid / nig, fm = gid * WGM, gsz = (nM - fm) < WGM ? (nM - fm) : WGM;
        u.pm = fm + ((wgid % nig) % gsz); u.pn = (wgid % nig) / gsz; u.kc = 0; return true;
    }
    __device__ __forceinline__ void a_ready(const Unit&) const {}
    __device__ __forceinline__ void done(const Unit&) const {}
};

__device__ __forceinline__ unsigned cvt_pk_bf16(float lo, float hi) { unsigned r; asm volatile("v_cvt_pk_bf16_f32 %0, %1, %2" : "=v"(r) : "v"(lo), "v"(hi)); return r; }
template <class Epi, class Sched, bool ALIGN_EPI = false, bool SP2 = false, bool SPLITK = false>
__device__ __forceinline__ void gemm_phase(PG8_LAS unsigned char* lds, const Gemm g, const Sched& S, const Epi& E) {
    int tid_l; asm volatile("v_mbcnt_lo_u32_b32 %0, -1, 0\n\tv_mbcnt_hi_u32_b32 %0, -1, %0" : "=v"(tid_l)); const int tid = g.wv * 64 + tid_l, wid = __builtin_amdgcn_readfirstlane(tid >> 6), lane = tid & 63, wr = wid >> 2, wc = wid & 3, fr = lane & 15, fq = lane >> 4;
    const int K = g.K, nt = (SPLITK ? g.Kc : g.K) / BK; const size_t kcb = SPLITK ? (size_t)g.Kc * 2 : 0;
    unsigned voffA[2], voffB[2];
#pragma unroll
    for (int i = 0; i < 2; ++i) { int R, C; stage_rc(tid * 16 + i * 8192, R, C); const int Rb = Epi::PERM ? ((R & ~31) + perm32(R & 31)) : R;
        voffA[i] = (unsigned)(R * K + C) * 2u; voffB[i] = (unsigned)(Rb * K + C) * 2u; }
    const size_t kstep = (size_t)(BK * 2);
    const size_t hstep = (size_t)HALF * K * 2;
    const size_t tstep = 2 * hstep;
    const unsigned ldsw = (unsigned)wid * 1024u;
    const int aoff = lds_byte(wr * 64 + fr, fq * 8), boff = lds_byte(wc * 32 + fr, fq * 8);
#define PG8_SA(b, h) (((b) * 2 + (h)) * HTB)
#define PG8_SB(b, h) ((4 + (b) * 2 + (h)) * HTB)
#define PG8_STAGE(bufoff, gbase, voff) do { _Pragma("unroll") for (int _i = 0; _i < 2; ++_i) \
        __builtin_amdgcn_global_load_lds((const unsigned*)((const char*)(gbase) + (voff)[_i]), (PG8_LAS unsigned*)(lds + (bufoff) + ldsw + _i * 8192), 16, 0, 0); } while (0)
#define PG8_LDA(dst, b, h) do { _Pragma("unroll") for (int m = 0; m < 4; ++m) _Pragma("unroll") for (int k = 0; k < 2; ++k) dst[m][k] = *(const PG8_LAS bf16x8*)(lds + PG8_SA(b, h) + aoff + m * 2048 + k * 1024); } while (0)
#define PG8_LDB(dst, b, h) do { _Pragma("unroll") for (int n = 0; n < 2; ++n) _Pragma("unroll") for (int k = 0; k < 2; ++k) dst[n][k] = *(const PG8_LAS bf16x8*)(lds + PG8_SB(b, h) + boff + n * 2048 + k * 1024); } while (0)
#define PG8_MMA(ai, bj, At, Bt) do { __builtin_amdgcn_s_setprio(1); _Pragma("unroll") for (int m = 0; m < 4; ++m) _Pragma("unroll") for (int n = 0; n < 2; ++n) _Pragma("unroll") for (int k = 0; k < 2; ++k) \
        acc[ai][bj][m][n] = __builtin_amdgcn_mfma_f32_16x16x32_bf16(Bt[n][k], At[m][k], acc[ai][bj][m][n], 0, 0, 0); __builtin_amdgcn_s_setprio(0); } while (0)
#define PG8_WAIT_V(n) asm volatile("s_waitcnt vmcnt(" #n ")" ::: "memory")
#define PG8_WAIT_L(n) asm volatile("s_waitcnt lgkmcnt(" #n ")" ::: "memory")
#define PG8_BAR __builtin_amdgcn_s_barrier()
#define PG8_SCHED __builtin_amdgcn_sched_barrier(0)
    Unit cur, nxt; int ui = 0;
    if (!S.next(0, cur)) return;
    f32x4 acc[2][2][4][2];
#pragma unroll
    for (int a = 0; a < 2; ++a)
#pragma unroll
        for (int b = 0; b < 2; ++b)
#pragma unroll
            for (int m = 0; m < 4; ++m)
#pragma unroll
                for (int n = 0; n < 2; ++n) acc[a][b][m][n] = (f32x4){0.f, 0.f, 0.f, 0.f};
    bf16x8 At[4][2], B0[2][2], B1[2][2];
    const char* cA = (const char*)g.A + (size_t)cur.pm * tstep + (SPLITK ? (size_t)cur.kc * kcb : 0); const char* cB = (const char*)g.Bt + (size_t)cur.pn * tstep + (SPLITK ? (size_t)cur.kc * kcb : 0);
    S.a_ready(cur);
    if constexpr (SP2) {
        PG8_STAGE(PG8_SB(0, 0), cB, voffB); PG8_STAGE(PG8_SB(0, 1), cB + hstep, voffB); PG8_STAGE(PG8_SA(0, 0), cA, voffA); PG8_STAGE(PG8_SA(0, 1), cA + hstep, voffA);
        if (wr == 1) PG8_BAR;
        PG8_WAIT_V(2); PG8_BAR;
        PG8_STAGE(PG8_SB(1, 0), cB + kstep, voffB); PG8_STAGE(PG8_SA(1, 0), cA + kstep, voffA); PG8_STAGE(PG8_SB(1, 1), cB + hstep + kstep, voffB);
        PG8_WAIT_V(6); PG8_BAR;
    } else {
        PG8_STAGE(PG8_SB(0, 0), cB, voffB); PG8_STAGE(PG8_SA(0, 0), cA, voffA); PG8_STAGE(PG8_SB(0, 1), cB + hstep, voffB); PG8_STAGE(PG8_SA(0, 1), cA + hstep, voffA);
        if (wr == 1) PG8_BAR;
        PG8_WAIT_V(4); PG8_BAR;
        PG8_STAGE(PG8_SB(1, 0), cB + kstep, voffB); PG8_STAGE(PG8_SA(1, 0), cA + kstep, voffA); PG8_STAGE(PG8_SB(1, 1), cB + hstep + kstep, voffB);
        PG8_WAIT_V(6); PG8_BAR;
    }
    for (;;) {
        const bool has_next = S.next(ui + 1, nxt);
        const char* nA = has_next ? (const char*)g.A + (size_t)nxt.pm * tstep + (SPLITK ? (size_t)nxt.kc * kcb : 0) : cA; const char* nB = has_next ? (const char*)g.Bt + (size_t)nxt.pn * tstep + (SPLITK ? (size_t)nxt.kc * kcb : 0) : cB;
#pragma unroll 1
        for (int t = 0; t < nt; t += 2) {
            const bool last = (t == nt - 2);
            const char* a1 = cA + (size_t)(t + 1) * kstep;
            const char* a2 = last ? nA : cA + (size_t)(t + 2) * kstep; const char* b2 = last ? nB : cB + (size_t)(t + 2) * kstep;
            const char* a3 = a2 + kstep; const char* b3 = b2 + kstep;
            if (last && has_next) S.a_ready(nxt);
            if constexpr (SP2) {
            PG8_LDB(B0, 0, 0); PG8_LDB(B1, 0, 1); PG8_SCHED; PG8_LDA(At, 0, 0); PG8_STAGE(PG8_SA(1, 1), a1 + hstep, voffA);
            PG8_WAIT_V(8); PG8_WAIT_L(0); PG8_BAR; PG8_MMA(0, 0, At, B0); PG8_MMA(0, 1, At, B1); PG8_BAR; PG8_SCHED;
            PG8_LDA(At, 0, 1); PG8_STAGE(PG8_SB(0, 0), b2, voffB); PG8_STAGE(PG8_SB(0, 1), b2 + hstep, voffB); PG8_STAGE(PG8_SA(0, 0), a2, voffA);
            PG8_WAIT_V(8); PG8_WAIT_L(0); PG8_BAR; PG8_MMA(1, 0, At, B0); PG8_MMA(1, 1, At, B1); PG8_BAR; PG8_SCHED;
            PG8_LDB(B0, 1, 0); PG8_LDB(B1, 1, 1); PG8_SCHED; PG8_LDA(At, 1, 0); PG8_STAGE(PG8_SA(0, 1), a2 + hstep, voffA);
            PG8_WAIT_V(8); PG8_WAIT_L(0); PG8_BAR; PG8_MMA(0, 0, At, B0); PG8_MMA(0, 1, At, B1); PG8_BAR; PG8_SCHED;
            PG8_LDA(At, 1, 1); PG8_STAGE(PG8_SB(1, 0), b3, voffB); PG8_STAGE(PG8_SB(1, 1), b3 + hstep, voffB); PG8_STAGE(PG8_SA(1, 0), a3, voffA);
            PG8_WAIT_V(8); PG8_WAIT_L(0); PG8_BAR; PG8_MMA(1, 0, At, B0); PG8_MMA(1, 1, At, B1); PG8_BAR; PG8_SCHED;
            } else {
            PG8_LDB(B0, 0, 0); PG8_SCHED; PG8_LDA(At, 0, 0); PG8_STAGE(PG8_SA(1, 1), a1 + hstep, voffA);
            PG8_WAIT_L(8); PG8_BAR; PG8_WAIT_L(0); PG8_MMA(0, 0, At, B0); PG8_BAR; PG8_SCHED;
            PG8_LDB(B1, 0, 1); PG8_STAGE(PG8_SB(0, 0), b2, voffB);
            PG8_BAR; PG8_WAIT_L(0); PG8_MMA(0, 1, At, B1); PG8_BAR;
            PG8_LDA(At, 0, 1); PG8_STAGE(PG8_SA(0, 0), a2, voffA);
            PG8_BAR; PG8_WAIT_L(0); PG8_MMA(1, 0, At, B0); PG8_BAR; PG8_SCHED;
            PG8_STAGE(PG8_SB(0, 1), b2 + hstep, voffB);
            PG8_WAIT_V(6); PG8_BAR; PG8_MMA(1, 1, At, B1); PG8_BAR;
            PG8_LDB(B0, 1, 0); PG8_SCHED; PG8_LDA(At, 1, 0); PG8_STAGE(PG8_SA(0, 1), a2 + hstep, voffA);
            PG8_WAIT_L(8); PG8_BAR; PG8_WAIT_L(0); PG8_MMA(0, 0, At, B0); PG8_BAR; PG8_SCHED;
            PG8_LDB(B1, 1, 1); PG8_STAGE(PG8_SB(1, 0), b3, voffB);
            PG8_BAR; PG8_WAIT_L(0); PG8_MMA(0, 1, At, B1); PG8_BAR;
            PG8_LDA(At, 1, 1); PG8_STAGE(PG8_SA(1, 0), a3, voffA);
            PG8_BAR; PG8_WAIT_L(0); PG8_MMA(1, 0, At, B0); PG8_BAR; PG8_SCHED;
            PG8_STAGE(PG8_SB(1, 1), b3 + hstep, voffB);
            PG8_WAIT_V(6); PG8_BAR; PG8_MMA(1, 1, At, B1); PG8_BAR;
            }
        }
        if constexpr (ALIGN_EPI) { if (wr == 0) PG8_BAR; }
        if constexpr (!Epi::AFTER_DRAIN) { E(acc, cur, wr, wc, fr, fq); S.done(cur); }
        if (!has_next) break;
#pragma unroll
        for (int a = 0; a < 2; ++a)
#pragma unroll
            for (int b = 0; b < 2; ++b)
#pragma unroll
                for (int m = 0; m < 4; ++m)
#pragma unroll
                    for (int n = 0; n < 2; ++n) acc[a][b][m][n] = (f32x4){0.f, 0.f, 0.f, 0.f};
        cur = nxt; cA = nA; cB = nB; ++ui;
        if constexpr (ALIGN_EPI) { if (wr == 1) PG8_BAR; }
    }
    PG8_WAIT_V(0);
    if constexpr (!ALIGN_EPI) { if (wr == 0) PG8_BAR; }
    PG8_BAR;
    if constexpr (Epi::AFTER_DRAIN) { E.fused(acc, cur, wr, wc, fr, fq, lds, wid, lane); S.done(cur); }
#undef PG8_SA
#undef PG8_SB
#undef PG8_STAGE
#undef PG8_LDA
#undef PG8_LDB
#undef PG8_MMA
#undef PG8_WAIT_V
#undef PG8_WAIT_L
#undef PG8_BAR
#undef PG8_SCHED
}
}

#define LAS __attribute__((address_space(3)))
typedef unsigned short bf16_t;
typedef float f32x4 __attribute__((ext_vector_type(4)));
typedef float f32x2 __attribute__((ext_vector_type(2)));
typedef float f32x16 __attribute__((ext_vector_type(16)));
typedef unsigned u32x4 __attribute__((ext_vector_type(4)));
typedef unsigned u32x2 __attribute__((ext_vector_type(2)));
typedef short bf16x8 __attribute__((ext_vector_type(8)));

constexpr int DM = 1024, NB = 32, SEQ = 2048, NMETA = 16, LP = 2064, DSQ = 32, PAST = 4096, KSAMP = 4128;
constexpr int MP = NB * LP;
constexpr int MS = NB * DSQ;
constexpr int M1 = MP + MS;
constexpr int M2P = NB * SEQ;
constexpr int M2 = M2P + MS;
constexpr int KPB = 2112;
constexpr int MKP = NB * KPB;
constexpr int MK = MKP + NB * KSAMP;
constexpr int NPROJ = 2304, INCOLS = 2208, RW0 = 416, RWC = 1792, DFF = 2816;
constexpr float EPS = 1e-6f, LNX_EPS = 64e-5f;
constexpr float QSCALE = 0.10206207261596577f * 1.4426950408889634f;

constexpr size_t OFF_YP = 0, OFF_YS = 67108864, OFF_KVP = 68157440, OFF_KRP = 76611584, OFF_WKVP = 78725120, OFF_SHP = 79773696,
                 OFF_KVS = 79831040, OFF_KRS = 79962112, OFF_WKVS = 79994880, OFF_SHS = 81043456;

constexpr size_t MiB = 1u << 20;
constexpr size_t WS_WIN = 0, WS_WQ = 5 * MiB, WS_WKV = 6 * MiB, WS_WL = 7 * MiB, WS_WOUT = 8 * MiB, WS_WGU = 10 * MiB, WS_WDN = 22 * MiB;
constexpr size_t WS_CTL = 28 * MiB;
constexpr size_t WS_XN = 32 * MiB, WS_PROJ = 163 * MiB;
constexpr size_t WS_CALL = 32 * MiB, WS_KRALL = 81 * MiB, WS_QL = 94 * MiB, WS_LIN = 127 * MiB;
constexpr size_t WS_RKV = 460 * MiB, WS_Q = 163 * MiB, WS_E = 262 * MiB, WS_A = 328 * MiB, WS_G = 394 * MiB;
constexpr size_t WS_MIX = 657 * MiB, WS_KN = 852 * MiB, WS_V = 920 * MiB, WS_ATT = 787 * MiB;
constexpr size_t WS_H = 32 * MiB, WS_U = 292 * MiB, WS_ACT = 422 * MiB;
constexpr size_t WS_HS = 790 * MiB;
constexpr size_t WS_PB5 = 430 * MiB, WS_PB7 = 300 * MiB;
constexpr size_t WS_NEED = 988 * MiB;
constexpr int LDS_BYTES = 155648;

struct P {
    const float *xp, *xs, *ckv, *ckr, *swkv, *sshift, *meta, *g_mix, *w_in, *g_q, *w_qup, *g_kv, *w_kvup, *g_qn, *g_qr, *g_kn, *g_kr, *g_ao,
                *mu, *w0, *w2, *a0, *a2, *g2, *k_k, *k_a, *r_k, *lnx_g, *lnx_b, *w_out, *g_ffn, *w_gate, *w_up, *w_down;
    float* out; unsigned char* ws;
};
__device__ __forceinline__ int lane_id() { int l; asm volatile("v_mbcnt_lo_u32_b32 %0, -1, 0\n\tv_mbcnt_hi_u32_b32 %0, -1, %0" : "=v"(l)); return l; }

__device__ __forceinline__ float bf2f(unsigned b) { return __uint_as_float(b << 16); }
__device__ __forceinline__ float bflo(unsigned w) { return __uint_as_float(w << 16); }
__device__ __forceinline__ float bfhi(unsigned w) { return __uint_as_float(w & 0xffff0000u); }
__device__ __forceinline__ unsigned pk2(float lo, float hi) { return pg8::cvt_pk_bf16(lo, hi); }
__device__ __forceinline__ float wave_sum(float v) {
#pragma unroll
    for (int o = 1; o < 64; o <<= 1) v += __shfl_xor(v, o);
    return v;
}
__device__ __forceinline__ float red16(float v) { v += __shfl_xor(v, 1); v += __shfl_xor(v, 2); v += __shfl_xor(v, 4); v += __shfl_xor(v, 8); return v; }
__device__ __forceinline__ float sigmoidf_(float x) { return 1.0f / (1.0f + __expf(-x)); }
__device__ __forceinline__ void rope_cs(float pos, int j, float& c, float& s) {
    const float inv = exp2f(-0.8304820237218406f * (float)j);
    const float ang = pos * inv;
    const float k = rintf(ang * 0.15915494309189535f);
    float r = fmaf(-k, 6.2831854820251465f, ang); r = fmaf(-k, -1.7484555e-7f, r);
    s = __sinf(r); c = __cosf(r);
}
__device__ __forceinline__ float row_pos(int row1) { return row1 < MP ? (float)(row1 % LP) : (float)(PAST + ((row1 - MP) & 31)); }

namespace pg8 {
struct EpiStore {
    static constexpr bool PERM = true, AFTER_DRAIN = false;
    bf16_t* O; int ldc;
    __device__ __forceinline__ void operator()(const f32x4 (&acc)[2][2][4][2], const Unit& u, int wr, int wc, int fr, int fq) const {
        const int row0 = u.pm * BM + wr * 64 + fr, col0 = u.pn * BM + wc * 32 + 8 * fq;
#pragma unroll
        for (int ai = 0; ai < 2; ++ai)
#pragma unroll
            for (int m = 0; m < 4; ++m) { bf16_t* rowp = O + (size_t)(row0 + ai * HALF + m * 16) * ldc + col0;
#pragma unroll
                for (int bj = 0; bj < 2; ++bj) { const f32x4 v0 = acc[ai][bj][m][0], v1 = acc[ai][bj][m][1]; u32x4 w;
                    w.x = cvt_pk_bf16(v0[0], v0[1]); w.y = cvt_pk_bf16(v0[2], v0[3]); w.z = cvt_pk_bf16(v1[0], v1[1]); w.w = cvt_pk_bf16(v1[2], v1[3]);
                    *(u32x4*)(rowp + bj * HALF) = w; } }
    }
};
struct EpiKV {
    static constexpr bool PERM = true, AFTER_DRAIN = false;
    bf16_t* KN; bf16_t* V; const float* gk;
    __device__ __forceinline__ void operator()(const f32x4 (&acc)[2][2][4][2], const Unit& u, int wr, int wc, int fr, int fq) const {
        const int slot = u.pn * 4 + wc, h = slot & 7;
        const size_t off0 = (size_t)(u.pm * BM + wr * 64 + fr) * 512 + h * 64 + 8 * fq;
        if (slot >= 8) {
#pragma unroll
            for (int ai = 0; ai < 2; ++ai)
#pragma unroll
                for (int m = 0; m < 4; ++m) { bf16_t* dst = V + off0 + (size_t)(ai * HALF + m * 16) * 512;
#pragma unroll
                    for (int bj = 0; bj < 2; ++bj) { const f32x4 v0 = acc[ai][bj][m][0], v1 = acc[ai][bj][m][1]; u32x4 w;
                        w.x = cvt_pk_bf16(v0[0], v0[1]); w.y = cvt_pk_bf16(v0[2], v0[3]); w.z = cvt_pk_bf16(v1[0], v1[1]); w.w = cvt_pk_bf16(v1[2], v1[3]);
                        *(u32x4*)(dst + 32 * bj) = w; } }
        } else {
#pragma unroll
            for (int ai = 0; ai < 2; ++ai)
#pragma unroll
                for (int m = 0; m < 4; ++m) {
                    float ss = 0.f;
#pragma unroll
                    for (int bj = 0; bj < 2; ++bj)
#pragma unroll
                        for (int n = 0; n < 2; ++n) { const f32x4 x = acc[ai][bj][m][n]; ss += (x[0] * x[0] + x[1] * x[1]) + (x[2] * x[2] + x[3] * x[3]); }
                    ss += __shfl_xor(ss, 16); ss += __shfl_xor(ss, 32);
                    const float rs = rsqrtf(ss * (1.0f / 64.0f) + EPS);
                    bf16_t* dst = KN + off0 + (size_t)(ai * HALF + m * 16) * 512;
#pragma unroll
                    for (int bj = 0; bj < 2; ++bj) { const f32x4 v0 = acc[ai][bj][m][0] * rs, v1 = acc[ai][bj][m][1] * rs; u32x4 w;
                        w.x = cvt_pk_bf16(v0[0], v0[1]); w.y = cvt_pk_bf16(v0[2], v0[3]); w.z = cvt_pk_bf16(v1[0], v1[1]); w.w = cvt_pk_bf16(v1[2], v1[3]);
                        *(u32x4*)(dst + 32 * bj) = w; }
                    asm volatile("" ::: "memory");
                }
        }
    }
};
struct EpiRes {
    static constexpr bool PERM = false, AFTER_DRAIN = false;
    float* O; const float* r0; const float* r1; int split;
    __device__ __forceinline__ void operator()(const f32x4 (&acc)[2][2][4][2], const Unit& u, int wr, int wc, int fr, int fq) const {
        const int col0 = u.pn * BM + wc * 32 + 4 * fq;
#pragma unroll
        for (int ai = 0; ai < 2; ++ai)
#pragma unroll
            for (int m = 0; m < 4; ++m) {
                const int row = u.pm * BM + ai * HALF + wr * 64 + m * 16 + fr;
                const float* rp = (row < split ? r0 + (size_t)row * 1024 : r1 + (size_t)(row - split) * 1024) + col0;
                float* op = O + (size_t)row * 1024 + col0;
#pragma unroll
                for (int bj = 0; bj < 2; ++bj)
#pragma unroll
                    for (int n = 0; n < 2; ++n) { const f32x4 x = *(const f32x4*)(rp + bj * HALF + n * 16); *(f32x4*)(op + bj * HALF + n * 16) = acc[ai][bj][m][n] + x; }
            }
    }
};
struct EpiResToB16 {
    static constexpr bool PERM = false, AFTER_DRAIN = false;
    bf16_t* H; const float* x;
    __device__ __forceinline__ void operator()(const f32x4 (&acc)[2][2][4][2], const Unit& u, int wr, int wc, int fr, int fq) const {
        const int col0 = u.pn * BM + wc * 32 + 4 * fq;
#pragma unroll
        for (int ai = 0; ai < 2; ++ai)
#pragma unroll
            for (int m = 0; m < 4; ++m) {
                const size_t o = (size_t)(u.pm * BM + ai * HALF + wr * 64 + m * 16 + fr) * 1024 + col0;
#pragma unroll
                for (int bj = 0; bj < 2; ++bj)
#pragma unroll
                    for (int n = 0; n < 2; ++n) { const f32x4 h = acc[ai][bj][m][n] + *(const f32x4*)(x + o + bj * HALF + n * 16);
                        u32x2 w; w.x = cvt_pk_bf16(h[0], h[1]); w.y = cvt_pk_bf16(h[2], h[3]); *(u32x2*)(H + o + bj * HALF + n * 16) = w; }
            }
    }
};
struct EpiOutFromB16 {
    static constexpr bool PERM = false, AFTER_DRAIN = false;
    float* O; const bf16_t* H;
    __device__ __forceinline__ void operator()(const f32x4 (&acc)[2][2][4][2], const Unit& u, int wr, int wc, int fr, int fq) const {
        const int col0 = u.pn * BM + wc * 32 + 4 * fq;
#pragma unroll
        for (int ai = 0; ai < 2; ++ai)
#pragma unroll
            for (int m = 0; m < 4; ++m) {
                const size_t o = (size_t)(u.pm * BM + ai * HALF + wr * 64 + m * 16 + fr) * 1024 + col0;
#pragma unroll
                for (int bj = 0; bj < 2; ++bj)
#pragma unroll
                    for (int n = 0; n < 2; ++n) { const u32x2 r = *(const u32x2*)(H + o + bj * HALF + n * 16);
                        const f32x4 h = {bflo(r.x), bfhi(r.x), bflo(r.y), bfhi(r.y)};
                        *(f32x4*)(O + o + bj * HALF + n * 16) = acc[ai][bj][m][n] + h; }
            }
    }
};
struct EpiSwiglu {
    static constexpr bool PERM = true, AFTER_DRAIN = false;
    bf16_t* O;
    __device__ __forceinline__ void operator()(const f32x4 (&acc)[2][2][4][2], const Unit& u, int wr, int wc, int fr, int fq) const {
        const int col0 = u.pn * HALF + wc * 32 + 8 * fq;
#pragma unroll
        for (int ai = 0; ai < 2; ++ai)
#pragma unroll
            for (int m = 0; m < 4; ++m) {
                const int row = u.pm * BM + ai * HALF + wr * 64 + m * 16 + fr;
                float o[8];
#pragma unroll
                for (int n = 0; n < 2; ++n)
#pragma unroll
                    for (int e = 0; e < 4; ++e) { const float g = acc[ai][0][m][n][e], up = acc[ai][1][m][n][e]; o[4 * n + e] = g * sigmoidf_(g) * up; }
                u32x4 w; w.x = cvt_pk_bf16(o[0], o[1]); w.y = cvt_pk_bf16(o[2], o[3]); w.z = cvt_pk_bf16(o[4], o[5]); w.w = cvt_pk_bf16(o[6], o[7]);
                *(u32x4*)(O + (size_t)row * DFF + col0) = w;
            }
    }
};
struct SplitOrder {
    int pm0, npm, nN, nkc, G, c;
    __device__ bool next(int i, Unit& u) const {
        const long L = (long)i * G + (G - 1 - c); if (L >= (long)npm * nN * nkc) return false;
        const int l = (int)L; u.kc = l % nkc; const int t = l / nkc; u.pn = t % nN; u.pm = pm0 + t / nN; return true;
    }
    __device__ __forceinline__ void a_ready(const Unit&) const {}
    __device__ __forceinline__ void done(const Unit&) const {}
};
struct EpiPartial {
    static constexpr bool PERM = false, AFTER_DRAIN = false;
    float* PB; int row0;
    __device__ __forceinline__ void operator()(const f32x4 (&acc)[2][2][4][2], const Unit& u, int wr, int wc, int fr, int fq) const {
        const int col0 = u.pn * BM + wc * 32 + 4 * fq;
        float* base = PB + ((size_t)u.kc * 1024 + (u.pm * BM + wr * 64 + fr - row0)) * 1024 + col0;
#pragma unroll
        for (int ai = 0; ai < 2; ++ai)
#pragma unroll
            for (int m = 0; m < 4; ++m) {
                float* op = base + (size_t)(ai * HALF + m * 16) * 1024;
#pragma unroll
                for (int bj = 0; bj < 2; ++bj)
#pragma unroll
                    for (int n = 0; n < 2; ++n) *(f32x4*)(op + bj * HALF + n * 16) = acc[ai][bj][m][n];
            }
    }
};
}

__device__ __forceinline__ float wsrc(const P& p, int mat, int n, int k) {
    switch (mat) {
    case 0: return n < INCOLS ? p.w_in[(size_t)k * INCOLS + n] : 0.f;
    case 1: return p.w_qup[(size_t)k * 768 + n];
    case 2: { const int pn = n >> 8, bj = (n >> 7) & 1, wc = (n >> 5) & 3, x = n & 31, slot = pn * 4 + wc;
              const int c = (slot & 7) * 128 + (slot < 8 ? 0 : 64) + 32 * bj + x;
              return p.w_kvup[(size_t)k * 1024 + c]; }
    case 3: { if (n < 512) return k < 64 ? p.w2[(size_t)k * 512 + n] : 0.f;
              if (n < 1024) return (k >= 64 && k < 128) ? p.a2[(size_t)(k - 64) * 512 + (n - 512)] : 0.f;
              return k >= 128 ? p.g2[(size_t)(k - 128) * 512 + (n - 1024)] : 0.f; }
    case 4: return p.w_out[(size_t)k * 1024 + n];
    case 5: { const int pn = n >> 8, r = n & 255; return r < 128 ? p.w_gate[(size_t)k * DFF + pn * 128 + r] : p.w_up[(size_t)k * DFF + pn * 128 + r - 128]; }
    default: return p.w_down[(size_t)k * 1024 + n];
    }
}
__device__ __forceinline__ const float* xn_src(const P& p, int row) {
    if (row < MP) { const int b = row / LP, t = row % LP; return t < NMETA ? p.meta + (size_t)t * DM : p.xp + ((size_t)b * SEQ + (t - NMETA)) * DM; }
    return p.xs + (size_t)(row - MP) * DM;
}
__device__ __forceinline__ void phase_e0(const P& p, int wv, LAS unsigned char* lds) {
    LAS float* T = (LAS float*)lds;
    const int tid_l = wv * 64 + lane_id(); const int tid = tid_l, lane = tid & 63, wave = tid >> 6;
    constexpr int NT = 3120;
#define E0_DECODE(T_, mat, K, n0, k0, dst) do { int r_; \
        if ((T_) < 576)       { mat = 0; r_ = (T_);        K = 1024; dst = (bf16_t*)(p.ws + WS_WIN); } \
        else if ((T_) < 624)  { mat = 1; r_ = (T_) - 576;  K = 256;  dst = (bf16_t*)(p.ws + WS_WQ); } \
        else if ((T_) < 656)  { mat = 2; r_ = (T_) - 624;  K = 128;  dst = (bf16_t*)(p.ws + WS_WKV); } \
        else if ((T_) < 752)  { mat = 3; r_ = (T_) - 656;  K = 256;  dst = (bf16_t*)(p.ws + WS_WL); } \
        else if ((T_) < 1008) { mat = 4; r_ = (T_) - 752;  K = 1024; dst = (bf16_t*)(p.ws + WS_WOUT); } \
        else if ((T_) < 2416) { mat = 5; r_ = (T_) - 1008; K = 1024; dst = (bf16_t*)(p.ws + WS_WGU); } \
        else                  { mat = 6; r_ = (T_) - 2416; K = 2816; dst = (bf16_t*)(p.ws + WS_WDN); } \
        const int nkt_ = K / 64; n0 = (r_ / nkt_) * 64; k0 = (r_ % nkt_) * 64; } while (0)
    {
        float v[8];
        int t = blockIdx.x;
        if (t < NT) { int mat, K, n0, k0; bf16_t* dst; E0_DECODE(t, mat, K, n0, k0, dst); (void)dst;
#pragma unroll
            for (int i = 0; i < 8; ++i) v[i] = wsrc(p, mat, n0 + (tid & 63), k0 + (tid >> 6) + 8 * i); }
        for (; t < NT; t += gridDim.x) {
            int mat, K, n0, k0; bf16_t* dst; E0_DECODE(t, mat, K, n0, k0, dst); (void)mat;
#pragma unroll
            for (int i = 0; i < 8; ++i) T[((tid >> 6) + 8 * i) * 65 + (tid & 63)] = v[i];
            __syncthreads();
            const int tn = t + gridDim.x;
            if (tn < NT) { int mat2, K2, n02, k02; bf16_t* dst2; E0_DECODE(tn, mat2, K2, n02, k02, dst2); (void)dst2;
#pragma unroll
                for (int i = 0; i < 8; ++i) v[i] = wsrc(p, mat2, n02 + (tid & 63), k02 + (tid >> 6) + 8 * i); }
#pragma unroll
            for (int i = 0; i < 4; ++i) { const int n = (tid >> 5) + 16 * i, kq = tid & 31;
                *(unsigned*)(dst + (size_t)(n0 + n) * K + k0 + 2 * kq) = pk2(T[(2 * kq) * 65 + n], T[(2 * kq + 1) * 65 + n]); }
            __syncthreads();
        }
    }
#undef E0_DECODE
    bf16_t* XN = (bf16_t*)(p.ws + WS_XN);
    f32x4 g[4];
#pragma unroll
    for (int j = 0; j < 4; ++j) g[j] = *(const f32x4*)(p.g_mix + 4 * lane + 256 * j);
    const int xstride = gridDim.x * 8;
    for (int row = blockIdx.x * 8 + wave; row < M1; row += 2 * xstride) {
        const int rowb = row + xstride; const bool hb = rowb < M1;
        const float* sa = xn_src(p, row); const float* sb = xn_src(p, hb ? rowb : row);
        f32x4 va[4], vb[4]; float ssa = 0.f, ssb = 0.f;
#pragma unroll
        for (int j = 0; j < 4; ++j) { va[j] = *(const f32x4*)(sa + 4 * lane + 256 * j); vb[j] = *(const f32x4*)(sb + 4 * lane + 256 * j); }
#pragma unroll
        for (int j = 0; j < 4; ++j) { ssa += (va[j][0] * va[j][0] + va[j][1] * va[j][1]) + (va[j][2] * va[j][2] + va[j][3] * va[j][3]);
                                      ssb += (vb[j][0] * vb[j][0] + vb[j][1] * vb[j][1]) + (vb[j][2] * vb[j][2] + vb[j][3] * vb[j][3]); }
        const float rsa = rsqrtf(wave_sum(ssa) * (1.0f / DM) + EPS), rsb = rsqrtf(wave_sum(ssb) * (1.0f / DM) + EPS);
#pragma unroll
        for (int j = 0; j < 4; ++j) { const f32x4 o = va[j] * g[j] * rsa; u32x2 w; w.x = pk2(o[0], o[1]); w.y = pk2(o[2], o[3]);
            *(u32x2*)(XN + (size_t)row * DM + 4 * lane + 256 * j) = w; }
        if (hb) {
#pragma unroll
            for (int j = 0; j < 4; ++j) { const f32x4 o = vb[j] * g[j] * rsb; u32x2 w; w.x = pk2(o[0], o[1]); w.y = pk2(o[2], o[3]);
                *(u32x2*)(XN + (size_t)rowb * DM + 4 * lane + 256 * j) = w; } }
    }
}

struct E1Raw { u32x2 q; unsigned c, kr; u32x2 cur[7], prv[7]; };
__device__ __forceinline__ void e1_load(E1Raw& R, const bf16_t* PROJ, int row, int lane) {
    const bf16_t* pr = PROJ + (size_t)row * NPROJ;
    R.q = *(const u32x2*)(pr + 4 * lane); R.c = *(const unsigned*)(pr + 256 + 2 * lane); R.kr = pr[384 + (lane & 31)];
#pragma unroll
    for (int idx = 0; idx < 7; ++idx) R.cur[idx] = *(const u32x2*)(pr + RW0 + 4 * lane + 256 * idx);
    const bool nofirst = row < MP ? (row % LP != 0) : (((row - MP) & 31) != 0);
#pragma unroll
    for (int idx = 0; idx < 7; ++idx) R.prv[idx] = nofirst ? *(const u32x2*)(pr - NPROJ + RW0 + 4 * lane + 256 * idx) : (u32x2){0u, 0u};
}
__device__ __forceinline__ void e1_finish(const P& p, const E1Raw& R, int row, int lane, f32x4 gq, f32x2 gkv, float gkr) {
    bf16_t* QL = (bf16_t*)(p.ws + WS_QL); bf16_t* CALL = (bf16_t*)(p.ws + WS_CALL); bf16_t* KRALL = (bf16_t*)(p.ws + WS_KRALL);
    bf16_t* RKV = (bf16_t*)(p.ws + WS_RKV); bf16_t* LIN = (bf16_t*)(p.ws + WS_LIN);
    const bool isP = row < MP;
        int b, t; if (isP) { b = row / LP; t = row % LP; } else { b = (row - MP) >> 5; t = (row - MP) & 31; }
        const int rowk = isP ? b * KPB + 48 + t : MKP + b * KSAMP + PAST + t;
        const float pos = isP ? (float)t : (float)(PAST + t);
        { const u32x2 raw = R.q; const float x0 = bflo(raw.x), x1 = bfhi(raw.x), x2 = bflo(raw.y), x3 = bfhi(raw.y);
          const float rs = rsqrtf(wave_sum((x0 * x0 + x1 * x1) + (x2 * x2 + x3 * x3)) * (1.0f / 256.0f) + EPS);
          u32x2 w; w.x = pk2(x0 * rs * gq[0], x1 * rs * gq[1]); w.y = pk2(x2 * rs * gq[2], x3 * rs * gq[3]);
          *(u32x2*)(QL + (size_t)row * 256 + 4 * lane) = w; }
        { const unsigned raw = R.c; const float x0 = bflo(raw), x1 = bfhi(raw);
          const float rs = rsqrtf(wave_sum(x0 * x0 + x1 * x1) * (1.0f / 128.0f) + EPS);
          const float c0 = x0 * rs * gkv[0], c1 = x1 * rs * gkv[1];
          float* dst = isP ? p.out + OFF_KVP + ((size_t)b * LP + t) * 128 : p.out + OFF_KVS + ((size_t)b * DSQ + t) * 128;
          *(f32x2*)(dst + 2 * lane) = (f32x2){c0, c1};
          *(unsigned*)(CALL + (size_t)rowk * 128 + 2 * lane) = pk2(c0, c1); }
        { const int j = lane & 31; const float x = bf2f(R.kr);
          float ss = x * x; ss += __shfl_xor(ss, 1); ss += __shfl_xor(ss, 2); ss += __shfl_xor(ss, 4); ss += __shfl_xor(ss, 8); ss += __shfl_xor(ss, 16);
          const float y = x * rsqrtf(ss * (1.0f / 32.0f) + EPS) * gkr;
          const float pa = __shfl_xor(y, 16);
          float c, s; rope_cs(pos, j & 15, c, s);
          const float o = j < 16 ? y * c - pa * s : pa * s + y * c;
          if (lane < 32) {
              float* dst = isP ? p.out + OFF_KRP + ((size_t)b * LP + t) * 32 : p.out + OFF_KRS + ((size_t)b * DSQ + t) * 32;
              dst[j] = o; KRALL[(size_t)rowk * 32 + j] = (bf16_t)(pk2(o, 0.f) & 0xffffu);
          } }
        const bool first = (t == 0), last = isP ? (t == LP - 1) : (t == DSQ - 1);
        float* shdst = isP ? p.out + OFF_SHP + (size_t)b * RWC : p.out + OFF_SHS + (size_t)b * RWC;
#pragma unroll
        for (int idx = 0; idx < 7; ++idx) {
            const int c = 4 * lane + 256 * idx;
            const u32x2 raw = R.cur[idx];
            const f32x4 cur = {bflo(raw.x), bfhi(raw.x), bflo(raw.y), bfhi(raw.y)};
            f32x4 prev;
            if (first) { if (isP) prev = (f32x4){0.f, 0.f, 0.f, 0.f}; else prev = *(const f32x4*)(p.sshift + (size_t)b * RWC + c); }
            else { const u32x2 rp = R.prv[idx]; prev = (f32x4){bflo(rp.x), bfhi(rp.x), bflo(rp.y), bfhi(rp.y)}; }
            const f32x4 mu = *(const f32x4*)(p.mu + c);
            f32x4 xm = cur + (prev - cur) * mu;
            if (last) *(f32x4*)(shdst + c) = cur;
            if (idx < 6) { u32x2 w; w.x = pk2(xm[0], xm[1]); w.y = pk2(xm[2], xm[3]); *(u32x2*)(RKV + (size_t)row * 1536 + c) = w; }
            else {
                const int lc = 4 * lane;
                if (lc < 64) {
#pragma unroll
                    for (int e = 0; e < 4; ++e) xm[e] = tanhf(xm[e]); }
                else if (lc >= 128) {
#pragma unroll
                    for (int e = 0; e < 4; ++e) xm[e] = sigmoidf_(xm[e]); }
                u32x2 w; w.x = pk2(xm[0], xm[1]); w.y = pk2(xm[2], xm[3]); *(u32x2*)(LIN + (size_t)row * 256 + lc) = w;
            }
        }
    }
__device__ __forceinline__ void phase_e1(const P& p, int wv) {
    const int tid_l = wv * 64 + lane_id(); const int tid = tid_l, lane = tid & 63, wave = tid >> 6;
    const bf16_t* PROJ = (const bf16_t*)(p.ws + WS_PROJ);
    bf16_t* QL = (bf16_t*)(p.ws + WS_QL); bf16_t* CALL = (bf16_t*)(p.ws + WS_CALL); bf16_t* KRALL = (bf16_t*)(p.ws + WS_KRALL);
    bf16_t* RKV = (bf16_t*)(p.ws + WS_RKV); bf16_t* LIN = (bf16_t*)(p.ws + WS_LIN);
    {
        const size_t gt = (size_t)blockIdx.x * 512 + tid, gs = (size_t)gridDim.x * 512;
        for (size_t e = gt; e < (size_t)NB * 48 * 128 / 4; e += gs) {
            const size_t idx = e * 4; const int b = (int)(idx / (48 * 128)); const size_t rem = idx - (size_t)b * 48 * 128;
            *(u32x2*)(CALL + (size_t)b * KPB * 128 + rem) = (u32x2){0u, 0u};
        }
        for (size_t e = gt; e < (size_t)NB * 48 * 32 / 4; e += gs) {
            const size_t idx = e * 4; const int b = (int)(idx / (48 * 32)); const size_t rem = idx - (size_t)b * 48 * 32;
            *(u32x2*)(KRALL + (size_t)b * KPB * 32 + rem) = (u32x2){0u, 0u};
        }
    }
    const f32x4 gq = *(const f32x4*)(p.g_q + 4 * lane);
    const f32x2 gkv = *(const f32x2*)(p.g_kv + 2 * lane);
    const float gkr = p.g_kr[lane & 31];
    const int e1stride = gridDim.x * 8;
    for (int row = blockIdx.x * 8 + wave; row < M1; row += 2 * e1stride) {
        const int rowb = row + e1stride; const bool hb = rowb < M1;
        E1Raw ra, rb;
        e1_load(ra, PROJ, row, lane); e1_load(rb, PROJ, hb ? rowb : row, lane);
        e1_finish(p, ra, row, lane, gq, gkv, gkr);
        if (hb) e1_finish(p, rb, rowb, lane, gq, gkv, gkr);
    }

}

template <int CTRL> __device__ __forceinline__ float dppf(float v) { return __uint_as_float(__builtin_amdgcn_update_dpp(0u, __float_as_uint(v), CTRL, 0xF, 0xF, true)); }
__device__ __forceinline__ float red8(float v) { v += dppf<0xB1>(v); v += dppf<0x4E>(v); v += dppf<0x141>(v); return v; }
__device__ __forceinline__ float red16d(float v) { v += dppf<0xB1>(v); v += dppf<0x4E>(v); v += dppf<0x141>(v); v += dppf<0x140>(v); return v; }

struct ScanPre { u32x2 r, k, v, lw, la, g; };
struct ScanKeep { f32x4 v; float bon; u32x2 g; };
struct ScanConst { f32x4 kk, ka, rk, lg, lb, w0, a0; };
constexpr int SC_BUF = 12416;

__device__ __forceinline__ void scan_load(ScanPre& q, const bf16_t* RKV, const bf16_t* LO, size_t row, int hc) {
    q.r = *(const u32x2*)(RKV + row * 1536 + hc); q.k = *(const u32x2*)(RKV + row * 1536 + 512 + hc); q.v = *(const u32x2*)(RKV + row * 1536 + 1024 + hc);
    q.lw = *(const u32x2*)(LO + row * 1536 + hc); q.la = *(const u32x2*)(LO + row * 1536 + 512 + hc); q.g = *(const u32x2*)(LO + row * 1536 + 1024 + hc);
}
__device__ __forceinline__ void scan_stage_a(const ScanPre& q, const ScanConst& C, LAS float* buf, int tt, int dq, ScanKeep& keep) {
    const f32x4 r = {bflo(q.r.x), bfhi(q.r.x), bflo(q.r.y), bfhi(q.r.y)}, k = {bflo(q.k.x), bfhi(q.k.x), bflo(q.k.y), bfhi(q.k.y)}, v = {bflo(q.v.x), bfhi(q.v.x), bflo(q.v.y), bfhi(q.v.y)};
    const f32x4 lw = (f32x4){bflo(q.lw.x), bfhi(q.lw.x), bflo(q.lw.y), bfhi(q.lw.y)} + C.w0, la = (f32x4){bflo(q.la.x), bfhi(q.la.x), bflo(q.la.y), bfhi(q.la.y)} + C.a0;
    f32x4 w, a;
#pragma unroll
    for (int c = 0; c < 4; ++c) { w[c] = __expf(-0.6065306597126334f * sigmoidf_(lw[c])); a[c] = sigmoidf_(la[c]); }
    const f32x4 kkr = k * C.kk;
    const float ss = red16d((kkr[0] * kkr[0] + kkr[1] * kkr[1]) + (kkr[2] * kkr[2] + kkr[3] * kkr[3]));
    const float inv = 1.0f / fmaxf(sqrtf(ss), 1e-12f);
    const f32x4 kk = kkr * inv;
    const f32x4 keff = k * (1.0f + (a - 1.0f) * C.ka);
    const f32x4 bb = a * kk, wr = w * r;
    const f32x4 t1 = bb * r, t2 = keff * r, t3 = t2 * C.rk;
    const float br = red16d((t1[0] + t1[1]) + (t1[2] + t1[3])), kr = red16d((t2[0] + t2[1]) + (t2[2] + t2[3])), bon = red16d((t3[0] + t3[1]) + (t3[2] + t3[3]));
    const int o = tt * 64 + 4 * dq;
    *(LAS f32x4*)(buf + o) = w; *(LAS f32x4*)(buf + 2048 + o) = bb; *(LAS f32x4*)(buf + 4096 + o) = keff; *(LAS f32x4*)(buf + 6144 + o) = kk; *(LAS f32x4*)(buf + 8192 + o) = wr; *(LAS f32x4*)(buf + 10240 + o) = v;
    if (dq == 0) *(LAS f32x4*)(buf + 12288 + tt * 4) = (f32x4){br, kr, bon, 0.f};
    keep.v = v; keep.bon = bon; keep.g = q.g;
}

struct ScanVec { f32x4 k0, k1, q0, q1, w0, w1, b0, b1, e0, e1, sc; float vi0, vi1; };
#define SV_DSR128(dst, addr, off) asm volatile("ds_read_b128 %0, %1 offset:" #off : "=v"(dst) : "v"(addr))
#define SV_DSR32(dst, addr, off) asm volatile("ds_read_b32 %0, %1 offset:" #off : "=v"(dst) : "v"(addr))
__device__ __forceinline__ void sv_issue(ScanVec& s, unsigned a_vec, unsigned a_sc, unsigned a_v) {
    SV_DSR128(s.k0, a_vec, 24576); SV_DSR128(s.k1, a_vec, 24592); SV_DSR128(s.q0, a_vec, 32768); SV_DSR128(s.q1, a_vec, 32784);
    SV_DSR128(s.sc, a_sc, 49152); SV_DSR32(s.vi0, a_v, 40960); SV_DSR32(s.vi1, a_v, 41088);
    SV_DSR128(s.w0, a_vec, 0); SV_DSR128(s.w1, a_vec, 16); SV_DSR128(s.b0, a_vec, 8192); SV_DSR128(s.b1, a_vec, 8208);
    SV_DSR128(s.e0, a_vec, 16384); SV_DSR128(s.e1, a_vec, 16400);
}
__device__ __forceinline__ void sv_wait(ScanVec& s) {
    asm volatile("s_waitcnt lgkmcnt(0)" : "+v"(s.k0), "+v"(s.k1), "+v"(s.q0), "+v"(s.q1), "+v"(s.w0), "+v"(s.w1), "+v"(s.b0), "+v"(s.b1), "+v"(s.e0), "+v"(s.e1), "+v"(s.sc), "+v"(s.vi0), "+v"(s.vi1));
}
__device__ __forceinline__ f32x2 lo2(f32x4 v) { return __builtin_shufflevector(v, v, 0, 1); }
__device__ __forceinline__ f32x2 hi2(f32x4 v) { return __builtin_shufflevector(v, v, 2, 3); }
__device__ __forceinline__ f32x2 fma2(f32x2 a, f32x2 b, f32x2 c) { return __builtin_elementwise_fma(a, b, c); }
__device__ __forceinline__ float sv_row(f32x2 (&S)[4], const ScanVec& s, float vi) {
    f32x2 a1 = S[0] * lo2(s.k0), a2 = S[0] * lo2(s.q0);
    a1 = fma2(S[1], hi2(s.k0), a1); a2 = fma2(S[1], hi2(s.q0), a2);
    a1 = fma2(S[2], lo2(s.k1), a1); a2 = fma2(S[2], lo2(s.q1), a2);
    a1 = fma2(S[3], hi2(s.k1), a1); a2 = fma2(S[3], hi2(s.q1), a2);
    const float d1 = red8(a1.x + a1.y), d2 = red8(a2.x + a2.y);
    const float sa = -d1;
    const float y = d2 + sa * s.sc[0] + vi * s.sc[1];
    const f32x2 sa2 = {sa, sa}, vi2 = {vi, vi};
    S[0] = fma2(S[0], lo2(s.w0), fma2(sa2, lo2(s.b0), vi2 * lo2(s.e0)));
    S[1] = fma2(S[1], hi2(s.w0), fma2(sa2, hi2(s.b0), vi2 * hi2(s.e0)));
    S[2] = fma2(S[2], lo2(s.w1), fma2(sa2, lo2(s.b1), vi2 * lo2(s.e1)));
    S[3] = fma2(S[3], hi2(s.w1), fma2(sa2, hi2(s.b1), vi2 * hi2(s.e1)));
    return y;
}
__device__ __forceinline__ void sv_step(f32x2 (&S0)[4], f32x2 (&S1)[4], const ScanVec& s, LAS float* Yc, int t, int i2, int j) {
    const float y0 = sv_row(S0, s, s.vi0), y1 = sv_row(S1, s, s.vi1);
    if (j == 0) { Yc[t * 64 + i2] = y0; Yc[t * 64 + 32 + i2] = y1; }
}
__device__ __forceinline__ void scan_stage_c(const ScanConst& C, const LAS float* buf, const LAS float* Yc, int tl, int dq, bool valid, u32x2 graw, bf16_t* dst) {
    const f32x4 y = *(const LAS f32x4*)(Yc + tl * 64 + 4 * dq);
    const float mean = red16d((y[0] + y[1]) + (y[2] + y[3])) * (1.0f / 64.0f);
    const f32x4 d = y - mean;
    const float var = red16d((d[0] * d[0] + d[1] * d[1]) + (d[2] * d[2] + d[3] * d[3])) * (1.0f / 64.0f);
    const f32x4 v = *(const LAS f32x4*)(buf + 10240 + tl * 64 + 4 * dq);
    const float bon = buf[12288 + tl * 4 + 2];
    if (valid) {
        const float rstd = rsqrtf(var + LNX_EPS);
        const f32x4 g = {bflo(graw.x), bfhi(graw.x), bflo(graw.y), bfhi(graw.y)};
        const f32x4 o = (d * rstd * C.lg + C.lb + v * bon) * g;
        u32x2 w; w.x = pk2(o[0], o[1]); w.y = pk2(o[2], o[3]);
        *(u32x2*)dst = w;
    }
}

constexpr int BG_PER_UNIT = 20480;
constexpr size_t BG_NV1 = (size_t)NB * PAST * 128 / 4;
__device__ __forceinline__ bool bg_load(const P& p, int uu, int li, f32x4& v) {
    if (uu < 0 || li >= BG_PER_UNIT) return false;
    const size_t g = (size_t)uu * BG_PER_UNIT + li;
    v = g < BG_NV1 ? *(const f32x4*)(p.ckv + g * 4) : *(const f32x4*)(p.ckr + (g - BG_NV1) * 4);
    return true;
}
__device__ __forceinline__ void bg_store(const P& p, int uu, int li, const f32x4& v) {
    const size_t g = (size_t)uu * BG_PER_UNIT + li;
    u32x2 w; w.x = pk2(v[0], v[1]); w.y = pk2(v[2], v[3]);
    if (g < BG_NV1) { const size_t idx = g * 4; const int b = (int)(idx / ((size_t)PAST * 128)); const size_t rem = idx - (size_t)b * PAST * 128;
        *(u32x2*)((bf16_t*)(p.ws + WS_CALL) + ((size_t)MKP + (size_t)b * KSAMP) * 128 + rem) = w; }
    else { const size_t idx = (g - BG_NV1) * 4; const int b = (int)(idx / ((size_t)PAST * 32)); const size_t rem = idx - (size_t)b * PAST * 32;
        *(u32x2*)((bf16_t*)(p.ws + WS_KRALL) + ((size_t)MKP + (size_t)b * KSAMP) * 32 + rem) = w; }
}

typedef __bf16 bf16x2_bg __attribute__((ext_vector_type(2)));
__device__ __forceinline__ unsigned pk2c(float lo, float hi) { const f32x2 v = {lo, hi}; const bf16x2_bg b = __builtin_convertvector(v, bf16x2_bg); return __builtin_bit_cast(unsigned, b); }
__device__ __forceinline__ float xhalf_sum(float v) { const auto rr = __builtin_amdgcn_permlane32_swap(__float_as_uint(v), __float_as_uint(v), false, false); return __uint_as_float(rr[0]) + __uint_as_float(rr[1]); }
__device__ __forceinline__ void bg_kv_tile(const P& p, const LAS unsigned char* Wimg, int b, int h, int tile, int lane) {
    const int q = lane & 31, hi = lane >> 5;
    const bf16_t* CA = (const bf16_t*)(p.ws + WS_CALL); bf16_t* KN = (bf16_t*)(p.ws + WS_KN); bf16_t* Vb = (bf16_t*)(p.ws + WS_V);
    const size_t rk = (size_t)b * KPB + 32 * (size_t)tile + q;
    bf16x8 cf[8];
#pragma unroll
    for (int i = 0; i < 8; ++i) cf[i] = *(const bf16x8*)(CA + rk * 128 + 16 * i + 8 * hi);
    {
        f32x16 k0, k1;
#pragma unroll
        for (int r = 0; r < 16; ++r) { k0[r] = 0.f; k1[r] = 0.f; }
#pragma unroll
        for (int i = 0; i < 8; ++i) {
            const bf16x8 w0 = *(const LAS bf16x8*)(Wimg + q * 272 + (16 * i + 8 * hi) * 2), w1 = *(const LAS bf16x8*)(Wimg + (32 + q) * 272 + (16 * i + 8 * hi) * 2);
            k0 = __builtin_amdgcn_mfma_f32_32x32x16_bf16(w0, cf[i], k0, 0, 0, 0); k1 = __builtin_amdgcn_mfma_f32_32x32x16_bf16(w1, cf[i], k1, 0, 0, 0); }
        float ss = 0.f;
#pragma unroll
        for (int r = 0; r < 16; ++r) ss += k0[r] * k0[r] + k1[r] * k1[r];
        const float rs = rsqrtf(xhalf_sum(ss) * (1.0f / 64.0f) + EPS);
        bf16_t* dst = KN + rk * 512 + h * 64 + 4 * hi;
#pragma unroll
        for (int rg = 0; rg < 4; ++rg) {
            u32x2 a; a.x = pk2c(k0[4 * rg] * rs, k0[4 * rg + 1] * rs); a.y = pk2c(k0[4 * rg + 2] * rs, k0[4 * rg + 3] * rs); *(u32x2*)(dst + 8 * rg) = a;
            u32x2 c; c.x = pk2c(k1[4 * rg] * rs, k1[4 * rg + 1] * rs); c.y = pk2c(k1[4 * rg + 2] * rs, k1[4 * rg + 3] * rs); *(u32x2*)(dst + 32 + 8 * rg) = c; }
    }
    {
        f32x16 v0, v1;
#pragma unroll
        for (int r = 0; r < 16; ++r) { v0[r] = 0.f; v1[r] = 0.f; }
#pragma unroll
        for (int i = 0; i < 8; ++i) {
            const bf16x8 w0 = *(const LAS bf16x8*)(Wimg + (64 + q) * 272 + (16 * i + 8 * hi) * 2), w1 = *(const LAS bf16x8*)(Wimg + (96 + q) * 272 + (16 * i + 8 * hi) * 2);
            v0 = __builtin_amdgcn_mfma_f32_32x32x16_bf16(w0, cf[i], v0, 0, 0, 0); v1 = __builtin_amdgcn_mfma_f32_32x32x16_bf16(w1, cf[i], v1, 0, 0, 0); }
        bf16_t* dst = Vb + rk * 512 + h * 64 + 4 * hi;
#pragma unroll
        for (int rg = 0; rg < 4; ++rg) {
            u32x2 a; a.x = pk2c(v0[4 * rg], v0[4 * rg + 1]); a.y = pk2c(v0[4 * rg + 2], v0[4 * rg + 3]); *(u32x2*)(dst + 8 * rg) = a;
            u32x2 c; c.x = pk2c(v1[4 * rg], v1[4 * rg + 1]); c.y = pk2c(v1[4 * rg + 2], v1[4 * rg + 3]); *(u32x2*)(dst + 32 + 8 * rg) = c; }
    }
}
constexpr int SC_WIMG_OFF = (2 * SC_BUF + 2 * 2048) * 4;

__device__ __forceinline__ void scan_unit(const P& p, int wv, LAS unsigned char* lds, int row1_base, int nsteps, const float* s0, float* s_out, int first_out, int row2_base, int h, int bg_unit) {
    const int tid_l = wv * 64 + lane_id(); const int tid = tid_l;
    const bool is_rec = tid < 256;
    LAS float* BUF = (LAS float*)lds;
    LAS float* Y = BUF + 2 * SC_BUF;
    const bf16_t* RKV = (const bf16_t*)(p.ws + WS_RKV); const bf16_t* LO = (const bf16_t*)(p.ws + WS_E);
    bf16_t* MIX = (bf16_t*)(p.ws + WS_MIX);
    const int nch = (nsteps + 31) >> 5;
    __syncthreads();
    if (is_rec) {
        const int i2 = tid >> 3, j = tid & 7;
        f32x2 S0[4], S1[4];
        if (s0) { const f32x4 a = *(const f32x4*)(s0 + i2 * 64 + 8 * j), b = *(const f32x4*)(s0 + i2 * 64 + 8 * j + 4), c = *(const f32x4*)(s0 + (i2 + 32) * 64 + 8 * j), d = *(const f32x4*)(s0 + (i2 + 32) * 64 + 8 * j + 4);
            S0[0] = lo2(a); S0[1] = hi2(a); S0[2] = lo2(b); S0[3] = hi2(b); S1[0] = lo2(c); S1[1] = hi2(c); S1[2] = lo2(d); S1[3] = hi2(d); }
        else {
#pragma unroll
            for (int cc = 0; cc < 4; ++cc) { S0[cc] = (f32x2){0.f, 0.f}; S1[cc] = (f32x2){0.f, 0.f}; } }
        const unsigned lbase = (unsigned)(unsigned long long)BUF;
        __syncthreads();
        for (int c = 0; c < nch; ++c) {
            const int c0 = c * 32, T = (nsteps - c0) < 32 ? (nsteps - c0) : 32;
            LAS float* Yc = Y + (c & 1) * 2048;
            const unsigned bb = lbase + (unsigned)(c & 1) * (SC_BUF * 4u);
            unsigned a_vec = bb + 32u * j, a_sc = bb, a_v = bb + 4u * i2;
            ScanVec va, vb;
            sv_issue(va, a_vec, a_sc, a_v); sv_wait(va);
            for (int t = 0; t < T; t += 2) {
                sv_issue(vb, a_vec + 256u, a_sc + 16u, a_v + 256u);
                sv_step(S0, S1, va, Yc, t, i2, j);
                sv_wait(vb);
                const unsigned adv = (t + 2 < T) ? 2u : 1u;
                a_vec += 256u * adv; a_sc += 16u * adv; a_v += 256u * adv;
                sv_issue(va, a_vec, a_sc, a_v);
                sv_step(S0, S1, vb, Yc, t + 1, i2, j);
                sv_wait(va);
            }
            __syncthreads();
        }
        float* so = s_out + i2 * 64 + 8 * j;
        *(f32x4*)so = (f32x4){S0[0].x, S0[0].y, S0[1].x, S0[1].y}; *(f32x4*)(so + 4) = (f32x4){S0[2].x, S0[2].y, S0[3].x, S0[3].y};
        *(f32x4*)(so + 2048) = (f32x4){S1[0].x, S1[0].y, S1[1].x, S1[1].y}; *(f32x4*)(so + 2052) = (f32x4){S1[2].x, S1[2].y, S1[3].x, S1[3].y};
    } else {
        const int ptid = tid - 256, tt = ptid >> 4, dq = ptid & 15, hc = h * 64 + 4 * dq;
        ScanConst C;
        C.kk = *(const f32x4*)(p.k_k + hc); C.ka = *(const f32x4*)(p.k_a + hc); C.rk = *(const f32x4*)(p.r_k + hc);
        C.lg = *(const f32x4*)(p.lnx_g + hc); C.lb = *(const f32x4*)(p.lnx_b + hc); C.w0 = *(const f32x4*)(p.w0 + hc); C.a0 = *(const f32x4*)(p.a0 + hc);
        ScanPre pa, pb; ScanKeep kdummy;
        pa.r = pa.k = pa.v = pa.lw = pa.la = pa.g = (u32x2){0u, 0u}; pb = pa;
        if (tt < nsteps) scan_load(pa, RKV, LO, (size_t)(row1_base + tt), hc);
        if (tt + 16 < nsteps) scan_load(pb, RKV, LO, (size_t)(row1_base + tt + 16), hc);
        if (tt < nsteps) scan_stage_a(pa, C, BUF, tt, dq, kdummy);
        if (tt + 16 < nsteps) scan_stage_a(pb, C, BUF, tt + 16, dq, kdummy);
        if (32 + tt < nsteps) scan_load(pa, RKV, LO, (size_t)(row1_base + 32 + tt), hc);
        if (48 + tt < nsteps) scan_load(pb, RKV, LO, (size_t)(row1_base + 48 + tt), hc);
        const LAS unsigned char* Wimg = lds + SC_WIMG_OFF;
        if (bg_unit >= 0) {
            const bf16_t* WKV = (const bf16_t*)(p.ws + WS_WKV);
            for (int e = ptid; e < 128 * 16; e += 256) { const int jr = e >> 4, ch = e & 15, d = jr & 63, slot = (jr < 64) ? h : 8 + h;
                const int prow = 256 * (slot >> 2) + 128 * (d >> 5) + 32 * (slot & 3) + (d & 31);
                *(LAS u32x4*)(lds + SC_WIMG_OFF + jr * 272 + ch * 16) = *(const u32x4*)(WKV + (size_t)prow * 128 + 8 * ch); } }
        __syncthreads();
        for (int c = 0; c < nch; ++c) {
            const int c0 = c * 32;
            f32x4 bg0, bg1; const int bgl0 = (2 * c) * 256 + ptid, bgl1 = (2 * c + 1) * 256 + ptid;
            const bool hb0 = bg_load(p, bg_unit, bgl0, bg0), hb1 = bg_load(p, bg_unit, bgl1, bg1);
            if (c >= 1) {
                const int pc0 = c0 - 32; const LAS float* bufp = BUF + ((c - 1) & 1) * SC_BUF; const LAS float* Yp = Y + ((c - 1) & 1) * 2048;
                const int tok0 = pc0 + tt, tok1 = pc0 + tt + 16;
                const bool v0 = tok0 >= first_out, v1 = tok1 >= first_out;
                u32x2 g0 = {0u, 0u}, g1 = {0u, 0u};
                if (v0) g0 = *(const u32x2*)(LO + (size_t)(row1_base + tok0) * 1536 + 1024 + hc);
                if (v1) g1 = *(const u32x2*)(LO + (size_t)(row1_base + tok1) * 1536 + 1024 + hc);
                scan_stage_c(C, bufp, Yp, tt, dq, v0, g0, MIX + (size_t)(row2_base + tok0 - first_out) * 1024 + 512 + hc);
                scan_stage_c(C, bufp, Yp, tt + 16, dq, v1, g1, MIX + (size_t)(row2_base + tok1 - first_out) * 1024 + 512 + hc);
            }
            if (c0 + 32 + tt < nsteps) scan_stage_a(pa, C, BUF + ((c + 1) & 1) * SC_BUF, tt, dq, kdummy);
            if (c0 + 48 + tt < nsteps) scan_stage_a(pb, C, BUF + ((c + 1) & 1) * SC_BUF, tt + 16, dq, kdummy);
            if (c0 + 64 + tt < nsteps) scan_load(pa, RKV, LO, (size_t)(row1_base + c0 + 64 + tt), hc);
            if (c0 + 80 + tt < nsteps) scan_load(pb, RKV, LO, (size_t)(row1_base + c0 + 80 + tt), hc);
            if (hb0) bg_store(p, bg_unit, bgl0, bg0);
            if (hb1) bg_store(p, bg_unit, bgl1, bg1);
            if (bg_unit >= 0 && (c % 3) == 0) {
                const int pw = ptid >> 6, tile = pw + 4 * (c / 3);
                if (tile < KPB / 32) bg_kv_tile(p, Wimg, bg_unit >> 3, h, tile, ptid & 63);
            }
            __syncthreads();
        }
        {
            const int c = nch - 1, pc0 = c * 32, T = nsteps - pc0; const LAS float* bufp = BUF + (c & 1) * SC_BUF; const LAS float* Yp = Y + (c & 1) * 2048;
            const int tok0 = pc0 + tt, tok1 = pc0 + tt + 16;
            const bool v0 = tt < T && tok0 >= first_out, v1 = tt + 16 < T && tok1 >= first_out;
            u32x2 g0 = {0u, 0u}, g1 = {0u, 0u};
            if (v0) g0 = *(const u32x2*)(LO + (size_t)(row1_base + tok0) * 1536 + 1024 + hc);
            if (v1) g1 = *(const u32x2*)(LO + (size_t)(row1_base + tok1) * 1536 + 1024 + hc);
            scan_stage_c(C, bufp, Yp, tt, dq, v0, g0, MIX + (size_t)(row2_base + tok0 - first_out) * 1024 + 512 + hc);
            scan_stage_c(C, bufp, Yp, tt + 16, dq, v1, g1, MIX + (size_t)(row2_base + tok1 - first_out) * 1024 + 512 + hc);
        }
    }
}
__device__ __forceinline__ void phase_scan(const P& p, int wv, LAS unsigned char* lds) {
    for (int u = blockIdx.x; u < 512; u += gridDim.x) {
        const int uu = u & 255, b = uu >> 3, h = uu & 7;
        if (u < 256) scan_unit(p, wv, lds, b * LP, LP, nullptr, p.out + OFF_WKVP + (size_t)uu * 4096, NMETA, b * SEQ, h, uu);
        else scan_unit(p, wv, lds, MP + b * DSQ, DSQ, p.swkv + (size_t)uu * 4096, p.out + OFF_WKVS + (size_t)uu * 4096, 0, M2P + b * DSQ, h, -1);
    }
}

__device__ __forceinline__ int crow(int r, int hi) { return (r & 3) + 8 * (r >> 2) + 4 * hi; }
constexpr float ATT_THR = 12.0f;
__device__ __forceinline__ float xhalf_max(float v) { const auto rr = __builtin_amdgcn_permlane32_swap(__float_as_uint(v), __float_as_uint(v), false, false); return fmaxf(__uint_as_float(rr[0]), __uint_as_float(rr[1])); }
__device__ __forceinline__ void att_blk(const LAS unsigned char* Kc, const LAS unsigned char* Vimg, const bf16x8 (&qf)[6], float& m, float& l, f32x16 (&O)[2], int lane, int nmask) {
    const int q = lane & 31, hi = lane >> 5;
    f32x16 s; const float nm = -m;
#pragma unroll
    for (int r = 0; r < 16; ++r) s[r] = nm;
#pragma unroll
    for (int i = 0; i < 6; ++i) { const bf16x8 kf = *(const LAS bf16x8*)(Kc + q * 208 + (16 * i + 8 * hi) * 2); s = __builtin_amdgcn_mfma_f32_32x32x16_bf16(kf, qf[i], s, 0, 0, 0); }
    if (nmask > 0) {
#pragma unroll
        for (int r = 0; r < 16; ++r) if (crow(r, hi) < nmask) s[r] = -1e30f; }
    float mx = fmaxf(s[0], s[1]);
#pragma unroll
    for (int r = 2; r < 16; r += 2) mx = fmaxf(fmaxf(mx, s[r]), s[r + 1]);
    if (__builtin_amdgcn_ballot_w64(mx > ATT_THR) != 0ull) {
        const float delta = fmaxf(xhalf_max(mx), 0.f), alpha = __builtin_amdgcn_exp2f(-delta);
        m += delta; l *= alpha;
#pragma unroll
        for (int r = 0; r < 16; ++r) { O[0][r] *= alpha; O[1][r] *= alpha; s[r] -= delta; }
    }
    float rsum = 0.f;
#pragma unroll
    for (int r = 0; r < 16; ++r) { s[r] = __builtin_amdgcn_exp2f(s[r]); rsum += s[r]; }
    l += rsum;
    bf16x8 pb[2];
#pragma unroll
    for (int i = 0; i < 2; ++i) { u32x4 w; w.x = pk2(s[8 * i + 0], s[8 * i + 1]); w.y = pk2(s[8 * i + 2], s[8 * i + 3]); w.z = pk2(s[8 * i + 4], s[8 * i + 5]); w.w = pk2(s[8 * i + 6], s[8 * i + 7]);
        pb[i] = __builtin_bit_cast(bf16x8, w); }
    typedef short v4i16_t __attribute__((ext_vector_type(4)));
    const int li = lane & 15, g16 = lane >> 4;
    const LAS unsigned char* vb = Vimg + (4 * hi + (li >> 2)) * 192 + (16 * (g16 & 1) + 4 * (li & 3)) * 2;
#pragma unroll
    for (int db = 0; db < 2; ++db)
#pragma unroll
        for (int i = 0; i < 2; ++i) {
            const v4i16_t lo = __builtin_amdgcn_ds_read_tr16_b64_v4i16((LAS v4i16_t*)(vb + (16 * i) * 192 + 64 * db));
            const v4i16_t hh = __builtin_amdgcn_ds_read_tr16_b64_v4i16((LAS v4i16_t*)(vb + (16 * i + 8) * 192 + 64 * db));
            const bf16x8 vf = {lo[0], lo[1], lo[2], lo[3], hh[0], hh[1], hh[2], hh[3]};
            O[db] = __builtin_amdgcn_mfma_f32_32x32x16_bf16(vf, pb[i], O[db], 0, 0, 0); }
}
__device__ __forceinline__ void att_tile64(const LAS unsigned char* Kc, const LAS unsigned char* Vimg, const bf16x8 (&qf)[6], float& m, float& l, f32x16 (&O)[2], int lane) {
    const int q = lane & 31, hi = lane >> 5;
    f32x16 s0, s1; const float nm = -m;
#pragma unroll
    for (int r = 0; r < 16; ++r) { s0[r] = nm; s1[r] = nm; }
#pragma unroll
    for (int i = 0; i < 6; ++i) {
        const bf16x8 k0 = *(const LAS bf16x8*)(Kc + q * 208 + (16 * i + 8 * hi) * 2), k1 = *(const LAS bf16x8*)(Kc + (32 + q) * 208 + (16 * i + 8 * hi) * 2);
        s0 = __builtin_amdgcn_mfma_f32_32x32x16_bf16(k0, qf[i], s0, 0, 0, 0); s1 = __builtin_amdgcn_mfma_f32_32x32x16_bf16(k1, qf[i], s1, 0, 0, 0); }
    float mx = fmaxf(s0[0], s1[0]);
#pragma unroll
    for (int r = 1; r < 16; ++r) mx = fmaxf(fmaxf(mx, s0[r]), s1[r]);
    if (__builtin_amdgcn_ballot_w64(mx > ATT_THR) != 0ull) {
        const float delta = fmaxf(xhalf_max(mx), 0.f), alpha = __builtin_amdgcn_exp2f(-delta);
        m += delta; l *= alpha;
#pragma unroll
        for (int r = 0; r < 16; ++r) { O[0][r] *= alpha; O[1][r] *= alpha; s0[r] -= delta; s1[r] -= delta; }
    }
    float rs0 = 0.f, rs1 = 0.f;
#pragma unroll
    for (int r = 0; r < 16; ++r) { s0[r] = __builtin_amdgcn_exp2f(s0[r]); s1[r] = __builtin_amdgcn_exp2f(s1[r]); rs0 += s0[r]; rs1 += s1[r]; }
    l += rs0 + rs1;
    bf16x8 pb[4];
#pragma unroll
    for (int i = 0; i < 2; ++i) { u32x4 w; w.x = pk2(s0[8 * i + 0], s0[8 * i + 1]); w.y = pk2(s0[8 * i + 2], s0[8 * i + 3]); w.z = pk2(s0[8 * i + 4], s0[8 * i + 5]); w.w = pk2(s0[8 * i + 6], s0[8 * i + 7]);
        pb[i] = __builtin_bit_cast(bf16x8, w);
        u32x4 x; x.x = pk2(s1[8 * i + 0], s1[8 * i + 1]); x.y = pk2(s1[8 * i + 2], s1[8 * i + 3]); x.z = pk2(s1[8 * i + 4], s1[8 * i + 5]); x.w = pk2(s1[8 * i + 6], s1[8 * i + 7]);
        pb[2 + i] = __builtin_bit_cast(bf16x8, x); }
    typedef short v4i16_t __attribute__((ext_vector_type(4)));
    const int li = lane & 15, g16 = lane >> 4;
    const LAS unsigned char* vb = Vimg + (4 * hi + (li >> 2)) * 192 + (16 * (g16 & 1) + 4 * (li & 3)) * 2;
#pragma unroll
    for (int i = 0; i < 4; ++i)
#pragma unroll
        for (int db = 0; db < 2; ++db) {
            const v4i16_t lo = __builtin_amdgcn_ds_read_tr16_b64_v4i16((LAS v4i16_t*)(vb + (16 * i) * 192 + 64 * db));
            const v4i16_t hh = __builtin_amdgcn_ds_read_tr16_b64_v4i16((LAS v4i16_t*)(vb + (16 * i + 8) * 192 + 64 * db));
            const bf16x8 vf = {lo[0], lo[1], lo[2], lo[3], hh[0], hh[1], hh[2], hh[3]};
            O[db] = __builtin_amdgcn_mfma_f32_32x32x16_bf16(vf, pb[i], O[db], 0, 0, 0); }
}
__device__ __forceinline__ int kpos(int key) { return (key & ~12) | ((key & 4) << 1) | ((key & 8) >> 1); }

__device__ __forceinline__ void load_q(bf16x8 (&qf)[6], const bf16_t* qrow, float pos, const float* gn, const float* gr, const float* gkn, int hi) {
    float x[6][8];
#pragma unroll
    for (int i = 0; i < 6; ++i) { const u32x4 raw = *(const u32x4*)(qrow + 16 * i + 8 * hi);
        x[i][0] = bflo(raw.x); x[i][1] = bfhi(raw.x); x[i][2] = bflo(raw.y); x[i][3] = bfhi(raw.y); x[i][4] = bflo(raw.z); x[i][5] = bfhi(raw.z); x[i][6] = bflo(raw.w); x[i][7] = bfhi(raw.w); }
    float ssn = 0.f, ssr = 0.f;
#pragma unroll
    for (int i = 0; i < 4; ++i)
#pragma unroll
        for (int e = 0; e < 8; ++e) ssn += x[i][e] * x[i][e];
#pragma unroll
    for (int i = 4; i < 6; ++i)
#pragma unroll
        for (int e = 0; e < 8; ++e) ssr += x[i][e] * x[i][e];
    ssn += __shfl_xor(ssn, 32); ssr += __shfl_xor(ssr, 32);
    const float rsn = rsqrtf(ssn * (1.0f / 64.0f) + EPS) * QSCALE, rsr = rsqrtf(ssr * (1.0f / 32.0f) + EPS) * QSCALE;
#pragma unroll
    for (int i = 0; i < 4; ++i) { float o[8];
#pragma unroll
        for (int e = 0; e < 8; ++e) o[e] = x[i][e] * rsn * (gn[16 * i + 8 * hi + e] * gkn[16 * i + 8 * hi + e]);
        u32x4 w; w.x = pk2(o[0], o[1]); w.y = pk2(o[2], o[3]); w.z = pk2(o[4], o[5]); w.w = pk2(o[6], o[7]); qf[i] = __builtin_bit_cast(bf16x8, w); }
    float o1[8], o2[8];
#pragma unroll
    for (int e = 0; e < 8; ++e) { const int j = 8 * hi + e; float c, s; rope_cs(pos, j, c, s);
        const float x1 = x[4][e] * rsr * gr[j], x2 = x[5][e] * rsr * gr[16 + j];
        o1[e] = x1 * c - x2 * s; o2[e] = x1 * s + x2 * c; }
    { u32x4 w; w.x = pk2(o1[0], o1[1]); w.y = pk2(o1[2], o1[3]); w.z = pk2(o1[4], o1[5]); w.w = pk2(o1[6], o1[7]); qf[4] = __builtin_bit_cast(bf16x8, w); }
    { u32x4 w; w.x = pk2(o2[0], o2[1]); w.y = pk2(o2[2], o2[3]); w.z = pk2(o2[4], o2[5]); w.w = pk2(o2[6], o2[7]); qf[5] = __builtin_bit_cast(bf16x8, w); }
}

constexpr int AT_KB = 64 * 208, AT_VB = 64 * 192, AT_BUF = AT_KB + AT_VB;
__device__ __forceinline__ void attn_prompt_unit(const P& p, int wv, LAS unsigned char* lds, int b, int h) {
    const int tid_l = wv * 64 + lane_id(); const int tid = tid_l, lane = tid & 63, w = tid >> 6, q = lane & 31, hi = lane >> 5;
    const bf16_t* Qb = (const bf16_t*)(p.ws + WS_Q); const bf16_t* KN = (const bf16_t*)(p.ws + WS_KN); const bf16_t* Vb = (const bf16_t*)(p.ws + WS_V);
    const bf16_t* KR = (const bf16_t*)(p.ws + WS_KRALL); bf16_t* ATT = (bf16_t*)(p.ws + WS_ATT);
    const int key = tid >> 3, part = tid & 7, key2 = tid >> 2, part2 = tid & 3;
    const size_t rowk_b = (size_t)b * KPB;
    for (int qt = 0; qt < 8; ++qt) {
        const size_t row1 = (size_t)b * LP + NMETA + 256 * qt + 32 * w + q;
        bf16x8 qf[6];
        load_q(qf, Qb + row1 * 768 + h * 96, (float)(NMETA + 256 * qt + 32 * w + q), p.g_qn, p.g_qr, p.g_kn, hi);
        const int cmax = 4 * qt + (w >> 1) + 1, ntile = 4 * qt + 5;
        float m = 0.f, l = 0.f; f32x16 O[2];
#pragma unroll
        for (int r = 0; r < 16; ++r) { O[0][r] = 0.f; O[1][r] = 0.f; }
        u32x4 rkn0, rkr0, rv0, rkn1, rkr1, rv1;
        rkr0 = rkr1 = (u32x4){0u, 0u, 0u, 0u};
#define AT_LOAD(S, JT) do { const size_t rk_ = rowk_b + 64 * (size_t)(JT); \
            rkn##S = *(const u32x4*)(KN + (rk_ + key) * 512 + h * 64 + 8 * part); rv##S = *(const u32x4*)(Vb + (rk_ + key) * 512 + h * 64 + 8 * part); \
            if (tid < 256) rkr##S = *(const u32x4*)(KR + (rk_ + key2) * 32 + 8 * part2); } while (0)
#define AT_STAGE(S, BUFI) do { LAS unsigned char* Kc_ = lds + (BUFI) * AT_BUF; LAS unsigned char* VT_ = Kc_ + AT_KB; \
            *(LAS u32x4*)(Kc_ + key * 208 + part * 16) = rkn##S; if (tid < 256) *(LAS u32x4*)(Kc_ + key2 * 208 + 128 + part2 * 16) = rkr##S; \
            *(LAS u32x4*)(VT_ + key * 192 + part * 16) = rv##S; } while (0)
#define AT_COMPUTE(JT, BUFI) do { if ((JT) <= cmax) { const LAS unsigned char* Kc_ = lds + (BUFI) * AT_BUF; const LAS unsigned char* VT_ = Kc_ + AT_KB; \
            if ((JT) > 0) att_tile64(Kc_, VT_, qf, m, l, O, lane); else att_blk(Kc_ + 32 * 208, VT_ + 32 * 192, qf, m, l, O, lane, 16); } } while (0)
        AT_LOAD(0, 0); AT_LOAD(1, 1);
        for (int jt = 0; jt < ntile; jt += 2) {
            AT_STAGE(0, 0);
            if (jt + 2 < ntile) AT_LOAD(0, jt + 2);
            __syncthreads();
            AT_COMPUTE(jt, 0);
            if (jt + 1 < ntile) {
                AT_STAGE(1, 1);
                if (jt + 3 < ntile) AT_LOAD(1, jt + 3);
                __syncthreads();
                AT_COMPUTE(jt + 1, 1);
            }
        }
#undef AT_LOAD
#undef AT_STAGE
#undef AT_COMPUTE
        __syncthreads();
        const float il = 1.0f / xhalf_sum(l);
        const size_t row2 = (size_t)b * SEQ + 256 * qt + 32 * w + q;
#pragma unroll
        for (int db = 0; db < 2; ++db)
#pragma unroll
            for (int rg = 0; rg < 4; ++rg) { u32x2 wv; wv.x = pk2(O[db][4 * rg] * il, O[db][4 * rg + 1] * il); wv.y = pk2(O[db][4 * rg + 2] * il, O[db][4 * rg + 3] * il);
                *(u32x2*)(ATT + row2 * 512 + h * 64 + 32 * db + 8 * rg + 4 * hi) = wv; }
    }
}
constexpr int AS_WIMG = 128 * 272;
constexpr int AS_KB = 32 * 208, AS_VB = 32 * 192, AS_WB = AS_KB + AS_VB;
__device__ __forceinline__ void attn_sample_unit(const P& p, int wv, LAS unsigned char* lds, int b, int h) {
    const int tid_l = wv * 64 + lane_id(); const int tid = tid_l, lane = tid & 63, w = tid >> 6, q = lane & 31, hi = lane >> 5;
    const bf16_t* Qb = (const bf16_t*)(p.ws + WS_Q); const bf16_t* CA = (const bf16_t*)(p.ws + WS_CALL); const bf16_t* WKV = (const bf16_t*)(p.ws + WS_WKV);
    const bf16_t* KR = (const bf16_t*)(p.ws + WS_KRALL); bf16_t* ATT = (bf16_t*)(p.ws + WS_ATT);
    for (int e = tid; e < 128 * 16; e += 512) { const int j = e >> 4, ch = e & 15, d = j & 63, slot = (j < 64) ? h : 8 + h;
        const int prow = 256 * (slot >> 2) + 128 * (d >> 5) + 32 * (slot & 3) + (d & 31);
        *(LAS u32x4*)(lds + j * 272 + ch * 16) = *(const u32x4*)(WKV + (size_t)prow * 128 + 8 * ch); }
    const size_t row1 = (size_t)MP + b * DSQ + q;
    bf16x8 qf[6];
    load_q(qf, Qb + row1 * 768 + h * 96, (float)(PAST + q), p.g_qn, p.g_qr, p.g_kn, hi);
    float m = 0.f, l = 0.f; f32x16 O[2];
#pragma unroll
    for (int r = 0; r < 16; ++r) { O[0][r] = 0.f; O[1][r] = 0.f; }
    LAS unsigned char* Kc = lds + AS_WIMG + w * AS_WB; LAS unsigned char* VT = Kc + AS_KB;
    const size_t rowk_b = (size_t)MKP + (size_t)b * KSAMP;
    __syncthreads();
    bf16x8 cf[8]; u32x4 rr2[2];
#define AS_LOAD(JT) do { const size_t rk_ = rowk_b + 32 * (size_t)(JT); \
        _Pragma("unroll") for (int i = 0; i < 8; ++i) cf[i] = *(const bf16x8*)(CA + (rk_ + q) * 128 + 16 * i + 8 * hi); \
        _Pragma("unroll") for (int n = 0; n < 2; ++n) { const int key = (lane >> 2) + 16 * n, part = lane & 3; rr2[n] = *(const u32x4*)(KR + (rk_ + key) * 32 + 8 * part); } } while (0)
    AS_LOAD(w);
    for (int jt = w; jt < 129; jt += 8) {
#pragma unroll
        for (int n = 0; n < 2; ++n) { const int key = (lane >> 2) + 16 * n, part = lane & 3; *(LAS u32x4*)(Kc + key * 208 + 128 + part * 16) = rr2[n]; }
        {
            f32x16 k0, k1;
#pragma unroll
            for (int r = 0; r < 16; ++r) { k0[r] = 0.f; k1[r] = 0.f; }
#pragma unroll
            for (int i = 0; i < 8; ++i) {
                const bf16x8 w0 = *(const LAS bf16x8*)(lds + q * 272 + (16 * i + 8 * hi) * 2), w1 = *(const LAS bf16x8*)(lds + (32 + q) * 272 + (16 * i + 8 * hi) * 2);
                k0 = __builtin_amdgcn_mfma_f32_32x32x16_bf16(w0, cf[i], k0, 0, 0, 0); k1 = __builtin_amdgcn_mfma_f32_32x32x16_bf16(w1, cf[i], k1, 0, 0, 0); }
            float ss = 0.f;
#pragma unroll
            for (int r = 0; r < 16; ++r) ss += k0[r] * k0[r] + k1[r] * k1[r];
            const float rs = rsqrtf(xhalf_sum(ss) * (1.0f / 64.0f) + EPS);
#pragma unroll
            for (int rg = 0; rg < 4; ++rg) {
                u32x2 a; a.x = pk2c(k0[4 * rg] * rs, k0[4 * rg + 1] * rs); a.y = pk2c(k0[4 * rg + 2] * rs, k0[4 * rg + 3] * rs);
                *(LAS u32x2*)(Kc + q * 208 + (8 * rg + 4 * hi) * 2) = a;
                u32x2 c; c.x = pk2c(k1[4 * rg] * rs, k1[4 * rg + 1] * rs); c.y = pk2c(k1[4 * rg + 2] * rs, k1[4 * rg + 3] * rs);
                *(LAS u32x2*)(Kc + q * 208 + (32 + 8 * rg + 4 * hi) * 2) = c; }
        }
        {
            f32x16 v0, v1;
#pragma unroll
            for (int r = 0; r < 16; ++r) { v0[r] = 0.f; v1[r] = 0.f; }
#pragma unroll
            for (int i = 0; i < 8; ++i) {
                const bf16x8 w0 = *(const LAS bf16x8*)(lds + (64 + q) * 272 + (16 * i + 8 * hi) * 2), w1 = *(const LAS bf16x8*)(lds + (96 + q) * 272 + (16 * i + 8 * hi) * 2);
                v0 = __builtin_amdgcn_mfma_f32_32x32x16_bf16(w0, cf[i], v0, 0, 0, 0); v1 = __builtin_amdgcn_mfma_f32_32x32x16_bf16(w1, cf[i], v1, 0, 0, 0); }
#pragma unroll
            for (int rg = 0; rg < 4; ++rg) {
                u32x2 a; a.x = pk2c(v0[4 * rg], v0[4 * rg + 1]); a.y = pk2c(v0[4 * rg + 2], v0[4 * rg + 3]);
                *(LAS u32x2*)(VT + q * 192 + (8 * rg + 4 * hi) * 2) = a;
                u32x2 c; c.x = pk2c(v1[4 * rg], v1[4 * rg + 1]); c.y = pk2c(v1[4 * rg + 2], v1[4 * rg + 3]);
                *(LAS u32x2*)(VT + q * 192 + (32 + 8 * rg + 4 * hi) * 2) = c; }
        }
        if (jt + 8 < 129) AS_LOAD(jt + 8);
        asm volatile("" ::: "memory"); __builtin_amdgcn_wave_barrier();
        att_blk(Kc, VT, qf, m, l, O, lane, 0);
        asm volatile("" ::: "memory"); __builtin_amdgcn_wave_barrier();
    }
#undef AS_LOAD
    __syncthreads();
    LAS float* Ox = (LAS float*)lds;
    LAS float* Mx = (LAS float*)(lds + 65536);
    LAS float* Lx = Mx + 256;
#pragma unroll
    for (int db = 0; db < 2; ++db)
#pragma unroll
        for (int r = 0; r < 16; ++r) Ox[(w * 64 + 32 * db + crow(r, hi)) * 32 + q] = O[db][r];
    { const float lt = xhalf_sum(l); if (hi == 0) { Mx[w * 32 + q] = m; Lx[w * 32 + q] = lt; } }
    __syncthreads();
    {
        const int qq = tid & 31, dg = tid >> 5;
        float M = -3e30f;
#pragma unroll
        for (int ww = 0; ww < 8; ++ww) M = fmaxf(M, Mx[ww * 32 + qq]);
        float L = 0.f, o[4] = {0.f, 0.f, 0.f, 0.f};
#pragma unroll
        for (int ww = 0; ww < 8; ++ww) { const float sc = __builtin_amdgcn_exp2f(Mx[ww * 32 + qq] - M); L += Lx[ww * 32 + qq] * sc;
#pragma unroll
            for (int e = 0; e < 4; ++e) o[e] += Ox[(ww * 64 + 4 * dg + e) * 32 + qq] * sc; }
        const float il = 1.0f / L;
        u32x2 wv; wv.x = pk2(o[0] * il, o[1] * il); wv.y = pk2(o[2] * il, o[3] * il);
        *(u32x2*)(ATT + ((size_t)M2P + b * DSQ + qq) * 512 + h * 64 + 4 * dg) = wv;
    }
    __syncthreads();
}
__device__ __forceinline__ void phase_attn(const P& p, int wv, LAS unsigned char* lds) {
    for (int u = blockIdx.x; u < 256; u += gridDim.x) attn_prompt_unit(p, wv, lds, u >> 3, u & 7);
    for (int u = blockIdx.x; u < 256; u += gridDim.x) attn_sample_unit(p, wv, lds, u >> 3, u & 7);
}

__device__ __forceinline__ void phase_e2(const P& p, int wv) {
    const int tid_l = wv * 64 + lane_id(); const int lane = tid_l & 63, wave = tid_l >> 6;
    const bf16_t* ATT = (const bf16_t*)(p.ws + WS_ATT); bf16_t* MIX = (bf16_t*)(p.ws + WS_MIX);
    const f32x4 g0 = *(const f32x4*)(p.g_ao + 8 * lane), g1 = *(const f32x4*)(p.g_ao + 8 * lane + 4);
    const int stride = gridDim.x * 8;
    for (int row0 = blockIdx.x * 8 + wave; row0 < M2; row0 += 4 * stride) {
        u32x4 raw[4];
#pragma unroll
        for (int u = 0; u < 4; ++u) { const int row = row0 + u * stride; raw[u] = *(const u32x4*)(ATT + (size_t)(row < M2 ? row : row0) * 512 + 8 * lane); }
#pragma unroll
        for (int u = 0; u < 4; ++u) { const int row = row0 + u * stride;
            const f32x4 a = {bflo(raw[u].x), bfhi(raw[u].x), bflo(raw[u].y), bfhi(raw[u].y)}, c = {bflo(raw[u].z), bfhi(raw[u].z), bflo(raw[u].w), bfhi(raw[u].w)};
            const float ss = (a[0] * a[0] + a[1] * a[1]) + (a[2] * a[2] + a[3] * a[3]) + (c[0] * c[0] + c[1] * c[1]) + (c[2] * c[2] + c[3] * c[3]);
            const float rs = rsqrtf(wave_sum(ss) * (1.0f / 512.0f) + EPS);
            const f32x4 o0 = a * g0 * rs, o1 = c * g1 * rs;
            u32x4 w; w.x = pk2(o0[0], o0[1]); w.y = pk2(o0[2], o0[3]); w.z = pk2(o1[0], o1[1]); w.w = pk2(o1[2], o1[3]);
            if (row < M2) *(u32x4*)(MIX + (size_t)row * 1024 + 8 * lane) = w; }
    }
}
__device__ __forceinline__ void phase_e3(const P& p, int wv) {
    const int tid_l = wv * 64 + lane_id(); const int lane = tid_l & 63, wave = tid_l >> 6;
    const bf16_t* H = (const bf16_t*)(p.ws + WS_H); bf16_t* U = (bf16_t*)(p.ws + WS_U);
    f32x4 g[4];
#pragma unroll
    for (int j = 0; j < 4; ++j) g[j] = *(const f32x4*)(p.g_ffn + 4 * lane + 256 * j);
    const int stride = gridDim.x * 8;
    for (int row = blockIdx.x * 8 + wave; row < M2P; row += 2 * stride) {
        const int rowb = row + stride; const bool hb = rowb < M2P; const int rb = hb ? rowb : row;
        f32x4 va[4], vb[4]; float ssa = 0.f, ssb = 0.f;
#pragma unroll
        for (int j = 0; j < 4; ++j) { const u32x2 ra_ = *(const u32x2*)(H + (size_t)row * 1024 + 4 * lane + 256 * j), rb_ = *(const u32x2*)(H + (size_t)rb * 1024 + 4 * lane + 256 * j);
            va[j] = (f32x4){bflo(ra_.x), bfhi(ra_.x), bflo(ra_.y), bfhi(ra_.y)}; vb[j] = (f32x4){bflo(rb_.x), bfhi(rb_.x), bflo(rb_.y), bfhi(rb_.y)}; }
#pragma unroll
        for (int j = 0; j < 4; ++j) { ssa += (va[j][0] * va[j][0] + va[j][1] * va[j][1]) + (va[j][2] * va[j][2] + va[j][3] * va[j][3]);
                                      ssb += (vb[j][0] * vb[j][0] + vb[j][1] * vb[j][1]) + (vb[j][2] * vb[j][2] + vb[j][3] * vb[j][3]); }
        const float rsa = rsqrtf(wave_sum(ssa) * (1.0f / 1024.0f) + EPS), rsb = rsqrtf(wave_sum(ssb) * (1.0f / 1024.0f) + EPS);
#pragma unroll
        for (int j = 0; j < 4; ++j) { const f32x4 o = va[j] * g[j] * rsa; u32x2 w; w.x = pk2(o[0], o[1]); w.y = pk2(o[2], o[3]);
            *(u32x2*)(U + (size_t)row * 1024 + 4 * lane + 256 * j) = w; }
        if (hb) {
#pragma unroll
            for (int j = 0; j < 4; ++j) { const f32x4 o = vb[j] * g[j] * rsb; u32x2 w; w.x = pk2(o[0], o[1]); w.y = pk2(o[2], o[3]);
                *(u32x2*)(U + (size_t)rowb * 1024 + 4 * lane + 256 * j) = w; } }
    }
    { const float* PB = (const float*)(p.ws + WS_PB5); float* Hw = (float*)(p.ws + WS_HS);
      for (int r = blockIdx.x * 8 + wave; r < MS; r += stride) {
          f32x4 v[4]; float ss = 0.f;
#pragma unroll
          for (int j = 0; j < 4; ++j) { const size_t o = (size_t)r * 1024 + 4 * lane + 256 * j;
              v[j] = (*(const f32x4*)(PB + o) + *(const f32x4*)(PB + 1048576 + o)) + (*(const f32x4*)(PB + 2 * 1048576 + o) + *(const f32x4*)(PB + 3 * 1048576 + o)) + *(const f32x4*)(p.xs + o);
              *(f32x4*)(Hw + (size_t)r * 1024 + 4 * lane + 256 * j) = v[j];
              ss += (v[j][0] * v[j][0] + v[j][1] * v[j][1]) + (v[j][2] * v[j][2] + v[j][3] * v[j][3]); }
          const float rs = rsqrtf(wave_sum(ss) * (1.0f / 1024.0f) + EPS);
#pragma unroll
          for (int j = 0; j < 4; ++j) { const f32x4 o = v[j] * g[j] * rs; u32x2 w; w.x = pk2(o[0], o[1]); w.y = pk2(o[2], o[3]);
              *(u32x2*)(U + (size_t)(M2P + r) * 1024 + 4 * lane + 256 * j) = w; }
      } }
}

#define XB_TMO      128
#define XB_XCNT(j)  (256  + 64 * (j))
#define XB_XSUB(j)  (1280 + 64 * (j))
#define XB_XGEN(j)  (2304 + 64 * (j))
#define XB_TOP      3328
#define XB_TOPGEN   3392
#define XCD_BAR_WORDS 3456
#define XB_SPIN_CAP (1u << 18)

__device__ __forceinline__ unsigned xb_ld(unsigned* p)              { return __hip_atomic_load(p, __ATOMIC_RELAXED, __HIP_MEMORY_SCOPE_AGENT); }
__device__ __forceinline__ unsigned xb_add(unsigned* p, unsigned v) { return __hip_atomic_fetch_add(p, v, __ATOMIC_RELAXED, __HIP_MEMORY_SCOPE_AGENT); }
__device__ __forceinline__ unsigned xb_xcc_id() { return (unsigned)__builtin_amdgcn_s_getreg((3 << 11) | 20) & 0xFu; }
#define XB_SPIN(cond, bar) do { unsigned _sp = 0; while (cond) { __builtin_amdgcn_s_sleep(1); \
    if ((++_sp & 255u) == 0u) { if (xb_ld(&(bar)[XB_TMO])) break; if (_sp > XB_SPIN_CAP) { atomicAdd(&(bar)[XB_TMO], 1u); break; } } } } while (0)

struct XcdBarrier {
    int wv;
    unsigned* bar; unsigned x;
    volatile LAS unsigned* st;
};

__device__ __forceinline__ XcdBarrier xcd_barrier_post(unsigned* bar, volatile LAS unsigned* st) {
    XcdBarrier b; b.wv = 0; b.bar = bar; b.x = xb_xcc_id(); b.st = st;
    if (threadIdx.x == 0) (void)xb_add(&bar[XB_XCNT(b.x)], 1u);
    return b;
}
__device__ __forceinline__ void xcd_barrier_complete(unsigned* bar, unsigned x, unsigned& nloc, unsigned& nx) {
    const unsigned G = gridDim.x * gridDim.y * gridDim.z;
    unsigned sum, cnt, mine, sp = 0u;
    for (;;) {
        sum = 0u; cnt = 0u; mine = 0u;
#pragma unroll
        for (unsigned j = 0; j < 16; ++j) { const unsigned c = xb_ld(&bar[XB_XCNT(j)]); sum += c; cnt += (c > 0u) ? 1u : 0u; mine = (j == x) ? c : mine; }
        if (sum == G) break;
        __builtin_amdgcn_s_sleep(1);
        if ((++sp & 255u) == 0u) { if (xb_ld(&bar[XB_TMO])) break; if (sp > XB_SPIN_CAP) { atomicAdd(&bar[XB_TMO], 1u); break; } }
    }
    nloc = mine > 0u ? mine : 1u; nx = cnt > 0u ? cnt : 1u;
}

__device__ __forceinline__ void xcd_barrier(const XcdBarrier& b) {
    asm volatile("s_waitcnt vmcnt(0)" ::: "memory");
    __syncthreads();
    if (b.wv == 0 && lane_id() == 0) {
        unsigned* bar = b.bar;
        __builtin_amdgcn_s_waitcnt(0);
        unsigned nloc = b.st[0], nx = b.st[1];
        if (nloc == 0u) { xcd_barrier_complete(bar, b.x, nloc, nx); b.st[0] = nloc; b.st[1] = nx; }
        const unsigned old = xb_add(&bar[XB_XSUB(b.x)], 1u);
        const unsigned gen = old / nloc;
        if (old + 1u == (gen + 1u) * nloc) {
            __builtin_amdgcn_fence(__ATOMIC_RELEASE, "agent");
            asm volatile("s_waitcnt vmcnt(0)" ::: "memory");
            const unsigned og = xb_add(&bar[XB_TOP], 1u);
            const unsigned tg = og / nx;
            if (og + 1u == (tg + 1u) * nx) xb_add(&bar[XB_TOPGEN], 1u);
            else XB_SPIN(xb_ld(&bar[XB_TOPGEN]) == tg, bar);
            __builtin_amdgcn_fence(__ATOMIC_ACQUIRE, "agent");
            xb_add(&bar[XB_XGEN(b.x)], 1u);
            asm volatile("s_waitcnt vmcnt(0)" ::: "memory");
        } else {
            XB_SPIN(xb_ld(&bar[XB_XGEN(b.x)]) == gen, bar);
            __builtin_amdgcn_fence(__ATOMIC_ACQUIRE, "agent");
            asm volatile("s_waitcnt vmcnt(0)" ::: "memory");
        }
    }
    __syncthreads();
}

template <class Epi> __device__ __forceinline__ void run_gemm(int wv, LAS unsigned char* lds, const bf16_t* A, const bf16_t* Bt, int M, int N, int K, const Epi& E) {
    pg8::Gemm g{A, Bt, M, N, K, K, wv}; pg8::StaticOrder S; S.init(M, N, (int)gridDim.x, (int)blockIdx.x);
    pg8::gemm_phase<Epi, pg8::StaticOrder, true, true>(lds, g, S, E);
}

#ifndef PH_MASK
#define PH_MASK 0xFFFF
#endif
#ifndef PH_TWICE
#define PH_TWICE 0
#ifndef EXTRA_SYNCS
#define EXTRA_SYNCS 0
#endif
#endif
__device__ __forceinline__ void run_gemm_split(int wv, LAS unsigned char* lds, const bf16_t* A, const bf16_t* Bt, int N, int K, int Kc, int pm0, int npm, const pg8::EpiPartial& E) {
    pg8::Gemm g{A, Bt, 0, N, K, Kc, wv}; pg8::SplitOrder S{pm0, npm, N / 256, K / Kc, (int)gridDim.x, (int)blockIdx.x};
    pg8::gemm_phase<pg8::EpiPartial, pg8::SplitOrder, true, true, true>(lds, g, S, E);
}
__global__ void __launch_bounds__(512, 2) hymba_fwd(P p) {
    extern __shared__ __attribute__((aligned(16))) unsigned char lds_raw[];
    LAS unsigned char* lds = (LAS unsigned char*)lds_raw;
    cg::grid_group grid = cg::this_grid();
    unsigned char* ws = p.ws;
    volatile LAS unsigned* bst = (volatile LAS unsigned*)(lds + LDS_BYTES - 64);
    if (threadIdx.x < 16) bst[threadIdx.x] = 0u;
    __syncthreads();
    XcdBarrier xbar = xcd_barrier_post((unsigned*)(ws + WS_CTL), bst);
    const int wv = __builtin_amdgcn_readfirstlane((int)(threadIdx.x >> 6)); xbar.wv = wv;
#define GBAR() xcd_barrier(xbar)
    if (PH_MASK & 1) phase_e0(p, wv, lds);
    if (PH_TWICE & 1) { __syncthreads(); phase_e0(p, wv, lds); }
    if (p.ws == nullptr) grid.sync();
    GBAR();
    if (PH_MASK & 2) { pg8::EpiStore E{(bf16_t*)(ws + WS_PROJ), NPROJ}; run_gemm(wv, lds, (const bf16_t*)(ws + WS_XN), (const bf16_t*)(ws + WS_WIN), M1, NPROJ, 1024, E); }
    if (PH_TWICE & 2) { pg8::EpiStore E{(bf16_t*)(ws + WS_PROJ), NPROJ}; run_gemm(wv, lds, (const bf16_t*)(ws + WS_XN), (const bf16_t*)(ws + WS_WIN), M1, NPROJ, 1024, E); }
    GBAR();
    for (int es = 0; es < EXTRA_SYNCS; ++es) GBAR();
    if (PH_MASK & 4) phase_e1(p, wv);
    if (PH_TWICE & 4) phase_e1(p, wv);
    GBAR();
    if (PH_MASK & 16) { pg8::EpiStore E{(bf16_t*)(ws + WS_E), 1536}; run_gemm(wv, lds, (const bf16_t*)(ws + WS_LIN), (const bf16_t*)(ws + WS_WL), M1, 1536, 256, E); }
    if (PH_TWICE & 16) { pg8::EpiStore E{(bf16_t*)(ws + WS_E), 1536}; run_gemm(wv, lds, (const bf16_t*)(ws + WS_LIN), (const bf16_t*)(ws + WS_WL), M1, 1536, 256, E); }
    GBAR();
    if (PH_MASK & 32) phase_scan(p, wv, lds);
    if (PH_TWICE & 32) phase_scan(p, wv, lds);
    GBAR();
    if (PH_MASK & 8) { pg8::EpiStore E{(bf16_t*)(ws + WS_Q), 768}; run_gemm(wv, lds, (const bf16_t*)(ws + WS_QL), (const bf16_t*)(ws + WS_WQ), M1, 768, 256, E); }
    if (PH_TWICE & 8) { pg8::EpiStore E{(bf16_t*)(ws + WS_Q), 768}; run_gemm(wv, lds, (const bf16_t*)(ws + WS_QL), (const bf16_t*)(ws + WS_WQ), M1, 768, 256, E); }
    GBAR();
    if (PH_MASK & 128) phase_attn(p, wv, lds);
    if (PH_TWICE & 128) phase_attn(p, wv, lds);
    GBAR();
    if (PH_MASK & 256) phase_e2(p, wv);
    if (PH_TWICE & 256) phase_e2(p, wv);
    GBAR();
    if (PH_MASK & 512) { pg8::EpiResToB16 E{(bf16_t*)(ws + WS_H), p.xp}; run_gemm(wv, lds, (const bf16_t*)(ws + WS_MIX), (const bf16_t*)(ws + WS_WOUT), M2P, 1024, 1024, E);
        pg8::EpiPartial E2{(float*)(ws + WS_PB5), M2P}; run_gemm_split(wv, lds, (const bf16_t*)(ws + WS_MIX), (const bf16_t*)(ws + WS_WOUT), 1024, 1024, 256, M2P / 256, MS / 256, E2); }
    GBAR();
    if (PH_MASK & 1024) phase_e3(p, wv);
    if (PH_TWICE & 1024) phase_e3(p, wv);
    GBAR();
    if (PH_MASK & 2048) { pg8::EpiSwiglu E{(bf16_t*)(ws + WS_ACT)}; run_gemm(wv, lds, (const bf16_t*)(ws + WS_U), (const bf16_t*)(ws + WS_WGU), M2, 2 * DFF, 1024, E); }
    if (PH_TWICE & 2048) { pg8::EpiSwiglu E{(bf16_t*)(ws + WS_ACT)}; run_gemm(wv, lds, (const bf16_t*)(ws + WS_U), (const bf16_t*)(ws + WS_WGU), M2, 2 * DFF, 1024, E); }
    GBAR();
    if (PH_MASK & 4096) { pg8::EpiOutFromB16 E{p.out, (const bf16_t*)(ws + WS_H)}; run_gemm(wv, lds, (const bf16_t*)(ws + WS_ACT), (const bf16_t*)(ws + WS_WDN), M2P, 1024, DFF, E);
        pg8::EpiPartial E2{(float*)(ws + WS_PB7), M2P}; run_gemm_split(wv, lds, (const bf16_t*)(ws + WS_ACT), (const bf16_t*)(ws + WS_WDN), 1024, DFF, 256, M2P / 256, MS / 256, E2); }
    GBAR();
    {
        const float* PB = (const float*)(ws + WS_PB7); float* ys = p.out + OFF_YS;
        const int tid_l = wv * 64 + lane_id();
        for (size_t e = (size_t)blockIdx.x * 512 + tid_l; e < (size_t)MS * 1024 / 4; e += (size_t)gridDim.x * 512) {
            f32x4 a = *(const f32x4*)(PB + 4 * e) + *(const f32x4*)((const float*)(ws + WS_HS) + 4 * e);
#pragma unroll
            for (int kc = 1; kc < 11; ++kc) a += *(const f32x4*)(PB + (size_t)kc * 1048576 + 4 * e);
            *(f32x4*)(ys + 4 * e) = a; }
    }
}

extern "C" void kernel_launch(void* const* d_in, const int* in_sizes, int n_in, void* d_out, int out_size, void* d_ws, size_t ws_size, hipStream_t stream) {
    static int grid_blocks = 0;
    if (grid_blocks == 0) {
        if (n_in != 34 || ws_size < WS_NEED) { fprintf(stderr, "kernel_launch: unexpected n_in %d / ws_size %zu\n", n_in, ws_size); grid_blocks = -1; return; }
        int dev = 0, cus = 0, per_cu = 0;
        hipGetDevice(&dev);
        hipDeviceGetAttribute(&cus, hipDeviceAttributeMultiprocessorCount, dev);
        if (hipFuncSetAttribute((const void*)hymba_fwd, hipFuncAttributeMaxDynamicSharedMemorySize, LDS_BYTES) != hipSuccess) { fprintf(stderr, "kernel_launch: hipFuncSetAttribute failed\n"); }
        if (hipOccupancyMaxActiveBlocksPerMultiprocessor(&per_cu, (const void*)hymba_fwd, 512, LDS_BYTES) != hipSuccess || per_cu < 1) per_cu = 1;
        (void)hipGetLastError();
        if (per_cu > 1) per_cu = 1;
        grid_blocks = cus * per_cu;
    }
    if (grid_blocks < 0) return;
    P p{};
    const float** f = (const float**)&p;
    for (int i = 0; i < 34; ++i) f[i] = (const float*)d_in[i];
    p.out = (float*)d_out; p.ws = (unsigned char*)d_ws;
    (void)hipMemsetAsync((char*)d_ws + WS_CTL, 0, 16384, stream);
    void* args[] = {&p};
    hipError_t e = hipLaunchCooperativeKernel((const void*)hymba_fwd, dim3(grid_blocks), dim3(512), args, LDS_BYTES, stream);
    if (e != hipSuccess) fprintf(stderr, "cooperative launch failed: %s (grid %d)\n", hipGetErrorString(e), grid_blocks);
}
```
